# Optimizing an MI355X kernel written in HIP

```python
import jax, jax.numpy as jnp
from jax import lax
import numpy as np

D_MODEL = 1024
BATCH = 8
SEQ = 4096
DEPTH = 1

PLE_DIM = 256
NORM_EPS = 1e-6
MIX_WIDTH = D_MODEL
GLA_WIDTH = MIX_WIDTH // 2
GLA_HEADS = 4
GLA_DV = GLA_WIDTH // GLA_HEADS
GLA_DK = GLA_DV // 2
GLA_GATE_RANK = 16
GLA_TAU = 16.0
GLA_CHUNK = 64
DSW_WIDTH = MIX_WIDTH - GLA_WIDTH
DSW_HEAD_DIM = 64
DSW_HEADS = DSW_WIDTH // DSW_HEAD_DIM
DSW_PATTERNS = ((128, 1), (512, 4), (2048, 16))
DSW_BLOCK = 128
ROT_DIM = DSW_HEAD_DIM // 4
ROPE_THETA = 500000.0
PEER_N_KEYS = 128
PEER_N_EXPERTS = PEER_N_KEYS * PEER_N_KEYS
PEER_HEADS = 8
PEER_TOPK = 16
PEER_QDIM = 256
PEER_HALF = PEER_QDIM // 2
PEER_TOKEN_BLOCK = 128

IN_SPLITS = (GLA_HEADS * GLA_DK, GLA_HEADS * GLA_DK, GLA_WIDTH, GLA_WIDTH, GLA_GATE_RANK,
             DSW_WIDTH, DSW_WIDTH, DSW_WIDTH)
IN_COLS = sum(IN_SPLITS)
IN_SPLIT_IDX = [int(c) for c in np.cumsum(IN_SPLITS)[:-1]]

kernel_name = "hymba_gla_dilated_peer_ple"


def rms_norm(x, g):
    xf = x.astype(jnp.float32)
    y = xf * lax.rsqrt(jnp.mean(xf * xf, axis=-1, keepdims=True) + NORM_EPS)
    return (y * g.astype(jnp.float32)).astype(x.dtype)


def partial_rope(t, positions):
    inv_freq = ROPE_THETA ** (-jnp.arange(0, ROT_DIM, 2, dtype=jnp.float32) / ROT_DIM)
    ang = positions.astype(jnp.float32)[..., None] * inv_freq
    ang = jnp.concatenate([ang, ang], axis=-1)[:, :, None, :]
    rot = t[..., :ROT_DIM].astype(jnp.float32)
    half = ROT_DIM // 2
    rot_half = jnp.concatenate([-rot[..., half:], rot[..., :half]], axis=-1)
    rot = rot * jnp.cos(ang) + rot_half * jnp.sin(ang)
    return jnp.concatenate([rot.astype(t.dtype), t[..., ROT_DIM:]], axis=-1)


def gla_chunked(q, k, v, log_a):
    bsz, slen, nh, dk = q.shape
    dv = v.shape[-1]
    n = slen // GLA_CHUNK

    def chunks(t):
        return t.astype(jnp.float32).reshape(bsz, n, GLA_CHUNK, nh, t.shape[-1]).transpose(0, 3, 1, 2, 4)

    qc = chunks(q) * (dk ** -0.5)
    kc = chunks(k)
    vc = chunks(v)
    b = jnp.cumsum(chunks(log_a), axis=3)
    b_last = b[:, :, :, -1:, :]
    q_dec = qc * jnp.exp(b)
    k_dec = kc * jnp.exp(-b)
    k_end = kc * jnp.exp(b_last - b)
    causal = jnp.tril(jnp.ones((GLA_CHUNK, GLA_CHUNK), dtype=bool))
    attn = jnp.where(causal, jnp.einsum('bhncd,bhnsd->bhncs', q_dec, k_dec), 0.0)
    o_intra = jnp.einsum('bhncs,bhnsv->bhncv', attn, vc)
    chunk_kv = jnp.einsum('bhncd,bhncv->bhndv', k_end, vc)
    decay = jnp.exp(b_last[:, :, :, 0, :])

    def step(state, inp):
        dec, kv = inp
        return dec[..., None] * state + kv, state

    init = jnp.zeros((bsz, nh, dk, dv), jnp.float32)
    _, s_prev = lax.scan(step, init, (jnp.moveaxis(decay, 2, 0), jnp.moveaxis(chunk_kv, 2, 0)))
    s_prev = jnp.moveaxis(s_prev, 0, 2)
    o = o_intra + jnp.einsum('bhncd,bhndv->bhncv', q_dec, s_prev)
    return o.transpose(0, 2, 3, 1, 4).reshape(bsz, slen, nh, dv)


def dilated_window_attention(q, k, v, window, dilation):
    bsz, slen, nh, hd = q.shape
    n_back = window // dilation
    span = dilation * DSW_BLOCK
    sp = -(-slen // span) * span
    pad = sp - slen
    m = sp // dilation
    nb = m // DSW_BLOCK

    def to_blocks(t):
        t = jnp.pad(t, ((0, 0), (0, pad), (0, 0), (0, 0)))
        t = t.reshape(bsz, m, dilation, nh, hd).transpose(0, 2, 1, 3, 4)
        return t.reshape(bsz, dilation, nb, DSW_BLOCK, nh, hd)

    qb, kb, vb = to_blocks(q), to_blocks(k), to_blocks(v)
    zpad = ((0, 0), (0, 0), (1, 0), (0, 0), (0, 0), (0, 0))
    kk = jnp.concatenate([jnp.pad(kb[:, :, :-1], zpad), kb], axis=3)
    vv = jnp.concatenate([jnp.pad(vb[:, :, :-1], zpad), vb], axis=3)
    scores = jnp.einsum('brnqhd,brnkhd->brnhqk', qb, kk).astype(jnp.float32) * (hd ** -0.5)
    qi = jnp.arange(DSW_BLOCK)[:, None]
    ki = jnp.arange(2 * DSW_BLOCK)[None, :]
    dist = qi + DSW_BLOCK - ki
    band = (dist >= 0) & (dist <= n_back)
    no_prev = (jnp.arange(nb) == 0)[:, None, None] & (ki < DSW_BLOCK)[None]
    mask = (band[None] & ~no_prev)[:, None]
    scores = jnp.where(mask, scores, -jnp.inf)
    lse = jax.nn.logsumexp(scores, axis=-1)
    probs = jnp.exp(scores - lse[..., None])
    o = jnp.einsum('brnhqk,brnkhd->brnqhd', probs.astype(v.dtype), vv)
    o = o.reshape(bsz, dilation, m, nh, hd).transpose(0, 2, 1, 3, 4).reshape(bsz, sp, nh, hd)[:, :slen]
    lse = lse.transpose(0, 1, 2, 4, 3).reshape(bsz, dilation, m, nh).transpose(0, 2, 1, 3)
    lse = lse.reshape(bsz, sp, nh)[:, :slen]
    return o, lse


def dilated_mixture(q, k, v):
    outs, lses = [], []
    for window, dilation in DSW_PATTERNS:
        o, lse = dilated_window_attention(q, k, v, window, dilation)
        outs.append(o.astype(jnp.float32))
        lses.append(lse)
    w = jax.nn.softmax(jnp.stack(lses, axis=0), axis=0)
    o = jnp.sum(w[..., None] * jnp.stack(outs, axis=0), axis=0)
    return o.astype(q.dtype)


def peer(h, w_q, sub_keys, u_table, v_table):
    bsz, slen, dm = h.shape
    t = bsz * slen
    hf = h.reshape(t, dm)
    qr = (hf @ w_q).reshape(t, PEER_HEADS, 2, PEER_HALF)
    sc = jnp.einsum('thcd,hcnd->thcn', qr, sub_keys).astype(jnp.float32)
    s_top, i_top = lax.top_k(sc, PEER_TOPK)
    cand = (s_top[:, :, 0, :, None] + s_top[:, :, 1, None, :]).reshape(t, PEER_HEADS, PEER_TOPK * PEER_TOPK)
    cand_idx = (i_top[:, :, 0, :, None] * PEER_N_KEYS + i_top[:, :, 1, None, :]).reshape(t, PEER_HEADS, PEER_TOPK * PEER_TOPK)
    best, pos = lax.top_k(cand, PEER_TOPK)
    expert_idx = jnp.take_along_axis(cand_idx, pos, axis=-1)
    gates = jax.nn.softmax(best, axis=-1)
    nblk = t // PEER_TOKEN_BLOCK

    def block(args):
        xb, ib, gb = args
        ub = jnp.take(u_table, ib, axis=0)
        a = jnp.einsum('td,thkd->thk', xb, ub).astype(jnp.float32)
        act = (jax.nn.gelu(a, approximate=False) * gb).astype(xb.dtype)
        vb = jnp.take(v_table, ib, axis=0)
        return jnp.einsum('thk,thkd->td', act, vb)

    out = lax.map(block, (hf.reshape(nblk, PEER_TOKEN_BLOCK, dm),
                          expert_idx.reshape(nblk, PEER_TOKEN_BLOCK, PEER_HEADS, PEER_TOPK),
                          gates.reshape(nblk, PEER_TOKEN_BLOCK, PEER_HEADS, PEER_TOPK)))
    return out.reshape(bsz, slen, dm)


def setup_inputs(seed: int = 0) -> dict:
    key = jax.random.key(seed)
    ks = jax.random.split(key, 20)
    f32 = jnp.float32
    nrm = lambda k, shape, s: jax.random.normal(k, shape, f32) * s
    gain = lambda k, shape: 1.0 + 0.02 * jax.random.normal(k, shape, f32)
    x = nrm(ks[0], (BATCH, SEQ, D_MODEL), 1.0)
    p = nrm(ks[1], (DEPTH, BATCH, SEQ, PLE_DIM), 1.0)
    positions = (jnp.arange(SEQ, dtype=jnp.int32)[None, :]
                 + jax.random.randint(ks[2], (BATCH, 1), 0, 1024, dtype=jnp.int32))
    return {
        "x": x,
        "p": p,
        "positions": positions,
        "g_mix": gain(ks[3], (DEPTH, D_MODEL)),
        "w_in": nrm(ks[4], (DEPTH, D_MODEL, IN_COLS), D_MODEL ** -0.5),
        "w_gla_gate_up": nrm(ks[5], (DEPTH, GLA_GATE_RANK, GLA_HEADS * GLA_DK), GLA_GATE_RANK ** -0.5),
        "b_gla_gate": nrm(ks[6], (DEPTH, GLA_HEADS * GLA_DK), 0.1),
        "g_gla_out": gain(ks[7], (DEPTH, GLA_HEADS, GLA_DV)),
        "w_out": nrm(ks[8], (DEPTH, MIX_WIDTH, D_MODEL), MIX_WIDTH ** -0.5),
        "g_peer": gain(ks[9], (DEPTH, D_MODEL)),
        "w_peer_q": nrm(ks[10], (DEPTH, D_MODEL, PEER_HEADS * PEER_QDIM), D_MODEL ** -0.5),
        "peer_sub_keys": nrm(ks[11], (DEPTH, PEER_HEADS, 2, PEER_N_KEYS, PEER_HALF), PEER_HALF ** -0.5),
        "peer_u": nrm(ks[12], (DEPTH, PEER_N_EXPERTS, D_MODEL), D_MODEL ** -0.5),
        "peer_v": nrm(ks[13], (DEPTH, PEER_N_EXPERTS, D_MODEL), 0.5),
        "g_ple": gain(ks[14], (DEPTH, D_MODEL)),
        "w_ple_gate": nrm(ks[15], (DEPTH, D_MODEL, D_MODEL), D_MODEL ** -0.5),
        "w_ple_proj": nrm(ks[16], (DEPTH, PLE_DIM, D_MODEL), PLE_DIM ** -0.5),
        "g_final": gain(ks[17], (D_MODEL,)),
    }


def reference(x, p, positions, g_mix, w_in, w_gla_gate_up, b_gla_gate, g_gla_out, w_out,
              g_peer, w_peer_q, peer_sub_keys, peer_u, peer_v, g_ple, w_ple_gate, w_ple_proj, g_final):
    bsz, slen, _ = x.shape
    for i in range(DEPTH):
        h = rms_norm(x, g_mix[i])
        proj = h @ w_in[i]
        qa, ka, va, ra, ga_low, qb, kb, vb = jnp.split(proj, IN_SPLIT_IDX, axis=-1)
        log_a = jax.nn.log_sigmoid((ga_low @ w_gla_gate_up[i] + b_gla_gate[i]).astype(jnp.float32)) / GLA_TAU
        oa = gla_chunked(qa.reshape(bsz, slen, GLA_HEADS, GLA_DK),
                         ka.reshape(bsz, slen, GLA_HEADS, GLA_DK),
                         va.reshape(bsz, slen, GLA_HEADS, GLA_DV),
                         log_a.reshape(bsz, slen, GLA_HEADS, GLA_DK)).astype(x.dtype)
        oa = rms_norm(oa, g_gla_out[i]).reshape(bsz, slen, GLA_WIDTH) * jax.nn.silu(ra)
        qb = partial_rope(qb.reshape(bsz, slen, DSW_HEADS, DSW_HEAD_DIM), positions)
        kb = partial_rope(kb.reshape(bsz, slen, DSW_HEADS, DSW_HEAD_DIM), positions)
        vb = vb.reshape(bsz, slen, DSW_HEADS, DSW_HEAD_DIM)
        ob = dilated_mixture(qb, kb, vb).reshape(bsz, slen, DSW_WIDTH)
        x = x + jnp.concatenate([oa, ob], axis=-1) @ w_out[i]
        x = x + peer(rms_norm(x, g_peer[i]), w_peer_q[i], peer_sub_keys[i], peer_u[i], peer_v[i])
        gate = jax.nn.sigmoid(rms_norm(x, g_ple[i]) @ w_ple_gate[i])
        x = x + (p[i] @ w_ple_proj[i]) * gate
    return rms_norm(x, g_final)
```

```cpp
#include <hip/hip_runtime.h>
#include <hip/hip_bf16.h>
#include <cstdint>
#include <cstdio>

typedef unsigned short bf16_t;
constexpr int T = 32768, D = 1024, SEQ = 4096, NBATCH = 8;
constexpr int INC = 3088;
constexpr float EPS = 1e-6f;

__device__ __forceinline__ float bf2f(bf16_t v) { return __uint_as_float(((unsigned)v) << 16); }
__device__ __forceinline__ bf16_t f2bf(float f) { unsigned u = __float_as_uint(f); return (bf16_t)((u + 0x7fffu + ((u >> 16) & 1u)) >> 16); }
__device__ __forceinline__ float wave_sum(float v) {
#pragma unroll
    for (int o = 1; o < 64; o <<= 1) v += __shfl_xor(v, o);
    return v;
}

__global__ void __launch_bounds__(256) k_rmsnorm_bf16(const float* __restrict__ x, const float* __restrict__ g, bf16_t* __restrict__ out) {
    const int row = blockIdx.x * 4 + (threadIdx.x >> 6), lane = threadIdx.x & 63;
    const float* xr = x + (size_t)row * D;
    float v[16]; float s = 0.f;
#pragma unroll
    for (int j = 0; j < 4; ++j) { const float4 t = *(const float4*)(xr + 256 * j + 4 * lane); v[4*j] = t.x; v[4*j+1] = t.y; v[4*j+2] = t.z; v[4*j+3] = t.w; s += t.x*t.x + t.y*t.y + t.z*t.z + t.w*t.w; }
    const float rstd = rsqrtf(wave_sum(s) * (1.f / D) + EPS);
#pragma unroll
    for (int j = 0; j < 4; ++j) { const float4 gg = *(const float4*)(g + 256 * j + 4 * lane); bf16_t* o = out + (size_t)row * D + 256 * j + 4 * lane;
        o[0] = f2bf(v[4*j] * rstd * gg.x); o[1] = f2bf(v[4*j+1] * rstd * gg.y); o[2] = f2bf(v[4*j+2] * rstd * gg.z); o[3] = f2bf(v[4*j+3] * rstd * gg.w); }
}
__global__ void __launch_bounds__(256) k_rmsnorm_f32(float* __restrict__ x, const float* __restrict__ g) {
    const int row = blockIdx.x * 4 + (threadIdx.x >> 6), lane = threadIdx.x & 63;
    float* xr = x + (size_t)row * D;
    float4 v[4]; float s = 0.f;
#pragma unroll
    for (int j = 0; j < 4; ++j) { v[j] = *(const float4*)(xr + 256 * j + 4 * lane); s += v[j].x*v[j].x + v[j].y*v[j].y + v[j].z*v[j].z + v[j].w*v[j].w; }
    const float rstd = rsqrtf(wave_sum(s) * (1.f / D) + EPS);
#pragma unroll
    for (int j = 0; j < 4; ++j) { const float4 gg = *(const float4*)(g + 256 * j + 4 * lane); float4 o; o.x = v[j].x * rstd * gg.x; o.y = v[j].y * rstd * gg.y; o.z = v[j].z * rstd * gg.z; o.w = v[j].w * rstd * gg.w; *(float4*)(xr + 256 * j + 4 * lane) = o; }
}
__global__ void k_f32_to_bf16(const float* __restrict__ in, bf16_t* __restrict__ out, size_t n) {
    for (size_t i = (size_t)blockIdx.x * blockDim.x + threadIdx.x; i < n; i += (size_t)gridDim.x * blockDim.x) out[i] = f2bf(in[i]);
}

struct EpiStoreBf16 { bf16_t* C; int ldc; int pad; __device__ void operator()(int m, int n, float v) const { C[(size_t)m * ldc + n] = f2bf(v); } };
struct EpiResidual { const float* X; float* O; __device__ void operator()(int m, int n, float v) const { O[(size_t)m * D + n] = X[(size_t)m * D + n] + v; } };
struct EpiSigmoid { bf16_t* C; __device__ void operator()(int m, int n, float v) const { C[(size_t)m * D + n] = f2bf(1.f / (1.f + __expf(-v))); } };
struct EpiMulAdd { const bf16_t* G; float* O; __device__ void operator()(int m, int n, float v) const { O[(size_t)m * D + n] += v * bf2f(G[(size_t)m * D + n]); } };

template <class Epi>
__global__ void __launch_bounds__(256) k_gemm(const bf16_t* __restrict__ A, const float* __restrict__ W, int M, int N, int K, int pad_, Epi epi) {
    __shared__ float As[16][68];
    __shared__ float Bs[16][68];
    const int tx = threadIdx.x & 15, ty = threadIdx.x >> 4;
    const int m0 = blockIdx.y * 64, n0 = blockIdx.x * 64;
    float acc[4][4];
#pragma unroll
    for (int i = 0; i < 4; ++i)
#pragma unroll
        for (int j = 0; j < 4; ++j) acc[i][j] = 0.f;
    for (int k0 = 0; k0 < K; k0 += 16) {
#pragma unroll
        for (int i = 0; i < 4; ++i) { const int e = threadIdx.x + 256 * i; const int r = e >> 4, c = e & 15; As[c][r] = bf2f(A[(size_t)(m0 + r) * K + k0 + c]); }
#pragma unroll
        for (int i = 0; i < 4; ++i) { const int e = threadIdx.x + 256 * i; const int r = e >> 6, c = e & 63; Bs[r][c] = (n0 + c < N) ? W[(size_t)(k0 + r) * N + n0 + c] : 0.f; }
        __syncthreads();
#pragma unroll
        for (int k = 0; k < 16; ++k) {
            float a[4], b[4];
#pragma unroll
            for (int i = 0; i < 4; ++i) { a[i] = As[k][ty * 4 + i]; b[i] = Bs[k][tx * 4 + i]; }
#pragma unroll
            for (int i = 0; i < 4; ++i)
#pragma unroll
                for (int j = 0; j < 4; ++j) acc[i][j] += a[i] * b[j];
        }
        __syncthreads();
    }
#pragma unroll
    for (int i = 0; i < 4; ++i)
#pragma unroll
        for (int j = 0; j < 4; ++j) { const int m = m0 + ty * 4 + i, n = n0 + tx * 4 + j; if (n < N) epi(m, n, acc[i][j]); }
}

constexpr int OFF_QA = 0, OFF_KA = 256, OFF_VA = 512, OFF_RA = 1024, OFF_GA = 1536, OFF_QB = 1552, OFF_KB = 2064, OFF_VB = 2576;
__global__ void k_rope(bf16_t* __restrict__ proj, const int* __restrict__ positions) {
    const int idx = blockIdx.x * blockDim.x + threadIdx.x;
    if (idx >= T * 128) return;
    const int i = idx & 7, h = (idx >> 3) & 7, qk = (idx >> 6) & 1, t = idx >> 7;
    const float inv_freq = powf(500000.0f, -(float)i / 8.0f);
    const float ang = (float)positions[t] * inv_freq;
    const float c = cosf(ang), s = sinf(ang);
    bf16_t* p = proj + (size_t)t * INC + (qk ? OFF_KB : OFF_QB) + h * 64;
    const float a = bf2f(p[i]), b = bf2f(p[i + 8]);
    p[i] = f2bf(a * c - b * s);
    p[i + 8] = f2bf(b * c + a * s);
}

__global__ void __launch_bounds__(128) k_gla(const bf16_t* __restrict__ proj, const float* __restrict__ w_up, const float* __restrict__ b_gate,
                                             const float* __restrict__ g_out, bf16_t* __restrict__ mix) {
    __shared__ float sa[64], sq[64], sk[64], red[2];
    const int b = blockIdx.x >> 2, h = blockIdx.x & 3, tid = threadIdx.x;
    float S[64];
#pragma unroll
    for (int i = 0; i < 64; ++i) S[i] = 0.f;
    float wup[16]; float bg = 0.f;
    if (tid < 64) {
#pragma unroll
        for (int r = 0; r < 16; ++r) wup[r] = w_up[r * 256 + h * 64 + tid];
        bg = b_gate[h * 64 + tid];
    } else {
#pragma unroll
        for (int r = 0; r < 16; ++r) wup[r] = 0.f;
    }
    const float gg = g_out[h * 128 + tid];
    for (int t = 0; t < SEQ; ++t) {
        const bf16_t* pr = proj + (size_t)(b * SEQ + t) * INC;
        if (tid < 64) {
            float z = bg;
#pragma unroll
            for (int r = 0; r < 16; ++r) z += bf2f(pr[OFF_GA + r]) * wup[r];
            const float ls = fminf(z, 0.f) - log1pf(expf(-fabsf(z)));
            sa[tid] = expf(ls * (1.f / 16.f));
            sq[tid] = bf2f(pr[OFF_QA + h * 64 + tid]) * 0.125f;
            sk[tid] = bf2f(pr[OFF_KA + h * 64 + tid]);
        }
        __syncthreads();
        const float v = bf2f(pr[OFF_VA + h * 128 + tid]);
        float o = 0.f;
#pragma unroll
        for (int i = 0; i < 64; ++i) { S[i] = sa[i] * S[i] + sk[i] * v; o += sq[i] * S[i]; }
        const float ss = wave_sum(o * o);
        if ((tid & 63) == 0) red[tid >> 6] = ss;
        __syncthreads();
        const float rstd = rsqrtf((red[0] + red[1]) * (1.f / 128.f) + EPS);
        const float r = bf2f(pr[OFF_RA + h * 128 + tid]);
        const float silu = r / (1.f + expf(-r));
        mix[(size_t)(b * SEQ + t) * D + h * 128 + tid] = f2bf(o * rstd * gg * silu);
        __syncthreads();
    }
}

__global__ void __launch_bounds__(256) k_dsw(const bf16_t* __restrict__ proj, bf16_t* __restrict__ mix) {
    const int wid = blockIdx.x * 4 + (threadIdx.x >> 6), lane = threadIdx.x & 63;
    const int h = wid & 7, tok = wid >> 3, b = tok / SEQ, t = tok % SEQ;
    const float q = bf2f(proj[(size_t)tok * INC + OFF_QB + h * 64 + lane]);
    float lse[3], op[3];
    const int dil[3] = {1, 4, 16};
#pragma unroll
    for (int p = 0; p < 3; ++p) {
        const int d = dil[p];
        float m = -INFINITY, l = 0.f, acc = 0.f;
        for (int j = 0; j <= 128; ++j) {
            const int tk = t - j * d;
            if (tk < 0) break;
            const bf16_t* kr = proj + (size_t)(b * SEQ + tk) * INC;
            const float s = wave_sum(q * bf2f(kr[OFF_KB + h * 64 + lane])) * 0.125f;
            const float v = bf2f(kr[OFF_VB + h * 64 + lane]);
            const float mn = fmaxf(m, s);
            const float sc = expf(m - mn), pe = expf(s - mn);
            l = l * sc + pe; acc = acc * sc + pe * v; m = mn;
        }
        lse[p] = m + logf(l); op[p] = acc / l;
    }
    const float M = fmaxf(lse[0], fmaxf(lse[1], lse[2]));
    const float w0 = expf(lse[0] - M), w1 = expf(lse[1] - M), w2 = expf(lse[2] - M);
    const float o = (w0 * op[0] + w1 * op[1] + w2 * op[2]) / (w0 + w1 + w2);
    mix[(size_t)tok * D + 512 + h * 64 + lane] = f2bf(o);
}

__device__ __forceinline__ void wave_argmax(float& v, int& i) {
#pragma unroll
    for (int o = 1; o < 64; o <<= 1) { const float ov = __shfl_xor(v, o); const int oi = __shfl_xor(i, o); if (ov > v || (ov == v && oi < i)) { v = ov; i = oi; } }
}
__global__ void __launch_bounds__(256) k_peer_select(const bf16_t* __restrict__ qr, const float* __restrict__ keys, int* __restrict__ sel_idx, float* __restrict__ sel_gate) {
    __shared__ float sqr[4][256];
    __shared__ float stop[4][2][16];
    __shared__ int itop[4][2][16];
    const int w = threadIdx.x >> 6, lane = threadIdx.x & 63;
    const int wid = blockIdx.x * 4 + w, h = wid & 7, tok = wid >> 3;
#pragma unroll
    for (int j = 0; j < 4; ++j) sqr[w][lane + 64 * j] = bf2f(qr[(size_t)tok * 2048 + h * 256 + lane + 64 * j]);
    __syncthreads();
    for (int c = 0; c < 2; ++c) {
        float s0 = 0.f, s1 = 0.f;
        const float* k0 = keys + ((size_t)(h * 2 + c) * 128 + lane) * 128;
        const float* k1 = k0 + 64 * 128;
        for (int d = 0; d < 128; ++d) { const float qv = sqr[w][c * 128 + d]; s0 += qv * k0[d]; s1 += qv * k1[d]; }
        for (int r = 0; r < 16; ++r) {
            float bv; int bi;
            if (s0 >= s1) { bv = s0; bi = lane; } else { bv = s1; bi = lane + 64; }
            wave_argmax(bv, bi);
            if (bi == lane) s0 = -INFINITY;
            if (bi == lane + 64) s1 = -INFINITY;
            if (lane == 0) { stop[w][c][r] = bv; itop[w][c][r] = bi; }
        }
    }
    __syncthreads();
    float cv[4];
#pragma unroll
    for (int j = 0; j < 4; ++j) { const int id = lane + 64 * j; cv[j] = stop[w][0][id >> 4] + stop[w][1][id & 15]; }
    float best[16]; int bpos[16];
#pragma unroll
    for (int r = 0; r < 16; ++r) {
        float bv = cv[0]; int bi = lane;
#pragma unroll
        for (int j = 1; j < 4; ++j) if (cv[j] > bv) { bv = cv[j]; bi = lane + 64 * j; }
        wave_argmax(bv, bi);
#pragma unroll
        for (int j = 0; j < 4; ++j) if (bi == lane + 64 * j) cv[j] = -INFINITY;
        best[r] = bv; bpos[r] = bi;
    }
    float den = 0.f;
#pragma unroll
    for (int r = 0; r < 16; ++r) den += expf(best[r] - best[0]);
    if (lane < 16) {
        float bv = 0.f; int bp = 0;
#pragma unroll
        for (int r = 0; r < 16; ++r) if (lane == r) { bv = best[r]; bp = bpos[r]; }
        sel_idx[(size_t)tok * 128 + h * 16 + lane] = itop[w][0][bp >> 4] * 128 + itop[w][1][bp & 15];
        sel_gate[(size_t)tok * 128 + h * 16 + lane] = expf(bv - best[0]) / den;
    }
}

__global__ void __launch_bounds__(256) k_peer_gather(const bf16_t* __restrict__ hp, const int* __restrict__ sel_idx, const float* __restrict__ sel_gate,
                                                     const float* __restrict__ U, const float* __restrict__ V, float* __restrict__ xio) {
    const int tok = blockIdx.x * 4 + (threadIdx.x >> 6), lane = threadIdx.x & 63;
    float hv[16], acc[16];
#pragma unroll
    for (int j = 0; j < 4; ++j)
#pragma unroll
        for (int i = 0; i < 4; ++i) { hv[4*j+i] = bf2f(hp[(size_t)tok * D + 256 * j + 4 * lane + i]); acc[4*j+i] = 0.f; }
    for (int e = 0; e < 128; ++e) {
        const int ex = sel_idx[(size_t)tok * 128 + e];
        const float gate = sel_gate[(size_t)tok * 128 + e];
        const float* ur = U + (size_t)ex * D; const float* vr = V + (size_t)ex * D;
        float s = 0.f;
#pragma unroll
        for (int j = 0; j < 4; ++j) { const float4 u4 = *(const float4*)(ur + 256 * j + 4 * lane); s += hv[4*j] * u4.x + hv[4*j+1] * u4.y + hv[4*j+2] * u4.z + hv[4*j+3] * u4.w; }
        const float a = wave_sum(s);
        const float act = 0.5f * a * (1.f + erff(a * 0.70710678118654752f)) * gate;
#pragma unroll
        for (int j = 0; j < 4; ++j) { const float4 v4 = *(const float4*)(vr + 256 * j + 4 * lane); acc[4*j] += act * v4.x; acc[4*j+1] += act * v4.y; acc[4*j+2] += act * v4.z; acc[4*j+3] += act * v4.w; }
    }
#pragma unroll
    for (int j = 0; j < 4; ++j) { float4* o = (float4*)(xio + (size_t)tok * D + 256 * j + 4 * lane); float4 t = *o; t.x += acc[4*j]; t.y += acc[4*j+1]; t.z += acc[4*j+2]; t.w += acc[4*j+3]; *o = t; }
}

extern "C" void kernel_launch(void* const* d_in, const int* in_sizes, int n_in, void* d_out, int out_size, void* d_ws, size_t ws_size, hipStream_t stream) {
    const float* x = (const float*)d_in[0]; const float* p = (const float*)d_in[1]; const int* positions = (const int*)d_in[2];
    const float* g_mix = (const float*)d_in[3]; const float* w_in = (const float*)d_in[4]; const float* w_up = (const float*)d_in[5];
    const float* b_gate = (const float*)d_in[6]; const float* g_gla = (const float*)d_in[7]; const float* w_out = (const float*)d_in[8];
    const float* g_peer = (const float*)d_in[9]; const float* w_pq = (const float*)d_in[10]; const float* skeys = (const float*)d_in[11];
    const float* pu = (const float*)d_in[12]; const float* pv = (const float*)d_in[13]; const float* g_ple = (const float*)d_in[14];
    const float* w_pg = (const float*)d_in[15]; const float* w_pp = (const float*)d_in[16]; const float* g_final = (const float*)d_in[17];
    float* out = (float*)d_out;
    unsigned char* ws = (unsigned char*)d_ws;
    constexpr size_t MiB = 1u << 20;
    bf16_t* hbuf = (bf16_t*)(ws);
    bf16_t* proj = (bf16_t*)(ws + 64 * MiB);
    bf16_t* mix = (bf16_t*)(ws + 264 * MiB);
    bf16_t* qr = (bf16_t*)(ws + 328 * MiB);
    int* sel_idx = (int*)(ws + 456 * MiB);
    float* sel_gate = (float*)(ws + 472 * MiB);
    bf16_t* gatebuf = mix;
    bf16_t* pb = proj;

    k_rmsnorm_bf16<<<T / 4, 256, 0, stream>>>(x, g_mix, hbuf);
    k_gemm<EpiStoreBf16><<<dim3((INC + 63) / 64, T / 64), 256, 0, stream>>>(hbuf, w_in, T, INC, D, 0, EpiStoreBf16{proj, INC, 0});
    k_rope<<<T * 128 / 256, 256, 0, stream>>>(proj, positions);
    k_gla<<<32, 128, 0, stream>>>(proj, w_up, b_gate, g_gla, mix);
    k_dsw<<<T * 8 / 4, 256, 0, stream>>>(proj, mix);
    k_gemm<EpiResidual><<<dim3(D / 64, T / 64), 256, 0, stream>>>(mix, w_out, T, D, D, 0, EpiResidual{x, out});
    k_rmsnorm_bf16<<<T / 4, 256, 0, stream>>>(out, g_peer, hbuf);
    k_gemm<EpiStoreBf16><<<dim3(2048 / 64, T / 64), 256, 0, stream>>>(hbuf, w_pq, T, 2048, D, 0, EpiStoreBf16{qr, 2048, 0});
    k_peer_select<<<T * 8 / 4, 256, 0, stream>>>(qr, skeys, sel_idx, sel_gate);
    k_peer_gather<<<T / 4, 256, 0, stream>>>(hbuf, sel_idx, sel_gate, pu, pv, out);
    k_rmsnorm_bf16<<<T / 4, 256, 0, stream>>>(out, g_ple, hbuf);
    k_gemm<EpiSigmoid><<<dim3(D / 64, T / 64), 256, 0, stream>>>(hbuf, w_pg, T, D, D, 0, EpiSigmoid{gatebuf});
    k_f32_to_bf16<<<2048, 256, 0, stream>>>(p, pb, (size_t)T * 256);
    k_gemm<EpiMulAdd><<<dim3(D / 64, T / 64), 256, 0, stream>>>(pb, w_pp, T, D, 256, 0, EpiMulAdd{gatebuf, out});
    k_rmsnorm_f32<<<T / 4, 256, 0, stream>>>(out, g_final);
}
```

```cpp
#include <hip/hip_runtime.h>
#include <cstdio>
#include <cstdint>
namespace pg8 {
#define PG8_LAS __attribute__((address_space(3)))
typedef unsigned short bf16_t;
typedef short bf16x8 __attribute__((ext_vector_type(8)));
typedef float f32x4 __attribute__((ext_vector_type(4)));
typedef unsigned u32x4 __attribute__((ext_vector_type(4)));
constexpr int BM = 256, BK = 64, HALF = 128, HTB = HALF * BK * 2  , STAGE_BYTES = 8 * HTB, NXCD = 8, WGM = 8;

__host__ __device__ __forceinline__ int lds_byte(int r, int c) { const int st = (r >> 4) * 2 + (c >> 5), rr = r & 15, cc = c & 31, ob = rr * 64 + cc * 2; return st * 1024 + (ob ^ (((ob >> 9) & 1) << 5)); }
__host__ __device__ __forceinline__ void stage_rc(int b, int& R, int& C) { const int st = b / 1024, sb = b % 1024, swz = sb ^ (((sb >> 9) & 1) << 5); R = (st >> 1) * 16 + swz / 64; C = (st & 1) * 32 + (swz % 64) / 2; }
__host__ __device__ __forceinline__ int perm32(int rho) { const int n = rho >> 4, i = rho & 15; return 8 * (i >> 2) + 4 * n + (i & 3); }

struct Unit { int pm, pn; };
struct Gemm { const bf16_t* A; const bf16_t* Bt; int M, N, K; };

struct StaticOrder {
    int nM, nN, nwg, G, c;
    __host__ __device__ void init(int M, int N, int G_, int c_) { nM = M / BM; nN = N / BM; nwg = nM * nN; G = G_; c = c_; }
    __host__ __device__ bool next(int i, Unit& u) const {
        const long L = (long)i * G + c; if (L >= nwg) return false;
        int wgid = (int)L; { const int q = nwg / NXCD, r = nwg % NXCD, xcd = wgid % NXCD, off = wgid / NXCD; wgid = (xcd < r ? xcd * (q + 1) : r * (q + 1) + (xcd - r) * q) + off; }
        const int nig = WGM * nN, gid = wgid / nig, fm = gid * WGM, gsz = (nM - fm) < WGM ? (nM - fm) : WGM;
        u.pm = fm + ((wgid % nig) % gsz); u.pn = (wgid % nig) / gsz; return true;
    }
    __device__ __forceinline__ void a_ready(const Unit&) const {}
    __device__ __forceinline__ void done(const Unit&) const {}
};

__device__ __forceinline__ unsigned cvt_pk_bf16(float lo, float hi) { unsigned r; asm volatile("v_cvt_pk_bf16_f32 %0, %1, %2" : "=v"(r) : "v"(lo), "v"(hi)); return r; }
typedef float f32x2 __attribute__((ext_vector_type(2)));
__device__ __forceinline__ f32x2 gelu_pk(f32x2 v) {
    const f32x2 av = __builtin_elementwise_abs(v), d = av * 0.2316418882f + 1.0f;
    f32x2 t; t.x = __builtin_amdgcn_rcpf(d.x); t.y = __builtin_amdgcn_rcpf(d.y);
    f32x2 q = t * 0.5307027145f + (-0.7265760135f); q = q * t + 0.7107068705f; q = q * t + (-0.142248368f); q = q * t + 0.127414796f; q = q * t;
    const f32x2 s = (v * v) * (-0.72134752044f);
    f32x2 e; e.x = __builtin_amdgcn_exp2f(s.x); e.y = __builtin_amdgcn_exp2f(s.y);
    const f32x2 m = v * (q * e), r = v - m;
    f32x2 o; o.x = v.x < 0.f ? m.x : r.x; o.y = v.y < 0.f ? m.y : r.y; return o;
}

template <int ACT  > struct EpiBf16 {
    static constexpr bool PERM = true, AFTER_DRAIN = false; static_assert(ACT == 0 || ACT == 1, "EpiBf16: ACT is 0 (none) or 1 (gelu_pk)");
    bf16_t* O; int ldc; const float* bias; int split_cols; size_t split_stride; float scale0;
    __device__ __forceinline__ void operator()(const f32x4 (&acc)[2][2][4][2], const Unit& u, int wr, int wc, int fr, int fq) const {
        const int row0 = u.pm * BM + wr * 64 + fr; int colt = u.pn * BM; bf16_t* base = O;
        float sc = 1.f; if (split_cols) { const int t = colt / split_cols; base += (size_t)t * split_stride; colt -= t * split_cols; if (t == 0) sc = scale0; }
        const int col0 = colt + wc * 32 + 8 * fq, bcol0 = u.pn * BM + wc * 32 + 8 * fq;
        f32x4 bv[2][2];
#pragma unroll
        for (int bj = 0; bj < 2; ++bj)
#pragma unroll
            for (int n = 0; n < 2; ++n) bv[bj][n] = bias ? *(const f32x4*)(bias + bcol0 + bj * HALF + 4 * n) : (f32x4){0.f, 0.f, 0.f, 0.f};
#pragma unroll
        for (int ai = 0; ai < 2; ++ai)
#pragma unroll
            for (int m = 0; m < 4; ++m) { bf16_t* rowp = base + (size_t)(row0 + ai * HALF + m * 16) * ldc + col0;
#pragma unroll
                for (int bj = 0; bj < 2; ++bj) { f32x4 v0 = acc[ai][bj][m][0] + bv[bj][0], v1 = acc[ai][bj][m][1] + bv[bj][1];
                    if (ACT == 1) { f32x2 a = gelu_pk((f32x2){v0[0], v0[1]}), b = gelu_pk((f32x2){v0[2], v0[3]}), c = gelu_pk((f32x2){v1[0], v1[1]}), d = gelu_pk((f32x2){v1[2], v1[3]});
                        v0 = (f32x4){a.x, a.y, b.x, b.y}; v1 = (f32x4){c.x, c.y, d.x, d.y}; }
                    v0 = v0 * sc; v1 = v1 * sc; u32x4 w; w.x = cvt_pk_bf16(v0[0], v0[1]); w.y = cvt_pk_bf16(v0[2], v0[3]); w.z = cvt_pk_bf16(v1[0], v1[1]); w.w = cvt_pk_bf16(v1[2], v1[3]);
                    *(u32x4*)(rowp + bj * HALF) = w; } }
    }
};

__device__ __forceinline__ float xshfl(float v, int srclane) { return __int_as_float(__builtin_amdgcn_ds_bpermute(srclane << 2, __float_as_int(v))); }
constexpr int P_INC = 3328;
struct EpiInProj {
    static constexpr bool PERM = true, AFTER_DRAIN = false;
    bf16_t* O; const float* rope; const float* bgate;
    __device__ __forceinline__ void operator()(const f32x4 (&acc)[2][2][4][2], const Unit& u, int wr, int wc, int fr, int fq) const {
        const int row0 = u.pm * BM + wr * 64 + fr;
#pragma unroll
        for (int bj = 0; bj < 2; ++bj) {
            const int cb = u.pn * BM + bj * HALF + wc * 32;
            const int c0 = cb + 8 * fq;
            const bool ropechunk = (cb >= 1792) && (cb < 2816) && ((cb & 63) == 0);
            const bool lachunk = (cb >= 1536) && (cb < 1792);
            f32x4 bg0 = {0.f, 0.f, 0.f, 0.f}, bg1 = {0.f, 0.f, 0.f, 0.f};
            if (lachunk) { bg0 = *(const f32x4*)(bgate + c0 - 1536); bg1 = *(const f32x4*)(bgate + c0 - 1536 + 4); }
#pragma unroll
            for (int ai = 0; ai < 2; ++ai)
#pragma unroll
                for (int m = 0; m < 4; ++m) {
                    const int row = row0 + ai * HALF + m * 16;
                    f32x4 v0 = acc[ai][bj][m][0], v1 = acc[ai][bj][m][1];
                    if (lachunk) {
#pragma unroll
                        for (int e = 0; e < 4; ++e) { const float z0 = v0[e] + bg0[e], z1 = v1[e] + bg1[e];
                            v0[e] = (fminf(z0, 0.f) - __logf(1.f + __expf(-fabsf(z0)))) * (1.f / 16.f); v1[e] = (fminf(z1, 0.f) - __logf(1.f + __expf(-fabsf(z1)))) * (1.f / 16.f); }
                    }
                    if (ropechunk) {
                        f32x4 p0, p1;
#pragma unroll
                        for (int e = 0; e < 4; ++e) { p0[e] = xshfl(v0[e], (fq * 16 + fr) ^ 16); p1[e] = xshfl(v1[e], (fq * 16 + fr) ^ 16); }
                        if (fq < 2) {
                            const f32x4* cs = (const f32x4*)(rope + (size_t)row * 16);
                            const f32x4 t0 = cs[0], t1 = cs[1], t2 = cs[2], t3 = cs[3];
                            const float sg = (fq == 0) ? -1.f : 1.f;
                            v0[0] = v0[0] * t0[0] + sg * p0[0] * t0[1]; v0[1] = v0[1] * t0[2] + sg * p0[1] * t0[3];
                            v0[2] = v0[2] * t1[0] + sg * p0[2] * t1[1]; v0[3] = v0[3] * t1[2] + sg * p0[3] * t1[3];
                            v1[0] = v1[0] * t2[0] + sg * p1[0] * t2[1]; v1[1] = v1[1] * t2[2] + sg * p1[1] * t2[3];
                            v1[2] = v1[2] * t3[0] + sg * p1[2] * t3[1]; v1[3] = v1[3] * t3[2] + sg * p1[3] * t3[3];
                        }
                    }
                    { u32x4 w; w.x = cvt_pk_bf16(v0[0], v0[1]); w.y = cvt_pk_bf16(v0[2], v0[3]); w.z = cvt_pk_bf16(v1[0], v1[1]); w.w = cvt_pk_bf16(v1[2], v1[3]);
                        *(u32x4*)(O + (size_t)row * P_INC + c0) = w; }
                }
        }
    }
};
struct EpiOutProj {
    static constexpr bool PERM = true, AFTER_DRAIN = false;
    const float* X; bf16_t* O; float* ssq;
    __device__ __forceinline__ void operator()(const f32x4 (&acc)[2][2][4][2], const Unit& u, int wr, int wc, int fr, int fq) const {
        const int row0 = u.pm * BM + wr * 64 + fr, col0 = u.pn * BM + wc * 32 + 8 * fq;
#pragma unroll
        for (int ai = 0; ai < 2; ++ai)
#pragma unroll
            for (int m = 0; m < 4; ++m) {
                const int row = row0 + ai * HALF + m * 16; float s = 0.f;
#pragma unroll
                for (int bj = 0; bj < 2; ++bj) {
                    const float* xp = X + (size_t)row * 1024 + col0 + bj * HALF;
                    const f32x4 x0 = *(const f32x4*)xp, x1 = *(const f32x4*)(xp + 4);
                    const f32x4 v0 = acc[ai][bj][m][0] + x0, v1 = acc[ai][bj][m][1] + x1;
                    s += (v0[0] * v0[0] + v0[1] * v0[1]) + (v0[2] * v0[2] + v0[3] * v0[3]) + (v1[0] * v1[0] + v1[1] * v1[1]) + (v1[2] * v1[2] + v1[3] * v1[3]);
                    u32x4 w; w.x = cvt_pk_bf16(v0[0], v0[1]); w.y = cvt_pk_bf16(v0[2], v0[3]); w.z = cvt_pk_bf16(v1[0], v1[1]); w.w = cvt_pk_bf16(v1[2], v1[3]);
                    *(u32x4*)(O + (size_t)row * 1024 + col0 + bj * HALF) = w;
                }
                s += xshfl(s, (fq * 16 + fr) ^ 16); s += xshfl(s, (fq * 16 + fr) ^ 32);
                if (fq == 0) ssq[(size_t)(u.pn * 4 + wc) * 32768 + row] = s;
            }
    }
};
struct EpiPeerQ {
    static constexpr bool PERM = true, AFTER_DRAIN = false;
    bf16_t* O; const float* ssq;
    __device__ __forceinline__ void operator()(const f32x4 (&acc)[2][2][4][2], const Unit& u, int wr, int wc, int fr, int fq) const {
        const int row0 = u.pm * BM + wr * 64 + fr, col0 = u.pn * BM + wc * 32 + 8 * fq;
#pragma unroll
        for (int ai = 0; ai < 2; ++ai)
#pragma unroll
            for (int m = 0; m < 4; ++m) {
                const int row = row0 + ai * HALF + m * 16;
                float s = 0.f;
#pragma unroll
                for (int q = 0; q < 4; ++q) s += ssq[(size_t)(4 * fq + q) * 32768 + row];
                s += xshfl(s, (fq * 16 + fr) ^ 16); s += xshfl(s, (fq * 16 + fr) ^ 32);
                const float rstd = rsqrtf(s * (1.f / 1024.f) + 1e-6f);
#pragma unroll
                for (int bj = 0; bj < 2; ++bj) {
                    const f32x4 v0 = acc[ai][bj][m][0] * rstd, v1 = acc[ai][bj][m][1] * rstd;
                    u32x4 w; w.x = cvt_pk_bf16(v0[0], v0[1]); w.y = cvt_pk_bf16(v0[2], v0[3]); w.z = cvt_pk_bf16(v1[0], v1[1]); w.w = cvt_pk_bf16(v1[2], v1[3]);
                    *(u32x4*)(O + (size_t)row * 2048 + col0 + bj * HALF) = w;
                }
            }
    }
};
struct EpiPle {
    static constexpr bool PERM = true, AFTER_DRAIN = false;
    const bf16_t* X2; const bf16_t* PP; const float* rstd2; float* O;
    __device__ __forceinline__ void operator()(const f32x4 (&acc)[2][2][4][2], const Unit& u, int wr, int wc, int fr, int fq) const {
        const int row0 = u.pm * BM + wr * 64 + fr, col0 = u.pn * BM + wc * 32 + 8 * fq;
#pragma unroll
        for (int ai = 0; ai < 2; ++ai)
#pragma unroll
            for (int m = 0; m < 4; ++m) {
                const int row = row0 + ai * HALF + m * 16;
                const float rstd = rstd2[row];
#pragma unroll
                for (int bj = 0; bj < 2; ++bj) {
                    const size_t off = (size_t)row * 1024 + col0 + bj * HALF;
                    const u32x4 xw = *(const u32x4*)(X2 + off), pw = *(const u32x4*)(PP + off);
                    f32x4 o0, o1;
#pragma unroll
                    for (int e = 0; e < 4; ++e) {
                        const unsigned xe = (e < 2) ? ((e == 0) ? xw.x : xw.y) : ((e == 2) ? xw.z : xw.w);
                        const unsigned pe = (e < 2) ? ((e == 0) ? pw.x : pw.y) : ((e == 2) ? pw.z : pw.w);
                        const float xlo = __uint_as_float(xe << 16), xhi = __uint_as_float(xe & 0xffff0000u);
                        const float plo = __uint_as_float(pe << 16), phi = __uint_as_float(pe & 0xffff0000u);
                        const float a0 = (e < 2) ? acc[ai][bj][m][0][2 * e] : acc[ai][bj][m][1][2 * e - 4];
                        const float a1 = (e < 2) ? acc[ai][bj][m][0][2 * e + 1] : acc[ai][bj][m][1][2 * e - 3];
                        const float g0 = 1.f / (1.f + __expf(-a0 * rstd)), g1 = 1.f / (1.f + __expf(-a1 * rstd));
                        const float r0 = xlo + plo * g0, r1 = xhi + phi * g1;
                        if (e < 2) { o0[2 * e] = r0; o0[2 * e + 1] = r1; } else { o1[2 * e - 4] = r0; o1[2 * e - 3] = r1; }
                    }
                    *(f32x4*)(O + off) = o0; *(f32x4*)(O + off + 4) = o1;
                }
            }
    }
};
template <class Epi, class Sched, bool ALIGN_EPI = false, bool SP2 = false>
__device__ __forceinline__ void gemm_phase(PG8_LAS unsigned char* lds, const Gemm g, const Sched& S, const Epi& E, const int wave_id  ) {
    int lane_; asm volatile("v_mbcnt_lo_u32_b32 %0, -1, 0\n\tv_mbcnt_hi_u32_b32 %0, -1, %0" : "=v"(lane_)); int tid_ = wave_id * 64 + lane_;
    const int tid = tid_, wid = wave_id, lane = tid & 63, wr = wid >> 2, wc = wid & 3, fr = lane & 15, fq = lane >> 4;
    const int K = g.K, nt = K / BK;
    unsigned voffA[2], voffB[2];
#pragma unroll
    for (int i = 0; i < 2; ++i) { int R, C; stage_rc(tid * 16 + i * 8192, R, C); const int Rb = Epi::PERM ? ((R & ~31) + perm32(R & 31)) : R;
        voffA[i] = (unsigned)(R * K + C) * 2u; voffB[i] = (unsigned)(Rb * K + C) * 2u; }
    const size_t kstep = (size_t)(BK * 2);
    const size_t hstep = (size_t)HALF * K * 2;
    const size_t tstep = 2 * hstep;
    const unsigned ldsw = (unsigned)wid * 1024u;
    const int aoff = lds_byte(wr * 64 + fr, fq * 8), boff = lds_byte(wc * 32 + fr, fq * 8);
#define PG8_SA(b, h) (((b) * 2 + (h)) * HTB)
#define PG8_SB(b, h) ((4 + (b) * 2 + (h)) * HTB)
#define PG8_STAGE(bufoff, gbase, voff) do { _Pragma("unroll") for (int _i = 0; _i < 2; ++_i) \
        __builtin_amdgcn_global_load_lds((const unsigned*)((const char*)(gbase) + (voff)[_i]), (PG8_LAS unsigned*)(lds + (bufoff) + ldsw + _i * 8192), 16, 0, 0); } while (0)
#define PG8_LDA(dst, b, h) do { _Pragma("unroll") for (int m = 0; m < 4; ++m) _Pragma("unroll") for (int k = 0; k < 2; ++k) dst[m][k] = *(const PG8_LAS bf16x8*)(lds + PG8_SA(b, h) + aoff + m * 2048 + k * 1024); } while (0)
#define PG8_LDB(dst, b, h) do { _Pragma("unroll") for (int n = 0; n < 2; ++n) _Pragma("unroll") for (int k = 0; k < 2; ++k) dst[n][k] = *(const PG8_LAS bf16x8*)(lds + PG8_SB(b, h) + boff + n * 2048 + k * 1024); } while (0)
#define PG8_MMA(ai, bj, At, Bt) do { __builtin_amdgcn_s_setprio(1); _Pragma("unroll") for (int m = 0; m < 4; ++m) _Pragma("unroll") for (int n = 0; n < 2; ++n) _Pragma("unroll") for (int k = 0; k < 2; ++k) \
        acc[ai][bj][m][n] = __builtin_amdgcn_mfma_f32_16x16x32_bf16(Bt[n][k], At[m][k], acc[ai][bj][m][n], 0, 0, 0); __builtin_amdgcn_s_setprio(0); } while (0)
#define PG8_WAIT_V(n) asm volatile("s_waitcnt vmcnt(" #n ")" ::: "memory")
#define PG8_WAIT_L(n) asm volatile("s_waitcnt lgkmcnt(" #n ")" ::: "memory")
#define PG8_BAR __builtin_amdgcn_s_barrier()
#define PG8_SCHED __builtin_amdgcn_sched_barrier(0)
    Unit cur, nxt; int ui = 0;
    if (!S.next(0, cur)) return;
    f32x4 acc[2][2][4][2];
#pragma unroll
    for (int a = 0; a < 2; ++a)
#pragma unroll
        for (int b = 0; b < 2; ++b)
#pragma unroll
            for (int m = 0; m < 4; ++m)
#pragma unroll
                for (int n = 0; n < 2; ++n) acc[a][b][m][n] = (f32x4){0.f, 0.f, 0.f, 0.f};
    bf16x8 At[4][2], B0[2][2], B1[2][2];
    const char* cA = (const char*)g.A + (size_t)cur.pm * tstep; const char* cB = (const char*)g.Bt + (size_t)cur.pn * tstep;
    S.a_ready(cur);
    if constexpr (SP2) {
        PG8_STAGE(PG8_SB(0, 0), cB, voffB); PG8_STAGE(PG8_SB(0, 1), cB + hstep, voffB); PG8_STAGE(PG8_SA(0, 0), cA, voffA); PG8_STAGE(PG8_SA(0, 1), cA + hstep, voffA);
        if (wr == 1) PG8_BAR;
        PG8_WAIT_V(2); PG8_BAR;
        PG8_STAGE(PG8_SB(1, 0), cB + kstep, voffB); PG8_STAGE(PG8_SA(1, 0), cA + kstep, voffA); PG8_STAGE(PG8_SB(1, 1), cB + hstep + kstep, voffB);
        PG8_WAIT_V(6); PG8_BAR;
    } else {
        PG8_STAGE(PG8_SB(0, 0), cB, voffB); PG8_STAGE(PG8_SA(0, 0), cA, voffA); PG8_STAGE(PG8_SB(0, 1), cB + hstep, voffB); PG8_STAGE(PG8_SA(0, 1), cA + hstep, voffA);
        if (wr == 1) PG8_BAR;
        PG8_WAIT_V(4); PG8_BAR;
        PG8_STAGE(PG8_SB(1, 0), cB + kstep, voffB); PG8_STAGE(PG8_SA(1, 0), cA + kstep, voffA); PG8_STAGE(PG8_SB(1, 1), cB + hstep + kstep, voffB);
        PG8_WAIT_V(6); PG8_BAR;
    }
    for (;;) {
        const bool has_next = S.next(ui + 1, nxt);
        const char* nA = has_next ? (const char*)g.A + (size_t)nxt.pm * tstep : cA; const char* nB = has_next ? (const char*)g.Bt + (size_t)nxt.pn * tstep : cB;
        for (int t = 0; t < nt; t += 2) {
            const bool last = (t == nt - 2);
            const char* a1 = cA + (size_t)(t + 1) * kstep;
            const char* a2 = last ? nA : cA + (size_t)(t + 2) * kstep; const char* b2 = last ? nB : cB + (size_t)(t + 2) * kstep;
            const char* a3 = a2 + kstep; const char* b3 = b2 + kstep;
            if (last && has_next) S.a_ready(nxt);
            if constexpr (SP2) {
            PG8_LDB(B0, 0, 0); PG8_LDB(B1, 0, 1); PG8_SCHED; PG8_LDA(At, 0, 0); PG8_STAGE(PG8_SA(1, 1), a1 + hstep, voffA);
            PG8_WAIT_V(8); PG8_WAIT_L(0); PG8_BAR; PG8_MMA(0, 0, At, B0); PG8_MMA(0, 1, At, B1); PG8_BAR; PG8_SCHED;
            PG8_LDA(At, 0, 1); PG8_STAGE(PG8_SB(0, 0), b2, voffB); PG8_STAGE(PG8_SB(0, 1), b2 + hstep, voffB); PG8_STAGE(PG8_SA(0, 0), a2, voffA);
            PG8_WAIT_V(8); PG8_WAIT_L(0); PG8_BAR; PG8_MMA(1, 0, At, B0); PG8_MMA(1, 1, At, B1); PG8_BAR; PG8_SCHED;
            PG8_LDB(B0, 1, 0); PG8_LDB(B1, 1, 1); PG8_SCHED; PG8_LDA(At, 1, 0); PG8_STAGE(PG8_SA(0, 1), a2 + hstep, voffA);
            PG8_WAIT_V(8); PG8_WAIT_L(0); PG8_BAR; PG8_MMA(0, 0, At, B0); PG8_MMA(0, 1, At, B1); PG8_BAR; PG8_SCHED;
            PG8_LDA(At, 1, 1); PG8_STAGE(PG8_SB(1, 0), b3, voffB); PG8_STAGE(PG8_SB(1, 1), b3 + hstep, voffB); PG8_STAGE(PG8_SA(1, 0), a3, voffA);
            PG8_WAIT_V(8); PG8_WAIT_L(0); PG8_BAR; PG8_MMA(1, 0, At, B0); PG8_MMA(1, 1, At, B1); PG8_BAR; PG8_SCHED;
            } else {
            PG8_LDB(B0, 0, 0); PG8_SCHED; PG8_LDA(At, 0, 0); PG8_STAGE(PG8_SA(1, 1), a1 + hstep, voffA);
            PG8_WAIT_L(8); PG8_BAR; PG8_WAIT_L(0); PG8_MMA(0, 0, At, B0); PG8_BAR; PG8_SCHED;
            PG8_LDB(B1, 0, 1); PG8_STAGE(PG8_SB(0, 0), b2, voffB);
            PG8_BAR; PG8_WAIT_L(0); PG8_MMA(0, 1, At, B1); PG8_BAR;
            PG8_LDA(At, 0, 1); PG8_STAGE(PG8_SA(0, 0), a2, voffA);
            PG8_BAR; PG8_WAIT_L(0); PG8_MMA(1, 0, At, B0); PG8_BAR; PG8_SCHED;
            PG8_STAGE(PG8_SB(0, 1), b2 + hstep, voffB);
            PG8_WAIT_V(6); PG8_BAR; PG8_MMA(1, 1, At, B1); PG8_BAR;
            PG8_LDB(B0, 1, 0); PG8_SCHED; PG8_LDA(At, 1, 0); PG8_STAGE(PG8_SA(0, 1), a2 + hstep, voffA);
            PG8_WAIT_L(8); PG8_BAR; PG8_WAIT_L(0); PG8_MMA(0, 0, At, B0); PG8_BAR; PG8_SCHED;
            PG8_LDB(B1, 1, 1); PG8_STAGE(PG8_SB(1, 0), b3, voffB);
            PG8_BAR; PG8_WAIT_L(0); PG8_MMA(0, 1, At, B1); PG8_BAR;
            PG8_LDA(At, 1, 1); PG8_STAGE(PG8_SA(1, 0), a3, voffA);
            PG8_BAR; PG8_WAIT_L(0); PG8_MMA(1, 0, At, B0); PG8_BAR; PG8_SCHED;
            PG8_STAGE(PG8_SB(1, 1), b3 + hstep, voffB);
            PG8_WAIT_V(6); PG8_BAR; PG8_MMA(1, 1, At, B1); PG8_BAR;
            }
        }
        if constexpr (ALIGN_EPI) { if (wr == 0) PG8_BAR; }
        if constexpr (!Epi::AFTER_DRAIN) { E(acc, cur, wr, wc, fr, fq); S.done(cur); }
        if (!has_next) break;
#pragma unroll
        for (int a = 0; a < 2; ++a)
#pragma unroll
            for (int b = 0; b < 2; ++b)
#pragma unroll
                for (int m = 0; m < 4; ++m)
#pragma unroll
                    for (int n = 0; n < 2; ++n) acc[a][b][m][n] = (f32x4){0.f, 0.f, 0.f, 0.f};
        cur = nxt; cA = nA; cB = nB; ++ui;
        if constexpr (ALIGN_EPI) { if (wr == 1) PG8_BAR; }
    }
    PG8_WAIT_V(0);
    if constexpr (!ALIGN_EPI) { if (wr == 0) PG8_BAR; }
    PG8_BAR;
    if constexpr (Epi::AFTER_DRAIN) { E.fused(acc, cur, wr, wc, fr, fq, lds, wid, lane); S.done(cur); }
#undef PG8_SA
#undef PG8_SB
#undef PG8_STAGE
#undef PG8_LDA
#undef PG8_LDB
#undef PG8_MMA
#undef PG8_WAIT_V
#undef PG8_WAIT_L
#undef PG8_BAR
#undef PG8_SCHED
}
}

#define GAS __attribute__((address_space(1)))
#define LAS __attribute__((address_space(3)))
typedef unsigned short bf16;
typedef unsigned v4u __attribute__((ext_vector_type(4)));
typedef float f32x4 __attribute__((ext_vector_type(4)));
typedef short bf16x8 __attribute__((ext_vector_type(8)));
typedef GAS unsigned gu32;
typedef GAS unsigned long long gu64;
#define RLX_AGENT __ATOMIC_RELAXED, __HIP_MEMORY_SCOPE_AGENT
#define LDS_WAIT() asm volatile("s_waitcnt lgkmcnt(0)" ::: "memory")
#define VM_WAIT() asm volatile("s_waitcnt vmcnt(0)" ::: "memory")
__device__ __forceinline__ unsigned long long rt() { return __builtin_amdgcn_s_memrealtime(); }
__device__ __forceinline__ unsigned f2bf(float f) { unsigned u = __builtin_bit_cast(unsigned, f); return (u + 0x7fffu + ((u >> 16) & 1u)) >> 16; }
__device__ __forceinline__ unsigned pk2(float lo, float hi) { return f2bf(lo) | (f2bf(hi) << 16); }

#define XB_TMO      128
#define XB_XCNT(j)  (256  + 64 * (j))
#define XB_XSUB(j)  (1280 + 64 * (j))
#define XB_XGEN(j)  (2304 + 64 * (j))
#define XB_TOP      3328
#define XB_TOPGEN   3392
#define XCD_BAR_WORDS 3456
#define XB_SPIN_CAP (1u << 18)

__device__ __forceinline__ unsigned xb_ld(unsigned* p)              { return __hip_atomic_load(p, __ATOMIC_RELAXED, __HIP_MEMORY_SCOPE_AGENT); }
__device__ __forceinline__ unsigned xb_add(unsigned* p, unsigned v) { return __hip_atomic_fetch_add(p, v, __ATOMIC_RELAXED, __HIP_MEMORY_SCOPE_AGENT); }
__device__ __forceinline__ unsigned xb_xcc_id() { return (unsigned)__builtin_amdgcn_s_getreg((3 << 11) | 20) & 0xFu; }
#define XB_SPIN(cond, bar) do { unsigned _sp = 0; while (cond) { __builtin_amdgcn_s_sleep(1); \
    if ((++_sp & 255u) == 0u) { if (xb_ld(&(bar)[XB_TMO])) break; if (_sp > XB_SPIN_CAP) { atomicAdd(&(bar)[XB_TMO], 1u); break; } } } } while (0)

struct XcdBarrier {
    unsigned* bar; unsigned x;
    volatile LAS unsigned* st;
};

__device__ __forceinline__ XcdBarrier xcd_barrier_post(unsigned* bar, volatile LAS unsigned* st) {
    XcdBarrier b; b.bar = bar; b.x = xb_xcc_id(); b.st = st;
    if (threadIdx.x == 0) (void)xb_add(&bar[XB_XCNT(b.x)], 1u);
    return b;
}
__device__ __forceinline__ void xcd_barrier_complete(unsigned* bar, unsigned x, unsigned& nloc, unsigned& nx) {
    const unsigned G = gridDim.x * gridDim.y * gridDim.z;
    unsigned sum, cnt, mine, sp = 0u;
    for (;;) {
        sum = 0u; cnt = 0u; mine = 0u;
#pragma unroll
        for (unsigned j = 0; j < 16; ++j) { const unsigned c = xb_ld(&bar[XB_XCNT(j)]); sum += c; cnt += (c > 0u) ? 1u : 0u; mine = (j == x) ? c : mine; }
        if (sum == G) break;
        __builtin_amdgcn_s_sleep(1);
        if ((++sp & 255u) == 0u) { if (xb_ld(&bar[XB_TMO])) break; if (sp > XB_SPIN_CAP) { atomicAdd(&bar[XB_TMO], 1u); break; } }
    }
    nloc = mine > 0u ? mine : 1u; nx = cnt > 0u ? cnt : 1u;
}

__device__ __forceinline__ void xcd_barrier(const XcdBarrier& b, const bool leader  ) {
    asm volatile("s_waitcnt vmcnt(0)" ::: "memory");
    __syncthreads();
    if (leader) {
        unsigned* bar = b.bar;
        __builtin_amdgcn_s_waitcnt(0);
        unsigned nloc = b.st[0], nx = b.st[1];
        if (nloc == 0u) { xcd_barrier_complete(bar, b.x, nloc, nx); b.st[0] = nloc; b.st[1] = nx; }
        const unsigned old = xb_add(&bar[XB_XSUB(b.x)], 1u);
        const unsigned gen = old / nloc;
        if (old + 1u == (gen + 1u) * nloc) {
            __builtin_amdgcn_fence(__ATOMIC_RELEASE, "agent");
            asm volatile("s_waitcnt vmcnt(0)" ::: "memory");
            const unsigned og = xb_add(&bar[XB_TOP], 1u);
            const unsigned tg = og / nx;
            if (og + 1u == (tg + 1u) * nx) xb_add(&bar[XB_TOPGEN], 1u);
            else XB_SPIN(xb_ld(&bar[XB_TOPGEN]) == tg, bar);
            __builtin_amdgcn_fence(__ATOMIC_ACQUIRE, "agent");
            xb_add(&bar[XB_XGEN(b.x)], 1u);
            asm volatile("s_waitcnt vmcnt(0)" ::: "memory");
        } else {
            XB_SPIN(xb_ld(&bar[XB_XGEN(b.x)]) == gen, bar);
            __builtin_amdgcn_fence(__ATOMIC_ACQUIRE, "agent");
            asm volatile("s_waitcnt vmcnt(0)" ::: "memory");
        }
    }
    __syncthreads();
}
#ifndef REP_P0
#define REP_P0 1
#endif
#ifndef REP_P1
#define REP_P1 1
#endif
#ifndef REP_P2
#define REP_P2 1
#endif
#ifndef REP_P2A
#define REP_P2A 1
#endif
#ifndef REP_SEQ
#define REP_SEQ 1
#endif
#ifndef REP_DSW
#define REP_DSW 1
#endif
#ifndef REP_P3
#define REP_P3 1
#endif
#ifndef REP_P4
#define REP_P4 1
#endif
#ifndef REP_P5
#define REP_P5 1
#endif
#ifndef REP_P6
#define REP_P6 1
#endif
#ifndef REP_P7
#define REP_P7 1
#endif
constexpr int NWAVES = 8;
constexpr int T = 32768, D = 1024, SEQ = 4096;
constexpr int INC = 3328, INCP = 3328, INC_OLD = 3088;
constexpr int OFF_QA = 0, OFF_KA = 256, OFF_VA = 512, OFF_RA = 1024, OFF_LA = 1536, OFF_QB = 1792, OFF_KB = 2304, OFF_VB = 2816;
constexpr float EPS = 1e-6f;
constexpr size_t MiB = 1u << 20;
constexpr size_t WS_CTL = 0, CTL_ZERO_BYTES = 1 * MiB;
constexpr size_t WS_BT_IN = 2 * MiB, WS_BT_OUT = 10 * MiB, WS_BT_PQ = 12 * MiB, WS_BT_PG = 16 * MiB, WS_BT_PP = 18 * MiB;
constexpr size_t WS_ROPE = 20 * MiB, WS_SSQ1 = 22 * MiB, WS_RSTD2 = 24 * MiB, WS_KEYSB = 26 * MiB, WS_GDEC = 27 * MiB;
constexpr size_t WS_H1 = 32 * MiB;
constexpr size_t WS_PROJ = 96 * MiB;
constexpr size_t WS_QR = 96 * MiB, WS_SEL = 224 * MiB;
constexpr size_t WS_MIX = 304 * MiB;
constexpr size_t WS_PB = 368 * MiB;
constexpr size_t WS_PPROJ = 384 * MiB;
constexpr size_t WS_X2B = 304 * MiB;
constexpr size_t WS_UB = 448 * MiB, WS_VB = 464 * MiB;
constexpr size_t WS_GOG = 32 * MiB;
constexpr size_t WS_GQD = 368 * MiB;
constexpr size_t WS_GKV = 480 * MiB;
constexpr size_t WS_END = 512 * MiB;
constexpr int CW_BAR = 4096;
constexpr int CW_DSW = 16384;
constexpr int RING_OFF = 0, RING_BYTES = 131072;
constexpr int LDSCTL_OFF = RING_BYTES, MISC_OFF = LDSCTL_OFF + 320;
constexpr int LDS_BYTES = 147456;

__device__ __forceinline__ float bf2f(bf16 v) { return __uint_as_float(((unsigned)v) << 16); }
__device__ __forceinline__ float wave_sum(float v) {
    v += __int_as_float(__builtin_amdgcn_update_dpp(0, __float_as_int(v), 0xB1, 0xF, 0xF, true));
    v += __int_as_float(__builtin_amdgcn_update_dpp(0, __float_as_int(v), 0x4E, 0xF, 0xF, true));
    v += __int_as_float(__builtin_amdgcn_update_dpp(0, __float_as_int(v), 0x141, 0xF, 0xF, true));
    v += __int_as_float(__builtin_amdgcn_update_dpp(0, __float_as_int(v), 0x140, 0xF, 0xF, true));
    v += __int_as_float(__builtin_amdgcn_update_dpp(0, __float_as_int(v), 0x142, 0xA, 0xF, false));
    v += __int_as_float(__builtin_amdgcn_update_dpp(0, __float_as_int(v), 0x143, 0xC, 0xF, false));
    return __int_as_float(__builtin_amdgcn_readlane(__float_as_int(v), 63));
}
__device__ __forceinline__ float xshfl(float v, int srclane) { return __int_as_float(__builtin_amdgcn_ds_bpermute(srclane << 2, __float_as_int(v))); }
__device__ __forceinline__ int xshfl_i(int v, int srclane) { return __builtin_amdgcn_ds_bpermute(srclane << 2, v); }


typedef __bf16 bf16x2_t __attribute__((ext_vector_type(2)));
typedef int i32x2 __attribute__((ext_vector_type(2)));
typedef short s16x4 __attribute__((ext_vector_type(4)));
typedef float f32x2 __attribute__((ext_vector_type(2)));
typedef float f32x32 __attribute__((ext_vector_type(32)));
typedef __bf16 bf16x32 __attribute__((ext_vector_type(32)));
typedef unsigned u32x6 __attribute__((ext_vector_type(6)));
typedef unsigned u32x16 __attribute__((ext_vector_type(16)));
__device__ __forceinline__ unsigned enc6(float y) { const float q = fabsf(y) * 8.f; float c;
    if (q < 16.f) c = rintf(q); else if (q < 32.f) c = 16.f + rintf((q - 16.f) * 0.5f); else c = 24.f + rintf((q - 32.f) * 0.25f);
    c = fminf(c, 31.f); return (unsigned)c | ((__float_as_uint(y) >> 31) << 5); }
__device__ __forceinline__ unsigned enc4(float y) { const float a = fabsf(y);
    const unsigned c = (a > 0.25f) + (a > 0.75f) + (a > 1.25f) + (a > 1.75f) + (a > 2.5f) + (a > 3.5f) + (a > 5.0f); return c | ((__float_as_uint(y) >> 31) << 3); }
__device__ __forceinline__ unsigned cvtpk(float a, float b) { const f32x2 v = {a, b}; return __builtin_bit_cast(unsigned, __builtin_convertvector(v, bf16x2_t)); }
template <int CTRL> __device__ __forceinline__ float dpp_mov(float v) { return __int_as_float(__builtin_amdgcn_update_dpp(0, __float_as_int(v), CTRL, 0xF, 0xF, true)); }
__device__ __forceinline__ float row_sum16(float v) { v += dpp_mov<0xB1>(v); v += dpp_mov<0x4E>(v); v += dpp_mov<0x141>(v); v += dpp_mov<0x140>(v); return v; }
__device__ __forceinline__ float dot2bf(unsigned a, unsigned b, float c) { return __builtin_amdgcn_fdot2_f32_bf16(__builtin_bit_cast(bf16x2_t, a), __builtin_bit_cast(bf16x2_t, b), c, false); }
__device__ __forceinline__ float bflo(unsigned w) { return __uint_as_float(w << 16); }
__device__ __forceinline__ float bfhi(unsigned w) { return __uint_as_float(w & 0xffff0000u); }


__device__ __forceinline__ int f2key(float f) { const int b = __float_as_int(f); return b ^ ((b >> 31) & 0x7fffffff); }
__device__ __forceinline__ float key2f(int k) { return __int_as_float(k ^ ((k >> 31) & 0x7fffffff)); }
#define CE_DESC(a, b) { const int _hi = max((a), (b)), _lo = min((a), (b)); (a) = _hi; (b) = _lo; }
template <int N> __device__ __forceinline__ void bitonic_sort_desc(int (&v)[N]) {
#pragma unroll
    for (int k = 2; k <= N; k <<= 1)
#pragma unroll
        for (int j = k >> 1; j > 0; j >>= 1)
#pragma unroll
            for (int i = 0; i < N; ++i) { const int l = i ^ j; if (l > i) { if ((i & k) == 0) CE_DESC(v[i], v[l]) else CE_DESC(v[l], v[i]) } }
}
template <int N> __device__ __forceinline__ void bitonic_merge_desc(int (&v)[N]) {
#pragma unroll
    for (int j = N >> 1; j > 0; j >>= 1)
#pragma unroll
        for (int i = 0; i < N; ++i) { const int l = i ^ j; if (l > i) CE_DESC(v[i], v[l]) }
}
__device__ __forceinline__ void merge_top16(int (&a)[16], int srclane) {
    int b[16];
#pragma unroll
    for (int i = 0; i < 16; ++i) b[i] = __builtin_amdgcn_ds_bpermute(srclane << 2, a[i]);
#pragma unroll
    for (int i = 0; i < 16; ++i) a[i] = max(a[i], b[15 - i]);
    bitonic_merge_desc<16>(a);
}
struct CandTab { int i[64], j[64]; int n;
    constexpr CandTab() : i{}, j{}, n(0) { for (int a = 0; a < 16; ++a) for (int b = 0; b < 16; ++b) if ((a + 1) * (b + 1) <= 16) { i[n] = a; j[n] = b; ++n; } for (int q = n; q < 64; ++q) { i[q] = -1; j[q] = -1; } } };
constexpr CandTab kCand{};
static_assert(kCand.n == 50, "50 product-key candidates can reach the top 16");

__device__ __forceinline__ float max_x16(float x) { const auto r = __builtin_amdgcn_permlane16_swap(__float_as_uint(x), __float_as_uint(x), false, false); return fmaxf(__uint_as_float(r[0]), __uint_as_float(r[1])); }
__device__ __forceinline__ float max_x32(float x) { const auto r = __builtin_amdgcn_permlane32_swap(__float_as_uint(x), __float_as_uint(x), false, false); return fmaxf(__uint_as_float(r[0]), __uint_as_float(r[1])); }
__device__ __forceinline__ float add_x16(float x) { const auto r = __builtin_amdgcn_permlane16_swap(__float_as_uint(x), __float_as_uint(x), false, false); return __uint_as_float(r[0]) + __uint_as_float(r[1]); }
__device__ __forceinline__ float add_x32(float x) { const auto r = __builtin_amdgcn_permlane32_swap(__float_as_uint(x), __float_as_uint(x), false, false); return __uint_as_float(r[0]) + __uint_as_float(r[1]); }

__device__ __forceinline__ void p0_transpose_item(const float* W, int K, int ldw, int src0, int ncols, const float* gain, bf16* WT, int dst0, int nblk, LAS float* scr, int item, int lane) {
    const int kb = item / nblk, nb = item % nblk, k0 = 64 * kb, n0 = 32 * nb;
    const int n = n0 + (lane & 31);
#pragma unroll 8
    for (int i = 0; i < 32; ++i) { const int kk = 2 * i + (lane >> 5); float v = 0.f; if (n < ncols) { v = W[(size_t)(k0 + kk) * ldw + src0 + n]; if (gain) v *= gain[k0 + kk]; } scr[kk * 33 + (lane & 31)] = v; }
    LDS_WAIT(); asm volatile("" ::: "memory");
    const int c = lane & 7;
#pragma unroll
    for (int j = 0; j < 4; ++j) { const int nn = (lane >> 3) + 8 * j; const LAS float* s = scr + (8 * c) * 33 + nn;
        v4u o; o.x = pk2(s[0 * 33], s[1 * 33]); o.y = pk2(s[2 * 33], s[3 * 33]); o.z = pk2(s[4 * 33], s[5 * 33]); o.w = pk2(s[6 * 33], s[7 * 33]);
        *(GAS v4u*)(WT + (size_t)(dst0 + n0 + nn) * K + k0 + 8 * c) = o; }
    LDS_WAIT(); asm volatile("" ::: "memory");
}

struct Args { const float* in[18]; float* outp; unsigned char* ws; };

#define xin      (args.in[0])
#define p_in     (args.in[1])
#define positions ((const int*)args.in[2])
#define g_mix    (args.in[3])
#define w_in     (args.in[4])
#define w_up     (args.in[5])
#define b_gate   (args.in[6])
#define g_gla    (args.in[7])
#define w_out    (args.in[8])
#define g_peer   (args.in[9])
#define w_pq     (args.in[10])
#define skeys    (args.in[11])
#define pu       (args.in[12])
#define pv       (args.in[13])
#define g_ple    (args.in[14])
#define w_pg     (args.in[15])
#define w_pp     (args.in[16])
#define g_final  (args.in[17])
#define out      (args.outp)
#define Bt_in    ((bf16*)(args.ws + WS_BT_IN))
#define Bt_out   ((bf16*)(args.ws + WS_BT_OUT))
#define Bt_pq    ((bf16*)(args.ws + WS_BT_PQ))
#define Bt_pg    ((bf16*)(args.ws + WS_BT_PG))
#define Bt_pp    ((bf16*)(args.ws + WS_BT_PP))
#define rope     ((float*)(args.ws + WS_ROPE))
#define ssq1     ((float*)(args.ws + WS_SSQ1))
#define rstd2    ((float*)(args.ws + WS_RSTD2))
#define h1       ((bf16*)(args.ws + WS_H1))
#define x1b      ((bf16*)(args.ws + WS_H1))
#define proj     ((bf16*)(args.ws + WS_PROJ))
#define qr       ((bf16*)(args.ws + WS_QR))
#define sel2     ((i32x2*)(args.ws + WS_SEL))
#define Ub       ((unsigned char*)(args.ws + WS_UB))
#define Vb       ((unsigned char*)(args.ws + WS_VB))
#define keysb    ((bf16*)(args.ws + WS_KEYSB))
#define mix      ((bf16*)(args.ws + WS_MIX))
#define pb       ((bf16*)(args.ws + WS_PB))
#define pproj    ((bf16*)(args.ws + WS_PPROJ))
#define x2b      ((bf16*)(args.ws + WS_X2B))


__global__ void __launch_bounds__(NWAVES * 64, 2) mk_fwd(Args args) {
    extern __shared__ __attribute__((aligned(16))) unsigned char lds[];
    LAS unsigned char* const L = (LAS unsigned char*)lds;
    volatile LAS unsigned* const MISC = (volatile LAS unsigned*)(L + MISC_OFF);
    const int wave = __builtin_amdgcn_readfirstlane((int)threadIdx.x >> 6);
#define LANE_DECL int lane; asm volatile("v_mbcnt_lo_u32_b32 %0, -1, 0\n\tv_mbcnt_hi_u32_b32 %0, -1, %0" : "=v"(lane))
    const int G = gridDim.x; const int bx = blockIdx.x;
    const int vcu = (G % 8 == 0) ? (bx % 8) * (G / 8) + bx / 8 : bx;
    const int gw = vcu * NWAVES + wave, NGW = G * NWAVES;
    gu32* const ctl = (gu32*)(args.ws + WS_CTL);
    for (int u = threadIdx.x; u < (LDS_BYTES - LDSCTL_OFF) / 4; u += NWAVES * 64) ((LAS unsigned*)(L + LDSCTL_OFF))[u] = 0u;
    __syncthreads();
    XcdBarrier bar = xcd_barrier_post((unsigned*)(ctl + CW_BAR), MISC + 8);

    for (int rep_ = 0; rep_ < REP_P0; ++rep_) {
        LANE_DECL;
        LAS float* scr = (LAS float*)(L + RING_OFF + wave * 16384);
        constexpr int I_INA = 16 * 48, I_INB = 16 * 48, I_OUT = 16 * 32, I_PQ = 16 * 64, I_PG = 16 * 32, I_PP = 4 * 32;
        constexpr int NITEMS = I_INA + I_INB + I_OUT + I_PQ + I_PG + I_PP;
        for (int it = gw; it < NITEMS; it += NGW) {
            int r = it;
            if (r < I_INA) { p0_transpose_item(w_in, 1024, INC_OLD, 0, 1536, nullptr, Bt_in, 0, 48, scr, r, lane); continue; } r -= I_INA;
            if (r < I_INB) { p0_transpose_item(w_in, 1024, INC_OLD, 1552, 1536, nullptr, Bt_in, 1792, 48, scr, r, lane); continue; } r -= I_INB;
            if (r < I_OUT) { p0_transpose_item(w_out, 1024, 1024, 0, 1024, nullptr, Bt_out, 0, 32, scr, r, lane); continue; } r -= I_OUT;
            if (r < I_PQ) { p0_transpose_item(w_pq, 1024, 2048, 0, 2048, g_peer, Bt_pq, 0, 64, scr, r, lane); continue; } r -= I_PQ;
            if (r < I_PG) { p0_transpose_item(w_pg, 1024, 1024, 0, 1024, g_ple, Bt_pg, 0, 32, scr, r, lane); continue; } r -= I_PG;
            p0_transpose_item(w_pp, 256, 1024, 0, 1024, nullptr, Bt_pp, 0, 32, scr, r, lane);
        }
        for (int i = gw * 64 + lane; i < 256 * 128; i += NGW * 64) {
            const int n = i >> 7, k0 = (i & 127) * 8;
            float wu[16];
#pragma unroll
            for (int r = 0; r < 16; ++r) wu[r] = w_up[r * 256 + n];
            float o8[8];
#pragma unroll
            for (int kk = 0; kk < 8; ++kk) { const GAS f32x4* wr4 = (const GAS f32x4*)(w_in + (size_t)(k0 + kk) * INC_OLD + 1536); float a = 0.f;
#pragma unroll
                for (int q = 0; q < 4; ++q) { const f32x4 w4 = wr4[q]; a += w4.x * wu[4 * q] + w4.y * wu[4 * q + 1] + w4.z * wu[4 * q + 2] + w4.w * wu[4 * q + 3]; }
                o8[kk] = a; }
            v4u o; o.x = pk2(o8[0], o8[1]); o.y = pk2(o8[2], o8[3]); o.z = pk2(o8[4], o8[5]); o.w = pk2(o8[6], o8[7]);
            *(GAS v4u*)(Bt_in + (size_t)(1536 + n) * 1024 + k0) = o;
        }
        for (int row = gw; row < T; row += NGW) {
            const GAS f32x4* xr = (const GAS f32x4*)(xin + (size_t)row * D) + lane;
            f32x4 v[4]; float s = 0.f;
#pragma unroll
            for (int j = 0; j < 4; ++j) { v[j] = xr[64 * j]; s += (v[j].x * v[j].x + v[j].y * v[j].y) + (v[j].z * v[j].z + v[j].w * v[j].w); }
            const float rstd = rsqrtf(wave_sum(s) * (1.f / D) + EPS);
            GAS unsigned long long* o8 = (GAS unsigned long long*)(h1 + (size_t)row * D) + lane;
#pragma unroll
            for (int j = 0; j < 4; ++j) { const f32x4 gg = ((const GAS f32x4*)g_mix)[64 * j + lane];
                o8[64 * j] = (unsigned long long)pk2(v[j].x * rstd * gg.x, v[j].y * rstd * gg.y) | ((unsigned long long)pk2(v[j].z * rstd * gg.z, v[j].w * rstd * gg.w) << 32); }
        }
        for (size_t i = (size_t)gw * 64 + lane; i < (size_t)T * 256 / 4; i += (size_t)NGW * 64) {
            const f32x4 v = ((const GAS f32x4*)p_in)[i];
            ((GAS unsigned long long*)pb)[i] = (unsigned long long)pk2(v.x, v.y) | ((unsigned long long)pk2(v.z, v.w) << 32);
        }
        for (int i = gw * 64 + lane; i < 16384 * 16 * 2; i += NGW * 64) {
            const int tab = i >> 18, row = (i >> 4) & 16383, li = i & 15;
            const float* src = (tab ? pv : pu) + (size_t)row * D;
            const float scl = tab ? 4.f : 64.f;
            unsigned dw[12];
#pragma unroll
            for (int q = 0; q < 12; ++q) dw[q] = 0u;
#pragma unroll
            for (int j = 0; j < 4; ++j)
#pragma unroll
                for (int e4 = 0; e4 < 4; ++e4) {
                    f32x4 v = ((const GAS f32x4*)(src + 256 * j + 16 * li))[e4];
                    if (!tab) v = v * ((const GAS f32x4*)(g_peer + 256 * j + 16 * li))[e4];
                    v = v * scl;
#pragma unroll
                    for (int e = 0; e < 4; ++e) {
                        const int k = (j & 1) * 16 + e4 * 4 + e, grp = j >> 1;
                        if (!tab) { const int bit = 6 * k, w = bit >> 5, sh = bit & 31; const unsigned c = enc6(v[e]); dw[grp * 6 + w] |= c << sh; if (sh > 26) dw[grp * 6 + w + 1] |= c >> (32 - sh); }
                        else dw[grp * 4 + (k >> 3)] |= enc4(v[e]) << (4 * (k & 7));
                    }
                }
            if (!tab) { GAS v4u* dst = (GAS v4u*)(Ub + (size_t)row * 768) + li;
                v4u o0, o1, o2; o0.x = dw[0]; o0.y = dw[1]; o0.z = dw[2]; o0.w = dw[3]; o1.x = dw[4]; o1.y = dw[5]; o1.z = dw[6]; o1.w = dw[7]; o2.x = dw[8]; o2.y = dw[9]; o2.z = dw[10]; o2.w = dw[11];
                dst[0] = o0; dst[16] = o1; dst[32] = o2; }
            else { GAS v4u* dst = (GAS v4u*)(Vb + (size_t)row * 512) + li;
                v4u o0, o1; o0.x = dw[0]; o0.y = dw[1]; o0.z = dw[2]; o0.w = dw[3]; o1.x = dw[4]; o1.y = dw[5]; o1.z = dw[6]; o1.w = dw[7];
                dst[0] = o0; dst[16] = o1; }
        }
        for (int i = gw * 64 + lane; i < 16 * 128 * 128 / 4; i += NGW * 64) {
            const f32x4 v = ((const GAS f32x4*)skeys)[i];
            ((GAS unsigned long long*)keysb)[i] = (unsigned long long)pk2(v.x, v.y) | ((unsigned long long)pk2(v.z, v.w) << 32);
        }
        for (int i = gw * 64 + lane; i < T * 8; i += NGW * 64) {
            const int t = i >> 3, j = i & 7;
            const float inv_freq = powf(500000.0f, -(float)j / 8.0f);
            const float ang = (float)positions[t] * inv_freq;
            rope[2 * i] = cosf(ang); rope[2 * i + 1] = sinf(ang);
        }
    }
    { LANE_DECL; xcd_barrier(bar, wave == 0 && lane == 0); }

    for (int rep_ = 0; rep_ < REP_P1; ++rep_) {
        pg8::Gemm g{h1, Bt_in, T, INCP, D}; pg8::StaticOrder S; S.init(T, INCP, G, bx);
        pg8::EpiInProj E{proj, rope, b_gate};
        pg8::gemm_phase<pg8::EpiInProj, pg8::StaticOrder, true, true>(L + RING_OFF, g, S, E, wave);
        pg8::Gemm g2{pb, Bt_pp, T, D, 256}; pg8::StaticOrder S2; S2.init(T, D, G, bx);
        pg8::EpiBf16<0> E2{pproj, D, nullptr, 0, 0, 1.f};
        pg8::gemm_phase<pg8::EpiBf16<0>, pg8::StaticOrder, true, true>(L + RING_OFF, g2, S2, E2, wave);
    }
    { LANE_DECL; xcd_barrier(bar, wave == 0 && lane == 0); }

    {
        LANE_DECL;
        const int fr = lane & 15, g = lane >> 4;
        constexpr int RS = 144;
        LAS unsigned char* const qd = L + RING_OFF;
        LAS unsigned char* const kd = qd + 64 * RS;
        LAS unsigned char* const keT = kd + 64 * RS;
        LAS unsigned char* const vT = keT + 64 * RS;
        LAS unsigned char* const Am = vT + 128 * RS;
        LAS float* const dec = (LAS float*)(Am + 64 * RS);
        for (int i = wave * 64 + lane; i < 64 * RS / 4; i += NWAVES * 64) ((LAS unsigned*)Am)[i] = 0u;
        __syncthreads();
        for (int rep4_ = 0; rep4_ < REP_P2A; ++rep4_) {
        int u = bx;
        const bf16* prow = proj + (size_t)((u >> 6) * 64 + lane) * INC + 0;
        v4u lav, qv, kv, vv0, vv1;
        {
            const int hh = (u >> 6) & 3, t0 = (u >> 8) * SEQ + (u & 63) * 64;
            prow = proj + (size_t)(t0 + lane) * INC;
            lav = *(const GAS v4u*)(prow + OFF_LA + hh * 64 + 8 * wave); qv = *(const GAS v4u*)(prow + OFF_QA + hh * 64 + 8 * wave); kv = *(const GAS v4u*)(prow + OFF_KA + hh * 64 + 8 * wave);
            vv0 = *(const GAS v4u*)(prow + OFF_VA + hh * 128 + 16 * wave); vv1 = *(const GAS v4u*)(prow + OFF_VA + hh * 128 + 16 * wave + 8);
        }
        for (; u < 2048; u += G) {
            const int h = (u >> 6) & 3, t0 = (u >> 8) * SEQ + (u & 63) * 64;
            float laf[8];
            laf[0] = bflo(lav.x); laf[1] = bfhi(lav.x); laf[2] = bflo(lav.y); laf[3] = bfhi(lav.y); laf[4] = bflo(lav.z); laf[5] = bfhi(lav.z); laf[6] = bflo(lav.w); laf[7] = bfhi(lav.w);
            float qf[8], kf[8];
            qf[0] = bflo(qv.x); qf[1] = bfhi(qv.x); qf[2] = bflo(qv.y); qf[3] = bfhi(qv.y); qf[4] = bflo(qv.z); qf[5] = bfhi(qv.z); qf[6] = bflo(qv.w); qf[7] = bfhi(qv.w);
            kf[0] = bflo(kv.x); kf[1] = bfhi(kv.x); kf[2] = bflo(kv.y); kf[3] = bfhi(kv.y); kf[4] = bflo(kv.z); kf[5] = bfhi(kv.z); kf[6] = bflo(kv.w); kf[7] = bfhi(kv.w);
            float qdv[8], kdv[8], kev[8];
#pragma unroll
            for (int c = 0; c < 8; ++c) {
                float bsum = laf[c];
                bsum += __int_as_float(__builtin_amdgcn_update_dpp(0, __float_as_int(bsum), 0x111, 0xF, 0xF, false));
                bsum += __int_as_float(__builtin_amdgcn_update_dpp(0, __float_as_int(bsum), 0x112, 0xF, 0xF, false));
                bsum += __int_as_float(__builtin_amdgcn_update_dpp(0, __float_as_int(bsum), 0x114, 0xF, 0xF, false));
                bsum += __int_as_float(__builtin_amdgcn_update_dpp(0, __float_as_int(bsum), 0x118, 0xF, 0xF, false));
                bsum += __int_as_float(__builtin_amdgcn_update_dpp(0, __float_as_int(bsum), 0x142, 0xA, 0xF, false));
                bsum += __int_as_float(__builtin_amdgcn_update_dpp(0, __float_as_int(bsum), 0x143, 0xC, 0xF, false));
                const float blast = __int_as_float(__builtin_amdgcn_readlane(__float_as_int(bsum), 63));
                qdv[c] = qf[c] * 0.125f * __expf(bsum);
                kdv[c] = kf[c] * __expf(-bsum);
                kev[c] = kf[c] * __expf(blast - bsum);
                if (lane == 0) dec[8 * wave + c] = __expf(blast);
            }
#pragma unroll
            for (int c = 0; c < 8; c += 2) { const unsigned w2 = cvtpk(kev[c], kev[c + 1]);
                *(LAS bf16*)(keT + (8 * wave + c) * RS + lane * 2) = (bf16)(w2 & 0xffffu); *(LAS bf16*)(keT + (8 * wave + c + 1) * RS + lane * 2) = (bf16)(w2 >> 16); }
            { v4u o; o.x = cvtpk(qdv[0], qdv[1]); o.y = cvtpk(qdv[2], qdv[3]); o.z = cvtpk(qdv[4], qdv[5]); o.w = cvtpk(qdv[6], qdv[7]); *(LAS v4u*)(qd + lane * RS + 16 * wave) = o;
              v4u o2; o2.x = cvtpk(kdv[0], kdv[1]); o2.y = cvtpk(kdv[2], kdv[3]); o2.z = cvtpk(kdv[4], kdv[5]); o2.w = cvtpk(kdv[6], kdv[7]); *(LAS v4u*)(kd + lane * RS + 16 * wave) = o2; }
            {
                const unsigned vw[8] = {vv0.x, vv0.y, vv0.z, vv0.w, vv1.x, vv1.y, vv1.z, vv1.w};
#pragma unroll
                for (int e = 0; e < 8; ++e) { *(LAS bf16*)(vT + (16 * wave + 2 * e) * RS + lane * 2) = (bf16)(vw[e] & 0xffffu); *(LAS bf16*)(vT + (16 * wave + 2 * e + 1) * RS + lane * 2) = (bf16)(vw[e] >> 16); }
            }
            if (u + G < 2048) {
                const int un = u + G, hn = (un >> 6) & 3, tn = (un >> 8) * SEQ + (un & 63) * 64;
                const bf16* pn = proj + (size_t)(tn + lane) * INC;
                lav = *(const GAS v4u*)(pn + OFF_LA + hn * 64 + 8 * wave); qv = *(const GAS v4u*)(pn + OFF_QA + hn * 64 + 8 * wave); kv = *(const GAS v4u*)(pn + OFF_KA + hn * 64 + 8 * wave);
                vv0 = *(const GAS v4u*)(pn + OFF_VA + hn * 128 + 16 * wave); vv1 = *(const GAS v4u*)(pn + OFF_VA + hn * 128 + 16 * wave + 8);
            }
            unsigned long long rav[4];
#pragma unroll
            for (int tt = 0; tt < 4; ++tt) rav[tt] = *(const GAS unsigned long long*)(proj + (size_t)(t0 + 16 * tt + fr) * INC + OFF_RA + h * 128 + 16 * wave + 4 * g);
            const f32x4 ggl = *(const GAS f32x4*)(g_gla + h * 128 + 16 * wave + 4 * g);
            LDS_WAIT(); __syncthreads();
#pragma unroll
            for (int rep = 0; rep < 2; ++rep) {
                const int ti = wave + 8 * rep;
                if (ti < 10) {
                    const int tt = (ti >= 6) ? 3 : ((ti >= 3) ? 2 : ((ti >= 1) ? 1 : 0));
                    const int tk = ti - ((tt * (tt + 1)) >> 1);
                    f32x4 acc = {0.f, 0.f, 0.f, 0.f};
#pragma unroll
                    for (int ks = 0; ks < 2; ++ks) { const bf16x8 a = *(const LAS bf16x8*)(qd + (16 * tt + fr) * RS + (32 * ks + 8 * g) * 2), bb = *(const LAS bf16x8*)(kd + (16 * tk + fr) * RS + (32 * ks + 8 * g) * 2);
                        acc = __builtin_amdgcn_mfma_f32_16x16x32_bf16(a, bb, acc, 0, 0, 0); }
#pragma unroll
                    for (int r = 0; r < 4; ++r) { const int tq = 16 * tt + 4 * g + r, tc = 16 * tk + fr; *(LAS bf16*)(Am + tq * RS + tc * 2) = (bf16)f2bf(tq >= tc ? acc[r] : 0.f); }
                }
            }
            {
                const int tt = wave >> 1, ks = wave & 1;
                const unsigned long long lo = *(const LAS unsigned long long*)(qd + (16 * tt + fr) * RS + (32 * ks + 4 * g) * 2), hi = *(const LAS unsigned long long*)(qd + (16 * tt + fr) * RS + (32 * ks + 16 + 4 * g) * 2);
                v4u w; w.x = (unsigned)lo; w.y = (unsigned)(lo >> 32); w.z = (unsigned)hi; w.w = (unsigned)(hi >> 32);
                ((GAS v4u*)(args.ws + WS_GQD))[((size_t)u * 8 + wave) * 64 + lane] = w;
                if (wave == 0) ((GAS float*)(args.ws + WS_GDEC))[(size_t)u * 64 + lane] = dec[lane];
            }
            LDS_WAIT(); __syncthreads();
            bf16x8 vb[2];
#pragma unroll
            for (int ks = 0; ks < 2; ++ks) vb[ks] = *(const LAS bf16x8*)(vT + (16 * wave + fr) * RS + (32 * ks + 8 * g) * 2);
#pragma unroll
            for (int tt = 0; tt < 4; ++tt) {
                f32x4 acc = {0.f, 0.f, 0.f, 0.f};
#pragma unroll
                for (int ks = 0; ks < 2; ++ks) { const bf16x8 a = *(const LAS bf16x8*)(Am + (16 * tt + fr) * RS + (32 * ks + 8 * g) * 2); acc = __builtin_amdgcn_mfma_f32_16x16x32_bf16(vb[ks], a, acc, 0, 0, 0); }
                const unsigned rlo = (unsigned)rav[tt], rhi = (unsigned)(rav[tt] >> 32);
                const float rr[4] = {bflo(rlo), bfhi(rlo), bflo(rhi), bfhi(rhi)};
                v4u w;
#pragma unroll
                for (int r = 0; r < 4; ++r) { const float gate = ggl[r] * rr[r] * __builtin_amdgcn_rcpf(1.f + __expf(-rr[r])); w[r] = cvtpk(acc[r], gate); }
                ((GAS v4u*)(args.ws + WS_GOG))[(((size_t)u * 8 + wave) * 4 + tt) * 64 + lane] = w;
            }
#pragma unroll
            for (int dt = 0; dt < 4; ++dt) {
                f32x4 acc = {0.f, 0.f, 0.f, 0.f};
#pragma unroll
                for (int ks = 0; ks < 2; ++ks) { const bf16x8 a = *(const LAS bf16x8*)(keT + (16 * dt + fr) * RS + (32 * ks + 8 * g) * 2); acc = __builtin_amdgcn_mfma_f32_16x16x32_bf16(a, vb[ks], acc, 0, 0, 0); }
                const unsigned long long w = (unsigned long long)cvtpk(acc[0], acc[1]) | ((unsigned long long)cvtpk(acc[2], acc[3]) << 32);
                ((GAS unsigned long long*)(args.ws + WS_GKV))[(((size_t)u * 8 + wave) * 4 + dt) * 64 + lane] = w;
            }
            LDS_WAIT(); __syncthreads();
        }
        }
    }
    { LANE_DECL; xcd_barrier(bar, wave == 0 && lane == 0); }

    for (int rep_ = 0; rep_ < REP_P2; ++rep_) {
    for (int rep3_ = 0; rep3_ < REP_SEQ; ++rep3_)
    if (bx < 32) {
        LANE_DECL;
        const int fr = lane & 15, g = lane >> 4;
        const int b = bx >> 2, h = bx & 3;
        LAS float* const ssqb = (LAS float*)(L + RING_OFF);
        LAS float* const rstdl = ssqb + 1024 + wave * 64;
        f32x4 S[4];
#pragma unroll
        for (int dt = 0; dt < 4; ++dt) S[dt] = (f32x4){0.f, 0.f, 0.f, 0.f};
        const GAS v4u* const gog = (const GAS v4u*)(args.ws + WS_GOG);
        const GAS unsigned long long* const gkv = (const GAS unsigned long long*)(args.ws + WS_GKV);
        const GAS v4u* const gqd = (const GAS v4u*)(args.ws + WS_GQD);
        const GAS f32x4* const gdec = (const GAS f32x4*)(args.ws + WS_GDEC);
        const int u0 = bx * 64;
        v4u ogA[4], ogB[4]; unsigned long long kvA[4], kvB[4]; v4u qdA[8], qdB[8]; f32x4 dcA[4], dcB[4];
#define GLA_LOAD(og_, kv_, qd_, dc_, uu) do { const size_t u_ = (size_t)(uu); \
        _Pragma("unroll") for (int q = 0; q < 4; ++q) { og_[q] = gog[((u_ * 8 + wave) * 4 + q) * 64 + lane]; kv_[q] = gkv[((u_ * 8 + wave) * 4 + q) * 64 + lane]; dc_[q] = gdec[u_ * 16 + 4 * q + g]; } \
        _Pragma("unroll") for (int q = 0; q < 8; ++q) qd_[q] = gqd[(u_ * 8 + q) * 64 + lane]; } while (0)
#define GLA_STEP(og_, kv_, qd_, dc_, n_) do { \
            const int t0 = b * SEQ + (n_) * 64; \
            bf16x8 sa[2];                                                   \
            _Pragma("unroll") for (int ks = 0; ks < 2; ++ks) { v4u w; w.x = cvtpk(S[2 * ks][0], S[2 * ks][1]); w.y = cvtpk(S[2 * ks][2], S[2 * ks][3]); w.z = cvtpk(S[2 * ks + 1][0], S[2 * ks + 1][1]); w.w = cvtpk(S[2 * ks + 1][2], S[2 * ks + 1][3]); sa[ks] = __builtin_bit_cast(bf16x8, w); } \
            f32x4 o[4]; f32x4 gt[4];                                        \
            _Pragma("unroll") for (int tt = 0; tt < 4; ++tt) { \
                f32x4 acc; \
                _Pragma("unroll") for (int r = 0; r < 4; ++r) { acc[r] = bflo(og_[tt][r]); gt[tt][r] = bfhi(og_[tt][r]); } \
                _Pragma("unroll") for (int ks = 0; ks < 2; ++ks) acc = __builtin_amdgcn_mfma_f32_16x16x32_bf16(sa[ks], __builtin_bit_cast(bf16x8, qd_[2 * tt + ks]), acc, 0, 0, 0); \
                o[tt] = acc; } \
            _Pragma("unroll") for (int dt = 0; dt < 4; ++dt) { const unsigned lo = (unsigned)kv_[dt], hi = (unsigned)(kv_[dt] >> 32); \
                S[dt][0] = S[dt][0] * dc_[dt][0] + bflo(lo); S[dt][1] = S[dt][1] * dc_[dt][1] + bfhi(lo); S[dt][2] = S[dt][2] * dc_[dt][2] + bflo(hi); S[dt][3] = S[dt][3] * dc_[dt][3] + bfhi(hi); } \
            LAS float* const sq = ssqb + ((n_) & 1) * 512; \
            _Pragma("unroll") for (int tt = 0; tt < 4; ++tt) { float s2 = (o[tt][0] * o[tt][0] + o[tt][1] * o[tt][1]) + (o[tt][2] * o[tt][2] + o[tt][3] * o[tt][3]); s2 = add_x32(add_x16(s2)); if (g == 0) sq[wave * 64 + 16 * tt + fr] = s2; } \
            LDS_WAIT(); __syncthreads(); \
            { float tot = 0.f; \
              _Pragma("unroll") for (int w2 = 0; w2 < 8; ++w2) tot += sq[w2 * 64 + lane]; \
              rstdl[lane] = __builtin_amdgcn_rsqf(tot * (1.f / 128.f) + EPS); } \
            LDS_WAIT(); asm volatile("" ::: "memory"); \
            _Pragma("unroll") for (int tt = 0; tt < 4; ++tt) { \
                const float rs = rstdl[16 * tt + fr]; \
                const unsigned long long w = (unsigned long long)cvtpk(o[tt][0] * rs * gt[tt][0], o[tt][1] * rs * gt[tt][1]) | ((unsigned long long)cvtpk(o[tt][2] * rs * gt[tt][2], o[tt][3] * rs * gt[tt][3]) << 32); \
                *(GAS unsigned long long*)(mix + (size_t)(t0 + 16 * tt + fr) * D + h * 128 + 16 * wave + 4 * g) = w; } \
            LDS_WAIT(); asm volatile("" ::: "memory"); } while (0)
        GLA_LOAD(ogA, kvA, qdA, dcA, u0);
        for (int n = 0; n < 64; n += 2) {
            GLA_LOAD(ogB, kvB, qdB, dcB, u0 + n + 1);
            GLA_STEP(ogA, kvA, qdA, dcA, n);
            if (n + 2 < 64) GLA_LOAD(ogA, kvA, qdA, dcA, u0 + n + 2);
            GLA_STEP(ogB, kvB, qdB, dcB, n + 1);
        }
#undef GLA_LOAD
#undef GLA_STEP
        __syncthreads();
    }
    for (int rep2_ = 0; rep2_ < REP_DSW; ++rep2_)
    {
        LANE_DECL;
        const int fr = lane & 15, g = lane >> 4;
        constexpr int OROW = 68;
        LAS float* const Ob = (LAS float*)(L + RING_OFF);
        constexpr int VROW = 160;
        LAS unsigned char* const Vst = L + RING_OFF + 256 * OROW * 4 + wave * (32 * VROW);
        volatile LAS int* const ubox = (volatile LAS int*)(L + MISC_OFF + 64);
        const float C2 = 0.125f * 1.4426950408889634f;
        for (;;) {
            if (wave == 0 && lane == 0) ubox[0] = (int)__hip_atomic_fetch_add(ctl + CW_DSW + 64 * (rep_ * 4 + rep2_), 1u, __ATOMIC_RELAXED, __HIP_MEMORY_SCOPE_AGENT);
            __syncthreads();
            const int unit = __builtin_amdgcn_readfirstlane(ubox[0]);
            if (unit >= 1024) break;
            const int sp = unit & 15, h = (unit >> 4) & 7, b = unit >> 7;
            const int s0 = sp * 256;
            const bf16* const base = proj + (size_t)b * SEQ * INC;
#pragma unroll 1
            for (int pt = 0; pt < 3; ++pt) {
                const int dl = (pt == 0) ? 0 : ((pt == 1) ? 2 : 4), d = 1 << dl;
#pragma unroll 1
                for (int rep = 0; rep < 2; ++rep) {
                    const int qt = wave + 8 * rep;
                    const int rr = qt & (d - 1), jj = qt >> dl;
                    const int tq0 = s0 + rr + ((16 * jj) << dl);
                    const int tkb = tq0 - (128 << dl);
                    bf16x8 qf[2];
#pragma unroll
                    for (int ks = 0; ks < 2; ++ks) qf[ks] = *(const GAS bf16x8*)(base + (size_t)(tq0 + (fr << dl)) * INC + OFF_QB + h * 64 + 32 * ks + 8 * g);
                    f32x4 O[4];
#pragma unroll
                    for (int dvt = 0; dvt < 4; ++dvt) O[dvt] = (f32x4){0.f, 0.f, 0.f, 0.f};
                    float m = -INFINITY, l = 0.f;
                    int cmin = 0;
                    while (tkb + ((32 * cmin + 31) << dl) < 0) ++cmin;
                    bf16x8 kfA[2][2], kfB[2][2]; v4u vrA[4], vrB[4];
#define DSW_LOAD(kf_, vr_, c_) do { const int k0_ = 32 * (c_); \
                        _Pragma("unroll") for (int kt = 0; kt < 2; ++kt) { int tk = tkb + ((k0_ + 16 * kt + fr) << dl); tk = tk < 0 ? 0 : (tk > SEQ - 1 ? SEQ - 1 : tk); \
                            _Pragma("unroll") for (int ks = 0; ks < 2; ++ks) kf_[kt][ks] = *(const GAS bf16x8*)(base + (size_t)tk * INC + OFF_KB + h * 64 + 32 * ks + 8 * g); } \
                        _Pragma("unroll") for (int it = 0; it < 4; ++it) { const int pc = lane + 64 * it, key = pc >> 3, ch = pc & 7; int tk = tkb + ((k0_ + key) << dl); tk = tk < 0 ? 0 : (tk > SEQ - 1 ? SEQ - 1 : tk); \
                            vr_[it] = *(const GAS v4u*)(base + (size_t)tk * INC + OFF_VB + h * 64 + 8 * ch); } } while (0)
#define DSW_STEP(kf_, vr_, c_) do { const int k0 = 32 * (c_); \
                        _Pragma("unroll") for (int it = 0; it < 4; ++it) { const int pc = lane + 64 * it, key = pc >> 3, ch = pc & 7; *(LAS v4u*)(Vst + key * VROW + ch * 16) = vr_[it]; } \
                        f32x4 sc[2]; \
                        _Pragma("unroll") for (int kt = 0; kt < 2; ++kt) { f32x4 acc = {0.f, 0.f, 0.f, 0.f}; \
                            _Pragma("unroll") for (int ks = 0; ks < 2; ++ks) acc = __builtin_amdgcn_mfma_f32_16x16x32_bf16(kf_[kt][ks], qf[ks], acc, 0, 0, 0); \
                            sc[kt] = acc; } \
                        float sv[8]; float cmax = -INFINITY; \
                        _Pragma("unroll") for (int kt = 0; kt < 2; ++kt) \
                            _Pragma("unroll") for (int r = 0; r < 4; ++r) { const int kk = k0 + 16 * kt + 4 * g + r; const bool ok = (kk >= fr) & (kk <= fr + 128) & (tkb + (kk << dl) >= 0); \
                                const float v = ok ? sc[kt][r] * C2 : -INFINITY; sv[4 * kt + r] = v; cmax = fmaxf(cmax, v); } \
                        cmax = max_x32(max_x16(cmax)); \
                        const float mn = fmaxf(m, cmax);                    \
                        const float alpha = __builtin_amdgcn_exp2f(m - mn); \
                        float pex[8]; float ps = 0.f; \
                        _Pragma("unroll") for (int e = 0; e < 8; ++e) { pex[e] = __builtin_amdgcn_exp2f(sv[e] - mn); ps += pex[e]; } \
                        l = l * alpha + ps; m = mn; \
                        v4u pw; pw.x = cvtpk(pex[0], pex[1]); pw.y = cvtpk(pex[2], pex[3]); pw.z = cvtpk(pex[4], pex[5]); pw.w = cvtpk(pex[6], pex[7]); \
                        const bf16x8 pb8 = __builtin_bit_cast(bf16x8, pw); \
                        LDS_WAIT(); asm volatile("" ::: "memory"); \
                        _Pragma("unroll") for (int dvt = 0; dvt < 4; ++dvt) { \
                            const s16x4 lo = __builtin_amdgcn_ds_read_tr16_b64_v4i16((LAS s16x4*)(Vst + (4 * g + (fr >> 2)) * VROW + (16 * dvt + 4 * (fr & 3)) * 2)); \
                            const s16x4 hi = __builtin_amdgcn_ds_read_tr16_b64_v4i16((LAS s16x4*)(Vst + (16 + 4 * g + (fr >> 2)) * VROW + (16 * dvt + 4 * (fr & 3)) * 2)); \
                            bf16x8 va; va[0] = lo[0]; va[1] = lo[1]; va[2] = lo[2]; va[3] = lo[3]; va[4] = hi[0]; va[5] = hi[1]; va[6] = hi[2]; va[7] = hi[3]; \
                            O[dvt] = __builtin_amdgcn_mfma_f32_16x16x32_bf16(va, pb8, O[dvt] * alpha, 0, 0, 0); } \
                        LDS_WAIT(); asm volatile("" ::: "memory");         \
                    } while (0)
                    DSW_LOAD(kfA, vrA, 4);
                    if (3 >= cmin) DSW_LOAD(kfB, vrB, 3);
                    DSW_STEP(kfA, vrA, 4);
                    if (3 >= cmin) {
                        if (2 >= cmin) DSW_LOAD(kfA, vrA, 2);
                        DSW_STEP(kfB, vrB, 3);
                        if (2 >= cmin) {
                            if (1 >= cmin) DSW_LOAD(kfB, vrB, 1);
                            DSW_STEP(kfA, vrA, 2);
                            if (1 >= cmin) {
                                if (0 >= cmin) DSW_LOAD(kfA, vrA, 0);
                                DSW_STEP(kfB, vrB, 1);
                                if (0 >= cmin) DSW_STEP(kfA, vrA, 0);
                            }
                        }
                    }
#undef DSW_LOAD
#undef DSW_STEP
                    l = add_x32(add_x16(l));
                    const int row = (tq0 - s0) + (fr << dl);
                    LAS float* orow = Ob + row * OROW;
                    if (pt > 0) {
                        const float m1 = orow[64], l1 = orow[65];
                        const float mn = fmaxf(m, m1), a0 = __builtin_amdgcn_exp2f(m - mn), a1 = __builtin_amdgcn_exp2f(m1 - mn);
#pragma unroll
                        for (int dvt = 0; dvt < 4; ++dvt) { const f32x4 o1 = *(const LAS f32x4*)(orow + 16 * dvt + 4 * g); O[dvt] = O[dvt] * a0 + o1 * a1; }
                        l = l * a0 + l1 * a1; m = mn;
                    }
                    if (pt < 2) {
#pragma unroll
                        for (int dvt = 0; dvt < 4; ++dvt) *(LAS f32x4*)(orow + 16 * dvt + 4 * g) = O[dvt];
                        if (g == 0) { orow[64] = m; orow[65] = l; }
                    } else {
                        const float rl = 1.f / l;
#pragma unroll
                        for (int dvt = 0; dvt < 4; ++dvt) { const unsigned long long w = (unsigned long long)pk2(O[dvt][0] * rl, O[dvt][1] * rl) | ((unsigned long long)pk2(O[dvt][2] * rl, O[dvt][3] * rl) << 32);
                            *(GAS unsigned long long*)(mix + (size_t)(b * SEQ + s0 + row) * D + 512 + h * 64 + 16 * dvt + 4 * g) = w; }
                    }
                }
                LDS_WAIT(); __syncthreads();
            }
        }
    }
    }
    { LANE_DECL; xcd_barrier(bar, wave == 0 && lane == 0); }

    for (int rep_ = 0; rep_ < REP_P3; ++rep_) {
        pg8::Gemm g{mix, Bt_out, T, D, D}; pg8::StaticOrder S; S.init(T, D, G, bx);
        pg8::EpiOutProj E{xin, x1b, ssq1};
        pg8::gemm_phase<pg8::EpiOutProj, pg8::StaticOrder, true, true>(L + RING_OFF, g, S, E, wave);
    }
    { LANE_DECL; xcd_barrier(bar, wave == 0 && lane == 0); }

    for (int rep_ = 0; rep_ < REP_P4; ++rep_) {
        pg8::Gemm g{x1b, Bt_pq, T, 2048, D}; pg8::StaticOrder S; S.init(T, 2048, G, bx);
        pg8::EpiPeerQ E{qr, ssq1};
        pg8::gemm_phase<pg8::EpiPeerQ, pg8::StaticOrder, true, true>(L + RING_OFF, g, S, E, wave);
    }
    { LANE_DECL; xcd_barrier(bar, wave == 0 && lane == 0); }

    for (int rep_ = 0; rep_ < REP_P5; ++rep_) {
        LANE_DECL;
        const int fr = lane & 15, g = lane >> 4;
        constexpr int KROW = 272;
        const int h = bx & 7, nbh = G >> 3;
        {
            const GAS v4u* src = (const GAS v4u*)(keysb + (size_t)h * 2 * 128 * 128);
            for (int pc = wave * 64 + lane; pc < 4096; pc += NWAVES * 64) { const int R = pc >> 4, ch = pc & 15; *(LAS v4u*)(L + RING_OFF + R * KROW + ch * 16) = src[pc]; }
        }
        LAS int* const scr = (LAS int*)(L + RING_OFF + 256 * KROW + wave * (16 * 33 * 4));
        __syncthreads();
        for (int tg = (bx >> 3) * NWAVES + wave; tg < T / 16; tg += nbh * NWAVES) {
            const int tok0 = tg * 16;
            int top[2][16];
#pragma unroll
            for (int c = 0; c < 2; ++c) {
                bf16x8 bq[4];
#pragma unroll
                for (int ks = 0; ks < 4; ++ks) bq[ks] = *(const GAS bf16x8*)(qr + (size_t)(tok0 + fr) * 2048 + h * 256 + c * 128 + 32 * ks + 8 * g);
                int v[32];
#pragma unroll
                for (int tl = 0; tl < 8; ++tl) {
                    f32x4 acc = {0.f, 0.f, 0.f, 0.f};
#pragma unroll
                    for (int ks = 0; ks < 4; ++ks) { const bf16x8 a = *(const LAS bf16x8*)(L + RING_OFF + (c * 128 + 16 * tl + fr) * KROW + (32 * ks + 8 * g) * 2);
                        acc = __builtin_amdgcn_mfma_f32_16x16x32_bf16(a, bq[ks], acc, 0, 0, 0); }
#pragma unroll
                    for (int r = 0; r < 4; ++r) v[4 * tl + r] = (f2key(acc[r]) & ~0x7f) | (16 * tl + 4 * g + r);
                }
                bitonic_sort_desc<32>(v);
#pragma unroll
                for (int i = 0; i < 16; ++i) top[c][i] = v[i];
                merge_top16(top[c], lane ^ 16);
                merge_top16(top[c], lane ^ 32);
            }
            float fa[16], fb[16];
#pragma unroll
            for (int i = 0; i < 16; ++i) { fa[i] = key2f(top[0][i]); fb[i] = key2f(top[1][i]); }
            int cand[16];
#pragma unroll
            for (int sl = 0; sl < 16; ++sl) {
                int cv[4];
#pragma unroll
                for (int gg = 0; gg < 4; ++gg) { constexpr int NEG = (int)0x80000000;
                    const int n = 16 * gg + sl;
                    if (kCand.i[n] >= 0) cv[gg] = (f2key(fa[kCand.i[n] < 0 ? 0 : kCand.i[n]] + fb[kCand.j[n] < 0 ? 0 : kCand.j[n]]) & ~0xff) | (kCand.i[n] * 16 + kCand.j[n]); else cv[gg] = NEG; }
                cand[sl] = (g == 0) ? cv[0] : ((g == 1) ? cv[1] : ((g == 2) ? cv[2] : cv[3]));
            }
            bitonic_sort_desc<16>(cand);
            merge_top16(cand, lane ^ 16);
            merge_top16(cand, lane ^ 32);
#pragma unroll
            for (int i = 0; i < 16; ++i) { if (g == (i >> 3)) scr[fr * 33 + i] = top[0][i] & 0x7f; if (g == 2 + (i >> 3)) scr[fr * 33 + 16 + i] = top[1][i] & 0x7f; }
            float ex[16]; float den = 0.f; const float m0 = key2f(cand[0]);
#pragma unroll
            for (int r = 0; r < 16; ++r) { ex[r] = __expf(key2f(cand[r]) - m0); den += ex[r]; }
            const float rden = 1.f / den;
            LDS_WAIT(); asm volatile("" ::: "memory");
            int oi[4]; float og[4];
#pragma unroll
            for (int q = 0; q < 4; ++q) {
                const int kq = (g == 0) ? cand[q] : ((g == 1) ? cand[4 + q] : ((g == 2) ? cand[8 + q] : cand[12 + q]));
                const float eq = (g == 0) ? ex[q] : ((g == 1) ? ex[4 + q] : ((g == 2) ? ex[8 + q] : ex[12 + q]));
                const int code = kq & 0xff;
                oi[q] = scr[fr * 33 + (code >> 4)] * 128 + scr[fr * 33 + 16 + (code & 15)]; og[q] = eq * rden;
            }
            GAS v4u* op = (GAS v4u*)(sel2 + (size_t)(tok0 + fr) * 128 + h * 16 + 4 * g);
            v4u o0, o1; o0.x = (unsigned)oi[0]; o0.y = __float_as_uint(og[0]); o0.z = (unsigned)oi[1]; o0.w = __float_as_uint(og[1]);
            o1.x = (unsigned)oi[2]; o1.y = __float_as_uint(og[2]); o1.z = (unsigned)oi[3]; o1.w = __float_as_uint(og[3]);
            op[0] = o0; op[1] = o1;
            LDS_WAIT(); asm volatile("" ::: "memory");
        }
        __syncthreads();
    }
    { LANE_DECL; xcd_barrier(bar, wave == 0 && lane == 0); }

    for (int rep_ = 0; rep_ < REP_P6; ++rep_) {
        LANE_DECL;
        const int g4 = lane >> 4, li = lane & 15;
        LAS i32x2* const selw = (LAS i32x2*)(L + RING_OFF + wave * 1024);
        for (int tok = gw; tok < T; tok += NGW) {
            const float s1 = (lane < 16) ? ssq1[(size_t)lane * T + tok] : 0.f;
            const float rstd1 = rsqrtf(wave_sum(s1) * (1.f / D) + EPS);
            v4u xw[8];
#pragma unroll
            for (int j = 0; j < 4; ++j) { xw[2 * j] = ((const GAS v4u*)(x1b + (size_t)tok * D))[32 * j + 2 * li]; xw[2 * j + 1] = ((const GAS v4u*)(x1b + (size_t)tok * D))[32 * j + 2 * li + 1]; }
            float acc[64];
#pragma unroll
            for (int k = 0; k < 64; ++k) acc[k] = 0.f;
            {
                const GAS i32x2* selg = (const GAS i32x2*)sel2 + (size_t)tok * 128;
                const i32x2 p0 = selg[lane], p1 = selg[lane + 64];
                const int b0 = p0.x >> 9, b1 = p1.x >> 9;
                const unsigned long long lt = (1ull << lane) - 1ull;
                int base = 0, r0 = 0, r1 = 0;
#pragma unroll
                for (int bk = 0; bk < 32; ++bk) {
                    const unsigned long long m0 = __ballot(b0 == bk), m1 = __ballot(b1 == bk);
                    const int c0 = __popcll(m0), c1 = __popcll(m1);
                    if (b0 == bk) r0 = base + __popcll(m0 & lt);
                    if (b1 == bk) r1 = base + c0 + __popcll(m1 & lt);
                    base += c0 + c1;
                }
                selw[r0] = p0; selw[r1] = p1;
                LDS_WAIT(); asm volatile("" ::: "memory");
            }
            const float ascale = rstd1 * (1.f / 64.f);
            i32x2 cur = selw[g4];
            for (int it = 0; it < 32; ++it) {
                const i32x2 nxt = selw[((it < 31) ? 4 * (it + 1) : 0) + g4];
                const GAS v4u* up = (const GAS v4u*)(Ub + (size_t)cur.x * 768) + li;
                const GAS v4u* vp = (const GAS v4u*)(Vb + (size_t)cur.x * 512) + li;
                const v4u u0 = up[0], u1 = up[16], u2 = up[32], v0 = vp[0], v1 = vp[16];
                float s = 0.f;
                { const u32x6 ga = {u0.x, u0.y, u0.z, u0.w, u1.x, u1.y};
                  const u32x16 d = __builtin_bit_cast(u32x16, __builtin_amdgcn_cvt_scalef32_pk32_bf16_fp6(ga, 1.0f));
#pragma unroll
                  for (int k = 0; k < 16; ++k) s = dot2bf(xw[k >> 2][k & 3], d[k], s); }
                { const u32x6 gb = {u1.z, u1.w, u2.x, u2.y, u2.z, u2.w};
                  const u32x16 d = __builtin_bit_cast(u32x16, __builtin_amdgcn_cvt_scalef32_pk32_bf16_fp6(gb, 1.0f));
#pragma unroll
                  for (int k = 0; k < 16; ++k) s = dot2bf(xw[4 + (k >> 2)][k & 3], d[k], s); }
                s = row_sum16(s);
                const float a = s * ascale;
                const float act = 0.5f * a * (1.f + erff(a * 0.70710678118654752f)) * __int_as_float(cur.y) * 0.25f;
#define PG_V4(bsel) { const f32x2 fa = __builtin_amdgcn_cvt_scalef32_pk_f32_fp4(v0[w], 1.0f, bsel), fb = __builtin_amdgcn_cvt_scalef32_pk_f32_fp4(v1[w], 1.0f, bsel); \
                        acc[8 * w + 2 * bsel] += act * fa.x; acc[8 * w + 2 * bsel + 1] += act * fa.y; acc[32 + 8 * w + 2 * bsel] += act * fb.x; acc[32 + 8 * w + 2 * bsel + 1] += act * fb.y; }
#pragma unroll
                for (int w = 0; w < 4; ++w) { PG_V4(0) PG_V4(1) PG_V4(2) PG_V4(3) }
#undef PG_V4
                cur = nxt;
            }
            float s2 = 0.f;
#pragma unroll
            for (int j = 0; j < 4; ++j) {
                float r[16];
#pragma unroll
                for (int e = 0; e < 16; ++e) { float v = acc[16 * j + e]; v += xshfl(v, lane ^ 16); v += xshfl(v, lane ^ 32);
                    const unsigned xwd = xw[2 * j + (e >> 3)][(e >> 1) & 3]; r[e] = v + ((e & 1) ? bfhi(xwd) : bflo(xwd)); s2 += r[e] * r[e]; }
                if (g4 == j) { v4u o0, o1; o0.x = pk2(r[0], r[1]); o0.y = pk2(r[2], r[3]); o0.z = pk2(r[4], r[5]); o0.w = pk2(r[6], r[7]); o1.x = pk2(r[8], r[9]); o1.y = pk2(r[10], r[11]); o1.z = pk2(r[12], r[13]); o1.w = pk2(r[14], r[15]);
                    ((GAS v4u*)(x2b + (size_t)tok * D))[32 * j + 2 * li] = o0; ((GAS v4u*)(x2b + (size_t)tok * D))[32 * j + 2 * li + 1] = o1; }
            }
            s2 = row_sum16(s2);
            if (lane == 0) rstd2[tok] = rsqrtf(s2 * (1.f / D) + EPS);
            LDS_WAIT(); asm volatile("" ::: "memory");
        }
    }
    { LANE_DECL; xcd_barrier(bar, wave == 0 && lane == 0); }

    for (int rep_ = 0; rep_ < REP_P7; ++rep_) {
        pg8::Gemm g{x2b, Bt_pg, T, D, D}; pg8::StaticOrder S; S.init(T, D, G, bx);
        pg8::EpiPle E{x2b, pproj, rstd2, out};
        pg8::gemm_phase<pg8::EpiPle, pg8::StaticOrder, true, true>(L + RING_OFF, g, S, E, wave);
    }
    { LANE_DECL; xcd_barrier(bar, wave == 0 && lane == 0); }

    {
    LANE_DECL;
    for (int row = gw; row < T; row += NGW) {
        GAS f32x4* xr = (GAS f32x4*)(out + (size_t)row * D) + lane;
        f32x4 v[4]; float s = 0.f;
#pragma unroll
        for (int j = 0; j < 4; ++j) { v[j] = xr[64 * j]; s += (v[j].x * v[j].x + v[j].y * v[j].y) + (v[j].z * v[j].z + v[j].w * v[j].w); }
        const float rstd = rsqrtf(wave_sum(s) * (1.f / D) + EPS);
#pragma unroll
        for (int j = 0; j < 4; ++j) { const f32x4 gg = ((const GAS f32x4*)g_final)[64 * j + lane]; f32x4 o; o.x = v[j].x * rstd * gg.x; o.y = v[j].y * rstd * gg.y; o.z = v[j].z * rstd * gg.z; o.w = v[j].w * rstd * gg.w; xr[64 * j] = o; }
    }
    }
}

#undef xin
#undef p_in
#undef positions
#undef g_mix
#undef w_in
#undef w_up
#undef b_gate
#undef g_gla
#undef w_out
#undef g_peer
#undef w_pq
#undef skeys
#undef pu
#undef pv
#undef g_ple
#undef w_pg
#undef w_pp
#undef g_final
#undef out
#undef Bt_in
#undef Bt_out
#undef Bt_pq
#undef Bt_pg
#undef Bt_pp
#undef rope
#undef ssq1
#undef rstd2
#undef h1
#undef x1b
#undef proj
#undef qr
#undef sel2
#undef Ub
#undef Vb
#undef keysb
#undef mix
#undef pb
#undef pproj
#undef x2b
extern "C" void kernel_launch(void* const* d_in, const int* in_sizes, int n_in, void* d_out, int out_size, void* d_ws, size_t ws_size, hipStream_t stream) {
    static int grid = 0;
    if (grid == 0) {
        if (n_in != 18 || out_size != T * D || ws_size < WS_END) { fprintf(stderr, "kernel_launch: unexpected shapes n_in %d out %d ws %zu\n", n_in, out_size, ws_size); grid = -1; return; }
        int dev = 0, cus = 0, per_cu = 0;
        if (hipGetDevice(&dev) != hipSuccess || hipDeviceGetAttribute(&cus, hipDeviceAttributeMultiprocessorCount, dev) != hipSuccess) { grid = -1; return; }
        if (hipFuncSetAttribute((const void*)mk_fwd, hipFuncAttributeMaxDynamicSharedMemorySize, LDS_BYTES) != hipSuccess) { fprintf(stderr, "kernel_launch: hipFuncSetAttribute failed\n"); grid = -1; return; }
        if (hipOccupancyMaxActiveBlocksPerMultiprocessor(&per_cu, (const void*)mk_fwd, NWAVES * 64, LDS_BYTES) != hipSuccess || per_cu < 1) fprintf(stderr, "kernel_launch: occupancy query reports %d\n", per_cu);
        (void)hipGetLastError();
        grid = cus;
    }
    if (grid < 0) return;
    if (hipMemsetAsync((char*)d_ws + WS_CTL, 0, CTL_ZERO_BYTES, stream) != hipSuccess) return;
    Args a{};
    for (int i = 0; i < 18; ++i) a.in[i] = (const float*)d_in[i];
    a.outp = (float*)d_out; a.ws = (unsigned char*)d_ws;
    hipLaunchKernelGGL(mk_fwd, dim3(grid), dim3(NWAVES * 64), LDS_BYTES, stream, a);
}
```

```cpp
#include <hip/hip_runtime.h>
#include <cstdio>
#include <cstdint>
namespace pg8 {
#define PG8_LAS __attribute__((address_space(3)))
typedef unsigned short bf16_t;
typedef short bf16x8 __attribute__((ext_vector_type(8)));
typedef float f32x4 __attribute__((ext_vector_type(4)));
typedef unsigned u32x4 __attribute__((ext_vector_type(4)));
constexpr int BM = 256, BK = 64, HALF = 128, HTB = HALF * BK * 2  , STAGE_BYTES = 8 * HTB, NXCD = 8, WGM = 8;

__host__ __device__ __forceinline__ int lds_byte(int r, int c) { const int st = (r >> 4) * 2 + (c >> 5), rr = r & 15, cc = c & 31, ob = rr * 64 + cc * 2; return st * 1024 + (ob ^ (((ob >> 9) & 1) << 5)); }
__host__ __device__ __forceinline__ void stage_rc(int b, int& R, int& C) { const int st = b / 1024, sb = b % 1024, swz = sb ^ (((sb >> 9) & 1) << 5); R = (st >> 1) * 16 + swz / 64; C = (st & 1) * 32 + (swz % 64) / 2; }
__host__ __device__ __forceinline__ int perm32(int rho) { const int n = rho >> 4, i = rho & 15; return 8 * (i >> 2) + 4 * n + (i & 3); }

struct Unit { int pm, pn; };
struct Gemm { const bf16_t* A; const bf16_t* Bt; int M, N, K; };

struct StaticOrder {
    int nM, nN, nwg, G, c;
    __host__ __device__ void init(int M, int N, int G_, int c_) { nM = M / BM; nN = N / BM; nwg = nM * nN; G = G_; c = c_; }
    __host__ __device__ bool next(int i, Unit& u) const {
        const long L = (long)i * G + c; if (L >= nwg) return false;
        int wgid = (int)L; { const int q = nwg / NXCD, r = nwg % NXCD, xcd = wgid % NXCD, off = wgid / NXCD; wgid = (xcd < r ? xcd * (q + 1) : r * (q + 1) + (xcd - r) * q) + off; }
        const int nig = WGM * nN, gid = wgid / nig, fm = gid * WGM, gsz = (nM - fm) < WGM ? (nM - fm) : WGM;
        u.pm = fm + ((wgid % nig) % gsz); u.pn = (wgid % nig) / gsz; return true;
    }
    __device__ __forceinline__ void a_ready(const Unit&) const {}
    __device__ __forceinline__ void done(const Unit&) const {}
};

__device__ __forceinline__ unsigned cvt_pk_bf16(float lo, float hi) { unsigned r; asm volatile("v_cvt_pk_bf16_f32 %0, %1, %2" : "=v"(r) : "v"(lo), "v"(hi)); return r; }
typedef float f32x2 __attribute__((ext_vector_type(2)));
__device__ __forceinline__ f32x2 gelu_pk(f32x2 v) {
    const f32x2 av = __builtin_elementwise_abs(v), d = av * 0.2316418882f + 1.0f;
    f32x2 t; t.x = __builtin_amdgcn_rcpf(d.x); t.y = __builtin_amdgcn_rcpf(d.y);
    f32x2 q = t * 0.5307027145f + (-0.7265760135f); q = q * t + 0.7107068705f; q = q * t + (-0.142248368f); q = q * t + 0.127414796f; q = q * t;
    const f32x2 s = (v * v) * (-0.72134752044f);
    f32x2 e; e.x = __builtin_amdgcn_exp2f(s.x); e.y = __builtin_amdgcn_exp2f(s.y);
    const f32x2 m = v * (q * e), r = v - m;
    f32x2 o; o.x = v.x < 0.f ? m.x : r.x; o.y = v.y < 0.f ? m.y : r.y; return o;
}

template <int ACT  > struct EpiBf16 {
    static constexpr bool PERM = true, AFTER_DRAIN = false; static_assert(ACT == 0 || ACT == 1, "EpiBf16: ACT is 0 (none) or 1 (gelu_pk)");
    bf16_t* O; int ldc; const float* bias; int split_cols; size_t split_stride; float scale0;
    __device__ __forceinline__ void operator()(const f32x4 (&acc)[2][2][4][2], const Unit& u, int wr, int wc, int fr, int fq) const {
        const int row0 = u.pm * BM + wr * 64 + fr; int colt = u.pn * BM; bf16_t* base = O;
        float sc = 1.f; if (split_cols) { const int t = colt / split_cols; base += (size_t)t * split_stride; colt -= t * split_cols; if (t == 0) sc = scale0; }
        const int col0 = colt + wc * 32 + 8 * fq, bcol0 = u.pn * BM + wc * 32 + 8 * fq;
        f32x4 bv[2][2];
#pragma unroll
        for (int bj = 0; bj < 2; ++bj)
#pragma unroll
            for (int n = 0; n < 2; ++n) bv[bj][n] = bias ? *(const f32x4*)(bias + bcol0 + bj * HALF + 4 * n) : (f32x4){0.f, 0.f, 0.f, 0.f};
#pragma unroll
        for (int ai = 0; ai < 2; ++ai)
#pragma unroll
            for (int m = 0; m < 4; ++m) { bf16_t* rowp = base + (size_t)(row0 + ai * HALF + m * 16) * ldc + col0;
#pragma unroll
                for (int bj = 0; bj < 2; ++bj) { f32x4 v0 = acc[ai][bj][m][0] + bv[bj][0], v1 = acc[ai][bj][m][1] + bv[bj][1];
                    if (ACT == 1) { f32x2 a = gelu_pk((f32x2){v0[0], v0[1]}), b = gelu_pk((f32x2){v0[2], v0[3]}), c = gelu_pk((f32x2){v1[0], v1[1]}), d = gelu_pk((f32x2){v1[2], v1[3]});
                        v0 = (f32x4){a.x, a.y, b.x, b.y}; v1 = (f32x4){c.x, c.y, d.x, d.y}; }
                    v0 = v0 * sc; v1 = v1 * sc; u32x4 w; w.x = cvt_pk_bf16(v0[0], v0[1]); w.y = cvt_pk_bf16(v0[2], v0[3]); w.z = cvt_pk_bf16(v1[0], v1[1]); w.w = cvt_pk_bf16(v1[2], v1[3]);
                    *(u32x4*)(rowp + bj * HALF) = w; } }
    }
};

__device__ __forceinline__ float xshfl(float v, int srclane) { return __int_as_float(__builtin_amdgcn_ds_bpermute(srclane << 2, __float_as_int(v))); }
constexpr int P_INC = 3328;
struct EpiInProj {
    static constexpr bool PERM = true, AFTER_DRAIN = false;
    bf16_t* O; const float* rope; const float* bgate;
    __device__ __forceinline__ void operator()(const f32x4 (&acc)[2][2][4][2], const Unit& u, int wr, int wc, int fr, int fq) const {
        const int row0 = u.pm * BM + wr * 64 + fr;
#pragma unroll
        for (int bj = 0; bj < 2; ++bj) {
            const int cb = u.pn * BM + bj * HALF + wc * 32;
            const int c0 = cb + 8 * fq;
            const bool ropechunk = (cb >= 1792) && (cb < 2816) && ((cb & 63) == 0);
            const bool lachunk = (cb >= 1536) && (cb < 1792);
            f32x4 bg0 = {0.f, 0.f, 0.f, 0.f}, bg1 = {0.f, 0.f, 0.f, 0.f};
            if (lachunk) { bg0 = *(const f32x4*)(bgate + c0 - 1536); bg1 = *(const f32x4*)(bgate + c0 - 1536 + 4); }
#pragma unroll
            for (int ai = 0; ai < 2; ++ai)
#pragma unroll
                for (int m = 0; m < 4; ++m) {
                    const int row = row0 + ai * HALF + m * 16;
                    f32x4 v0 = acc[ai][bj][m][0], v1 = acc[ai][bj][m][1];
                    if (lachunk) {
#pragma unroll
                        for (int e = 0; e < 4; ++e) { const float z0 = v0[e] + bg0[e], z1 = v1[e] + bg1[e];
                            v0[e] = (fminf(z0, 0.f) - __logf(1.f + __expf(-fabsf(z0)))) * (1.f / 16.f); v1[e] = (fminf(z1, 0.f) - __logf(1.f + __expf(-fabsf(z1)))) * (1.f / 16.f); }
                    }
                    if (ropechunk) {
                        f32x4 p0, p1;
#pragma unroll
                        for (int e = 0; e < 4; ++e) { p0[e] = xshfl(v0[e], (fq * 16 + fr) ^ 16); p1[e] = xshfl(v1[e], (fq * 16 + fr) ^ 16); }
                        if (fq < 2) {
                            const f32x4* cs = (const f32x4*)(rope + (size_t)row * 16);
                            const f32x4 t0 = cs[0], t1 = cs[1], t2 = cs[2], t3 = cs[3];
                            const float sg = (fq == 0) ? -1.f : 1.f;
                            v0[0] = v0[0] * t0[0] + sg * p0[0] * t0[1]; v0[1] = v0[1] * t0[2] + sg * p0[1] * t0[3];
                            v0[2] = v0[2] * t1[0] + sg * p0[2] * t1[1]; v0[3] = v0[3] * t1[2] + sg * p0[3] * t1[3];
                            v1[0] = v1[0] * t2[0] + sg * p1[0] * t2[1]; v1[1] = v1[1] * t2[2] + sg * p1[1] * t2[3];
                            v1[2] = v1[2] * t3[0] + sg * p1[2] * t3[1]; v1[3] = v1[3] * t3[2] + sg * p1[3] * t3[3];
                        }
                    }
                    { u32x4 w; w.x = cvt_pk_bf16(v0[0], v0[1]); w.y = cvt_pk_bf16(v0[2], v0[3]); w.z = cvt_pk_bf16(v1[0], v1[1]); w.w = cvt_pk_bf16(v1[2], v1[3]);
                        *(u32x4*)(O + (size_t)row * P_INC + c0) = w; }
                }
        }
    }
};
struct EpiOutProj {
    static constexpr bool PERM = true, AFTER_DRAIN = false;
    const float* X; bf16_t* O; float* ssq;
    __device__ __forceinline__ void operator()(const f32x4 (&acc)[2][2][4][2], const Unit& u, int wr, int wc, int fr, int fq) const {
        const int row0 = u.pm * BM + wr * 64 + fr, col0 = u.pn * BM + wc * 32 + 8 * fq;
#pragma unroll
        for (int ai = 0; ai < 2; ++ai)
#pragma unroll
            for (int m = 0; m < 4; ++m) {
                const int row = row0 + ai * HALF + m * 16; float s = 0.f;
#pragma unroll
                for (int bj = 0; bj < 2; ++bj) {
                    const float* xp = X + (size_t)row * 1024 + col0 + bj * HALF;
                    const f32x4 x0 = *(const f32x4*)xp, x1 = *(const f32x4*)(xp + 4);
                    const f32x4 v0 = acc[ai][bj][m][0] + x0, v1 = acc[ai][bj][m][1] + x1;
                    s += (v0[0] * v0[0] + v0[1] * v0[1]) + (v0[2] * v0[2] + v0[3] * v0[3]) + (v1[0] * v1[0] + v1[1] * v1[1]) + (v1[2] * v1[2] + v1[3] * v1[3]);
                    u32x4 w; w.x = cvt_pk_bf16(v0[0], v0[1]); w.y = cvt_pk_bf16(v0[2], v0[3]); w.z = cvt_pk_bf16(v1[0], v1[1]); w.w = cvt_pk_bf16(v1[2], v1[3]);
                    *(u32x4*)(O + (size_t)row * 1024 + col0 + bj * HALF) = w;
                }
                s += xshfl(s, (fq * 16 + fr) ^ 16); s += xshfl(s, (fq * 16 + fr) ^ 32);
                if (fq == 0) ssq[(size_t)(u.pn * 4 + wc) * 32768 + row] = s;
            }
    }
};
struct EpiPeerQ {
    static constexpr bool PERM = true, AFTER_DRAIN = false;
    bf16_t* O; const float* ssq;
    __device__ __forceinline__ void operator()(const f32x4 (&acc)[2][2][4][2], const Unit& u, int wr, int wc, int fr, int fq) const {
        const int row0 = u.pm * BM + wr * 64 + fr, col0 = u.pn * BM + wc * 32 + 8 * fq;
#pragma unroll
        for (int ai = 0; ai < 2; ++ai)
#pragma unroll
            for (int m = 0; m < 4; ++m) {
                const int row = row0 + ai * HALF + m * 16;
                float s = 0.f;
#pragma unroll
                for (int q = 0; q < 4; ++q) s += ssq[(size_t)(4 * fq + q) * 32768 + row];
                s += xshfl(s, (fq * 16 + fr) ^ 16); s += xshfl(s, (fq * 16 + fr) ^ 32);
                const float rstd = rsqrtf(s * (1.f / 1024.f) + 1e-6f);
#pragma unroll
                for (int bj = 0; bj < 2; ++bj) {
                    const f32x4 v0 = acc[ai][bj][m][0] * rstd, v1 = acc[ai][bj][m][1] * rstd;
                    u32x4 w; w.x = cvt_pk_bf16(v0[0], v0[1]); w.y = cvt_pk_bf16(v0[2], v0[3]); w.z = cvt_pk_bf16(v1[0], v1[1]); w.w = cvt_pk_bf16(v1[2], v1[3]);
                    *(u32x4*)(O + (size_t)row * 2048 + col0 + bj * HALF) = w;
                }
            }
    }
};
struct EpiPle {
    static constexpr bool PERM = true, AFTER_DRAIN = false;
    const bf16_t* X2; const bf16_t* PP; const float* rstd2; bf16_t* O;
    __device__ __forceinline__ void operator()(const f32x4 (&acc)[2][2][4][2], const Unit& u, int wr, int wc, int fr, int fq) const {
        const int row0 = u.pm * BM + wr * 64 + fr, col0 = u.pn * BM + wc * 32 + 8 * fq;
#pragma unroll
        for (int ai = 0; ai < 2; ++ai)
#pragma unroll
            for (int m = 0; m < 4; ++m) {
                const int row = row0 + ai * HALF + m * 16;
                const float rstd = rstd2[row];
#pragma unroll
                for (int bj = 0; bj < 2; ++bj) {
                    const size_t off = (size_t)row * 1024 + col0 + bj * HALF;
                    const u32x4 xw = *(const u32x4*)(X2 + off), pw = *(const u32x4*)(PP + off);
                    f32x4 o0, o1;
#pragma unroll
                    for (int e = 0; e < 4; ++e) {
                        const unsigned xe = (e < 2) ? ((e == 0) ? xw.x : xw.y) : ((e == 2) ? xw.z : xw.w);
                        const unsigned pe = (e < 2) ? ((e == 0) ? pw.x : pw.y) : ((e == 2) ? pw.z : pw.w);
                        const float xlo = __uint_as_float(xe << 16), xhi = __uint_as_float(xe & 0xffff0000u);
                        const float plo = __uint_as_float(pe << 16), phi = __uint_as_float(pe & 0xffff0000u);
                        const float a0 = (e < 2) ? acc[ai][bj][m][0][2 * e] : acc[ai][bj][m][1][2 * e - 4];
                        const float a1 = (e < 2) ? acc[ai][bj][m][0][2 * e + 1] : acc[ai][bj][m][1][2 * e - 3];
                        const float g0 = 1.f / (1.f + __expf(-a0 * rstd)), g1 = 1.f / (1.f + __expf(-a1 * rstd));
                        const float r0 = xlo + plo * g0, r1 = xhi + phi * g1;
                        if (e < 2) { o0[2 * e] = r0; o0[2 * e + 1] = r1; } else { o1[2 * e - 4] = r0; o1[2 * e - 3] = r1; }
                    }
                    { u32x4 w; w.x = cvt_pk_bf16(o0[0], o0[1]); w.y = cvt_pk_bf16(o0[2], o0[3]); w.z = cvt_pk_bf16(o1[0], o1[1]); w.w = cvt_pk_bf16(o1[2], o1[3]); *(u32x4*)(O + off) = w; }
                }
            }
    }
};
template <class Epi, class Sched, bool ALIGN_EPI = false, bool SP2 = false>
__device__ __forceinline__ void gemm_phase(PG8_LAS unsigned char* lds, const Gemm g, const Sched& S, const Epi& E, const int wave_id  ) {
    int lane_; asm volatile("v_mbcnt_lo_u32_b32 %0, -1, 0\n\tv_mbcnt_hi_u32_b32 %0, -1, %0" : "=v"(lane_)); int tid_ = wave_id * 64 + lane_;
    const int tid = tid_, wid = wave_id, lane = tid & 63, wr = wid >> 2, wc = wid & 3, fr = lane & 15, fq = lane >> 4;
    const int K = g.K, nt = K / BK;
    unsigned voffA[2], voffB[2];
#pragma unroll
    for (int i = 0; i < 2; ++i) { int R, C; stage_rc(tid * 16 + i * 8192, R, C); const int Rb = Epi::PERM ? ((R & ~31) + perm32(R & 31)) : R;
        voffA[i] = (unsigned)(R * K + C) * 2u; voffB[i] = (unsigned)(Rb * K + C) * 2u; }
    const size_t kstep = (size_t)(BK * 2);
    const size_t hstep = (size_t)HALF * K * 2;
    const size_t tstep = 2 * hstep;
    const unsigned ldsw = (unsigned)wid * 1024u;
    const int aoff = lds_byte(wr * 64 + fr, fq * 8), boff = lds_byte(wc * 32 + fr, fq * 8);
#define PG8_SA(b, h) (((b) * 2 + (h)) * HTB)
#define PG8_SB(b, h) ((4 + (b) * 2 + (h)) * HTB)
#define PG8_STAGE(bufoff, gbase, voff) do { _Pragma("unroll") for (int _i = 0; _i < 2; ++_i) \
        __builtin_amdgcn_global_load_lds((const unsigned*)((const char*)(gbase) + (voff)[_i]), (PG8_LAS unsigned*)(lds + (bufoff) + ldsw + _i * 8192), 16, 0, 0); } while (0)
#define PG8_LDA(dst, b, h) do { _Pragma("unroll") for (int m = 0; m < 4; ++m) _Pragma("unroll") for (int k = 0; k < 2; ++k) dst[m][k] = *(const PG8_LAS bf16x8*)(lds + PG8_SA(b, h) + aoff + m * 2048 + k * 1024); } while (0)
#define PG8_LDB(dst, b, h) do { _Pragma("unroll") for (int n = 0; n < 2; ++n) _Pragma("unroll") for (int k = 0; k < 2; ++k) dst[n][k] = *(const PG8_LAS bf16x8*)(lds + PG8_SB(b, h) + boff + n * 2048 + k * 1024); } while (0)
#define PG8_MMA(ai, bj, At, Bt) do { __builtin_amdgcn_s_setprio(1); _Pragma("unroll") for (int m = 0; m < 4; ++m) _Pragma("unroll") for (int n = 0; n < 2; ++n) _Pragma("unroll") for (int k = 0; k < 2; ++k) \
        acc[ai][bj][m][n] = __builtin_amdgcn_mfma_f32_16x16x32_bf16(Bt[n][k], At[m][k], acc[ai][bj][m][n], 0, 0, 0); __builtin_amdgcn_s_setprio(0); } while (0)
#define PG8_WAIT_V(n) asm volatile("s_waitcnt vmcnt(" #n ")" ::: "memory")
#define PG8_WAIT_L(n) asm volatile("s_waitcnt lgkmcnt(" #n ")" ::: "memory")
#define PG8_BAR __builtin_amdgcn_s_barrier()
#define PG8_SCHED __builtin_amdgcn_sched_barrier(0)
    Unit cur, nxt; int ui = 0;
    if (!S.next(0, cur)) return;
    f32x4 acc[2][2][4][2];
#pragma unroll
    for (int a = 0; a < 2; ++a)
#pragma unroll
        for (int b = 0; b < 2; ++b)
#pragma unroll
            for (int m = 0; m < 4; ++m)
#pragma unroll
                for (int n = 0; n < 2; ++n) acc[a][b][m][n] = (f32x4){0.f, 0.f, 0.f, 0.f};
    bf16x8 At[4][2], B0[2][2], B1[2][2];
    const char* cA = (const char*)g.A + (size_t)cur.pm * tstep; const char* cB = (const char*)g.Bt + (size_t)cur.pn * tstep;
    S.a_ready(cur);
    if constexpr (SP2) {
        PG8_STAGE(PG8_SB(0, 0), cB, voffB); PG8_STAGE(PG8_SB(0, 1), cB + hstep, voffB); PG8_STAGE(PG8_SA(0, 0), cA, voffA); PG8_STAGE(PG8_SA(0, 1), cA + hstep, voffA);
        if (wr == 1) PG8_BAR;
        PG8_WAIT_V(2); PG8_BAR;
        PG8_STAGE(PG8_SB(1, 0), cB + kstep, voffB); PG8_STAGE(PG8_SA(1, 0), cA + kstep, voffA); PG8_STAGE(PG8_SB(1, 1), cB + hstep + kstep, voffB);
        PG8_WAIT_V(6); PG8_BAR;
    } else {
        PG8_STAGE(PG8_SB(0, 0), cB, voffB); PG8_STAGE(PG8_SA(0, 0), cA, voffA); PG8_STAGE(PG8_SB(0, 1), cB + hstep, voffB); PG8_STAGE(PG8_SA(0, 1), cA + hstep, voffA);
        if (wr == 1) PG8_BAR;
        PG8_WAIT_V(4); PG8_BAR;
        PG8_STAGE(PG8_SB(1, 0), cB + kstep, voffB); PG8_STAGE(PG8_SA(1, 0), cA + kstep, voffA); PG8_STAGE(PG8_SB(1, 1), cB + hstep + kstep, voffB);
        PG8_WAIT_V(6); PG8_BAR;
    }
    for (;;) {
        const bool has_next = S.next(ui + 1, nxt);
        const char* nA = has_next ? (const char*)g.A + (size_t)nxt.pm * tstep : cA; const char* nB = has_next ? (const char*)g.Bt + (size_t)nxt.pn * tstep : cB;
        for (int t = 0; t < nt; t += 2) {
            const bool last = (t == nt - 2);
            const char* a1 = cA + (size_t)(t + 1) * kstep;
            const char* a2 = last ? nA : cA + (size_t)(t + 2) * kstep; const char* b2 = last ? nB : cB + (size_t)(t + 2) * kstep;
            const char* a3 = a2 + kstep; const char* b3 = b2 + kstep;
            if (last && has_next) S.a_ready(nxt);
            if constexpr (SP2) {
            PG8_LDB(B0, 0, 0); PG8_LDB(B1, 0, 1); PG8_SCHED; PG8_LDA(At, 0, 0); PG8_STAGE(PG8_SA(1, 1), a1 + hstep, voffA);
            PG8_WAIT_V(8); PG8_WAIT_L(0); PG8_BAR; PG8_MMA(0, 0, At, B0); PG8_MMA(0, 1, At, B1); PG8_BAR; PG8_SCHED;
            PG8_LDA(At, 0, 1); PG8_STAGE(PG8_SB(0, 0), b2, voffB); PG8_STAGE(PG8_SB(0, 1), b2 + hstep, voffB); PG8_STAGE(PG8_SA(0, 0), a2, voffA);
            PG8_WAIT_V(8); PG8_WAIT_L(0); PG8_BAR; PG8_MMA(1, 0, At, B0); PG8_MMA(1, 1, At, B1); PG8_BAR; PG8_SCHED;
            PG8_LDB(B0, 1, 0); PG8_LDB(B1, 1, 1); PG8_SCHED; PG8_LDA(At, 1, 0); PG8_STAGE(PG8_SA(0, 1), a2 + hstep, voffA);
            PG8_WAIT_V(8); PG8_WAIT_L(0); PG8_BAR; PG8_MMA(0, 0, At, B0); PG8_MMA(0, 1, At, B1); PG8_BAR; PG8_SCHED;
            PG8_LDA(At, 1, 1); PG8_STAGE(PG8_SB(1, 0), b3, voffB); PG8_STAGE(PG8_SB(1, 1), b3 + hstep, voffB); PG8_STAGE(PG8_SA(1, 0), a3, voffA);
            PG8_WAIT_V(8); PG8_WAIT_L(0); PG8_BAR; PG8_MMA(1, 0, At, B0); PG8_MMA(1, 1, At, B1); PG8_BAR; PG8_SCHED;
            } else {
            PG8_LDB(B0, 0, 0); PG8_SCHED; PG8_LDA(At, 0, 0); PG8_STAGE(PG8_SA(1, 1), a1 + hstep, voffA);
            PG8_WAIT_L(8); PG8_BAR; PG8_WAIT_L(0); PG8_MMA(0, 0, At, B0); PG8_BAR; PG8_SCHED;
            PG8_LDB(B1, 0, 1); PG8_STAGE(PG8_SB(0, 0), b2, voffB);
            PG8_BAR; PG8_WAIT_L(0); PG8_MMA(0, 1, At, B1); PG8_BAR;
            PG8_LDA(At, 0, 1); PG8_STAGE(PG8_SA(0, 0), a2, voffA);
            PG8_BAR; PG8_WAIT_L(0); PG8_MMA(1, 0, At, B0); PG8_BAR; PG8_SCHED;
            PG8_STAGE(PG8_SB(0, 1), b2 + hstep, voffB);
            PG8_WAIT_V(6); PG8_BAR; PG8_MMA(1, 1, At, B1); PG8_BAR;
            PG8_LDB(B0, 1, 0); PG8_SCHED; PG8_LDA(At, 1, 0); PG8_STAGE(PG8_SA(0, 1), a2 + hstep, voffA);
            PG8_WAIT_L(8); PG8_BAR; PG8_WAIT_L(0); PG8_MMA(0, 0, At, B0); PG8_BAR; PG8_SCHED;
            PG8_LDB(B1, 1, 1); PG8_STAGE(PG8_SB(1, 0), b3, voffB);
            PG8_BAR; PG8_WAIT_L(0); PG8_MMA(0, 1, At, B1); PG8_BAR;
            PG8_LDA(At, 1, 1); PG8_STAGE(PG8_SA(1, 0), a3, voffA);
            PG8_BAR; PG8_WAIT_L(0); PG8_MMA(1, 0, At, B0); PG8_BAR; PG8_SCHED;
            PG8_STAGE(PG8_SB(1, 1), b3 + hstep, voffB);
            PG8_WAIT_V(6); PG8_BAR; PG8_MMA(1, 1, At, B1); PG8_BAR;
            }
        }
        if constexpr (ALIGN_EPI) { if (wr == 0) PG8_BAR; }
        if constexpr (!Epi::AFTER_DRAIN) { E(acc, cur, wr, wc, fr, fq); S.done(cur); }
        if (!has_next) break;
#pragma unroll
        for (int a = 0; a < 2; ++a)
#pragma unroll
            for (int b = 0; b < 2; ++b)
#pragma unroll
                for (int m = 0; m < 4; ++m)
#pragma unroll
                    for (int n = 0; n < 2; ++n) acc[a][b][m][n] = (f32x4){0.f, 0.f, 0.f, 0.f};
        cur = nxt; cA = nA; cB = nB; ++ui;
        if constexpr (ALIGN_EPI) { if (wr == 1) PG8_BAR; }
    }
    PG8_WAIT_V(0);
    if constexpr (!ALIGN_EPI) { if (wr == 0) PG8_BAR; }
    PG8_BAR;
    if constexpr (Epi::AFTER_DRAIN) { E.fused(acc, cur, wr, wc, fr, fq, lds, wid, lane); S.done(cur); }
#undef PG8_SA
#undef PG8_SB
#undef PG8_STAGE
#undef PG8_LDA
#undef PG8_LDB
#undef PG8_MMA
#undef PG8_WAIT_V
#undef PG8_WAIT_L
#undef PG8_BAR
#undef PG8_SCHED
}
}

#define GAS __attribute__((address_space(1)))
#define LAS __attribute__((address_space(3)))
typedef unsigned short bf16;
typedef unsigned v4u __attribute__((ext_vector_type(4)));
typedef float f32x4 __attribute__((ext_vector_type(4)));
typedef short bf16x8 __attribute__((ext_vector_type(8)));
typedef GAS unsigned gu32;
typedef GAS unsigned long long gu64;
#define RLX_AGENT __ATOMIC_RELAXED, __HIP_MEMORY_SCOPE_AGENT
#define LDS_WAIT() asm volatile("s_waitcnt lgkmcnt(0)" ::: "memory")
#define VM_WAIT() asm volatile("s_waitcnt vmcnt(0)" ::: "memory")
__device__ __forceinline__ unsigned long long rt() { return __builtin_amdgcn_s_memrealtime(); }
__device__ __forceinline__ unsigned f2bf(float f) { unsigned u = __builtin_bit_cast(unsigned, f); return (u + 0x7fffu + ((u >> 16) & 1u)) >> 16; }
__device__ __forceinline__ unsigned pk2(float lo, float hi) { return f2bf(lo) | (f2bf(hi) << 16); }

#define XB_TMO      128
#define XB_XCNT(j)  (256  + 64 * (j))
#define XB_XSUB(j)  (1280 + 64 * (j))
#define XB_XGEN(j)  (2304 + 64 * (j))
#define XB_TOP      3328
#define XB_TOPGEN   3392
#define XCD_BAR_WORDS 3456
#define XB_SPIN_CAP (1u << 18)

__device__ __forceinline__ unsigned xb_ld(unsigned* p)              { return __hip_atomic_load(p, __ATOMIC_RELAXED, __HIP_MEMORY_SCOPE_AGENT); }
__device__ __forceinline__ unsigned xb_add(unsigned* p, unsigned v) { return __hip_atomic_fetch_add(p, v, __ATOMIC_RELAXED, __HIP_MEMORY_SCOPE_AGENT); }
__device__ __forceinline__ unsigned xb_xcc_id() { return (unsigned)__builtin_amdgcn_s_getreg((3 << 11) | 20) & 0xFu; }
#define XB_SPIN(cond, bar) do { unsigned _sp = 0; while (cond) { __builtin_amdgcn_s_sleep(1); \
    if ((++_sp & 255u) == 0u) { if (xb_ld(&(bar)[XB_TMO])) break; if (_sp > XB_SPIN_CAP) { atomicAdd(&(bar)[XB_TMO], 1u); break; } } } } while (0)

struct XcdBarrier {
    unsigned* bar; unsigned x;
    volatile LAS unsigned* st;
};

__device__ __forceinline__ XcdBarrier xcd_barrier_post(unsigned* bar, volatile LAS unsigned* st) {
    XcdBarrier b; b.bar = bar; b.x = xb_xcc_id(); b.st = st;
    if (threadIdx.x == 0) (void)xb_add(&bar[XB_XCNT(b.x)], 1u);
    return b;
}
__device__ __forceinline__ void xcd_barrier_complete(unsigned* bar, unsigned x, unsigned& nloc, unsigned& nx) {
    const unsigned G = gridDim.x * gridDim.y * gridDim.z;
    unsigned sum, cnt, mine, sp = 0u;
    for (;;) {
        sum = 0u; cnt = 0u; mine = 0u;
#pragma unroll
        for (unsigned j = 0; j < 16; ++j) { const unsigned c = xb_ld(&bar[XB_XCNT(j)]); sum += c; cnt += (c > 0u) ? 1u : 0u; mine = (j == x) ? c : mine; }
        if (sum == G) break;
        __builtin_amdgcn_s_sleep(1);
        if ((++sp & 255u) == 0u) { if (xb_ld(&bar[XB_TMO])) break; if (sp > XB_SPIN_CAP) { atomicAdd(&bar[XB_TMO], 1u); break; } }
    }
    nloc = mine > 0u ? mine : 1u; nx = cnt > 0u ? cnt : 1u;
}

__device__ __forceinline__ void xcd_barrier(const XcdBarrier& b, const bool leader  ) {
    asm volatile("s_waitcnt vmcnt(0)" ::: "memory");
    __syncthreads();
    if (leader) {
        unsigned* bar = b.bar;
        __builtin_amdgcn_s_waitcnt(0);
        unsigned nloc = b.st[0], nx = b.st[1];
        if (nloc == 0u) { xcd_barrier_complete(bar, b.x, nloc, nx); b.st[0] = nloc; b.st[1] = nx; }
        const unsigned old = xb_add(&bar[XB_XSUB(b.x)], 1u);
        const unsigned gen = old / nloc;
        if (old + 1u == (gen + 1u) * nloc) {
            __builtin_amdgcn_fence(__ATOMIC_RELEASE, "agent");
            asm volatile("s_waitcnt vmcnt(0)" ::: "memory");
            const unsigned og = xb_add(&bar[XB_TOP], 1u);
            const unsigned tg = og / nx;
            if (og + 1u == (tg + 1u) * nx) xb_add(&bar[XB_TOPGEN], 1u);
            else XB_SPIN(xb_ld(&bar[XB_TOPGEN]) == tg, bar);
            __builtin_amdgcn_fence(__ATOMIC_ACQUIRE, "agent");
            xb_add(&bar[XB_XGEN(b.x)], 1u);
            asm volatile("s_waitcnt vmcnt(0)" ::: "memory");
        } else {
            XB_SPIN(xb_ld(&bar[XB_XGEN(b.x)]) == gen, bar);
            __builtin_amdgcn_fence(__ATOMIC_ACQUIRE, "agent");
            asm volatile("s_waitcnt vmcnt(0)" ::: "memory");
        }
    }
    __syncthreads();
}
#ifndef REP_P0
#define REP_P0 1
#endif
#ifndef REP_P1
#define REP_P1 1
#endif
#ifndef REP_P2
#define REP_P2 1
#endif
#ifndef REP_P2A
#define REP_P2A 1
#endif
#ifndef REP_SEQ
#define REP_SEQ 1
#endif
#ifndef REP_DSW
#define REP_DSW 1
#endif
#ifndef REP_P3
#define REP_P3 1
#endif
#ifndef REP_P4
#define REP_P4 1
#endif
#ifndef REP_P5
#define REP_P5 1
#endif
#ifndef REP_P6
#define REP_P6 1
#endif
#ifndef REP_P7
#define REP_P7 1
#endif
constexpr int NWAVES = 8;
constexpr int T = 32768, D = 1024, SEQ = 4096;
constexpr int INC = 3328, INCP = 3328, INC_OLD = 3088;
constexpr int OFF_QA = 0, OFF_KA = 256, OFF_VA = 512, OFF_RA = 1024, OFF_LA = 1536, OFF_QB = 1792, OFF_KB = 2304, OFF_VB = 2816;
constexpr float EPS = 1e-6f;
constexpr size_t MiB = 1u << 20;
constexpr size_t WS_CTL = 0, CTL_ZERO_BYTES = 1 * MiB;
constexpr size_t WS_BT_IN = 2 * MiB, WS_BT_OUT = 10 * MiB, WS_BT_PQ = 12 * MiB, WS_BT_PG = 16 * MiB, WS_BT_PP = 18 * MiB;
constexpr size_t WS_ROPE = 20 * MiB, WS_SSQ1 = 22 * MiB, WS_RSTD2 = 24 * MiB, WS_KEYSB = 26 * MiB, WS_GDEC = 27 * MiB;
constexpr size_t WS_H1 = 32 * MiB;
constexpr size_t WS_PROJ = 96 * MiB;
constexpr size_t WS_QR = 96 * MiB, WS_SEL = 224 * MiB;
constexpr size_t WS_MIX = 304 * MiB;
constexpr size_t WS_PB = 368 * MiB;
constexpr size_t WS_PPROJ = 384 * MiB;
constexpr size_t WS_X2B = 304 * MiB;
constexpr size_t WS_UB = 448 * MiB, WS_VB = 464 * MiB;
constexpr size_t WS_GOG = 32 * MiB;
constexpr size_t WS_GQD = 368 * MiB;
constexpr size_t WS_GKV = 480 * MiB;
constexpr size_t WS_END = 512 * MiB;
constexpr int CW_BAR = 4096;
constexpr int CW_DSW = 16384;
constexpr int RING_OFF = 0, RING_BYTES = 131072;
constexpr int LDSCTL_OFF = RING_BYTES, MISC_OFF = LDSCTL_OFF + 320;
constexpr int LDS_BYTES = 147456;

__device__ __forceinline__ float bf2f(bf16 v) { return __uint_as_float(((unsigned)v) << 16); }
__device__ __forceinline__ float wave_sum(float v) {
    v += __int_as_float(__builtin_amdgcn_update_dpp(0, __float_as_int(v), 0xB1, 0xF, 0xF, true));
    v += __int_as_float(__builtin_amdgcn_update_dpp(0, __float_as_int(v), 0x4E, 0xF, 0xF, true));
    v += __int_as_float(__builtin_amdgcn_update_dpp(0, __float_as_int(v), 0x141, 0xF, 0xF, true));
    v += __int_as_float(__builtin_amdgcn_update_dpp(0, __float_as_int(v), 0x140, 0xF, 0xF, true));
    v += __int_as_float(__builtin_amdgcn_update_dpp(0, __float_as_int(v), 0x142, 0xA, 0xF, false));
    v += __int_as_float(__builtin_amdgcn_update_dpp(0, __float_as_int(v), 0x143, 0xC, 0xF, false));
    return __int_as_float(__builtin_amdgcn_readlane(__float_as_int(v), 63));
}
__device__ __forceinline__ float xshfl(float v, int srclane) { return __int_as_float(__builtin_amdgcn_ds_bpermute(srclane << 2, __float_as_int(v))); }
__device__ __forceinline__ int xshfl_i(int v, int srclane) { return __builtin_amdgcn_ds_bpermute(srclane << 2, v); }


typedef __bf16 bf16x2_t __attribute__((ext_vector_type(2)));
typedef int i32x2 __attribute__((ext_vector_type(2)));
typedef short s16x4 __attribute__((ext_vector_type(4)));
typedef float f32x2 __attribute__((ext_vector_type(2)));
typedef float f32x32 __attribute__((ext_vector_type(32)));
typedef __bf16 bf16x32 __attribute__((ext_vector_type(32)));
typedef unsigned u32x6 __attribute__((ext_vector_type(6)));
typedef unsigned u32x16 __attribute__((ext_vector_type(16)));
__device__ __forceinline__ unsigned enc6(float y) { const float q = fabsf(y) * 8.f; float c;
    if (q < 16.f) c = rintf(q); else if (q < 32.f) c = 16.f + rintf((q - 16.f) * 0.5f); else c = 24.f + rintf((q - 32.f) * 0.25f);
    c = fminf(c, 31.f); return (unsigned)c | ((__float_as_uint(y) >> 31) << 5); }
__device__ __forceinline__ unsigned enc4(float y) { const float a = fabsf(y);
    const unsigned c = (a > 0.25f) + (a > 0.75f) + (a > 1.25f) + (a > 1.75f) + (a > 2.5f) + (a > 3.5f) + (a > 5.0f); return c | ((__float_as_uint(y) >> 31) << 3); }
__device__ __forceinline__ unsigned cvtpk(float a, float b) { const f32x2 v = {a, b}; return __builtin_bit_cast(unsigned, __builtin_convertvector(v, bf16x2_t)); }
template <int CTRL> __device__ __forceinline__ float dpp_mov(float v) { return __int_as_float(__builtin_amdgcn_update_dpp(0, __float_as_int(v), CTRL, 0xF, 0xF, true)); }
__device__ __forceinline__ float row_sum16(float v) { v += dpp_mov<0xB1>(v); v += dpp_mov<0x4E>(v); v += dpp_mov<0x141>(v); v += dpp_mov<0x140>(v); return v; }
__device__ __forceinline__ float dot2bf(unsigned a, unsigned b, float c) { return __builtin_amdgcn_fdot2_f32_bf16(__builtin_bit_cast(bf16x2_t, a), __builtin_bit_cast(bf16x2_t, b), c, false); }
__device__ __forceinline__ float bflo(unsigned w) { return __uint_as_float(w << 16); }
__device__ __forceinline__ float bfhi(unsigned w) { return __uint_as_float(w & 0xffff0000u); }


__device__ __forceinline__ int f2key(float f) { const int b = __float_as_int(f); return b ^ ((b >> 31) & 0x7fffffff); }
__device__ __forceinline__ float key2f(int k) { return __int_as_float(k ^ ((k >> 31) & 0x7fffffff)); }
#define CE_DESC(a, b) { const int _hi = max((a), (b)), _lo = min((a), (b)); (a) = _hi; (b) = _lo; }
template <int N> __device__ __forceinline__ void bitonic_sort_desc(int (&v)[N]) {
#pragma unroll
    for (int k = 2; k <= N; k <<= 1)
#pragma unroll
        for (int j = k >> 1; j > 0; j >>= 1)
#pragma unroll
            for (int i = 0; i < N; ++i) { const int l = i ^ j; if (l > i) { if ((i & k) == 0) CE_DESC(v[i], v[l]) else CE_DESC(v[l], v[i]) } }
}
template <int N> __device__ __forceinline__ void bitonic_merge_desc(int (&v)[N]) {
#pragma unroll
    for (int j = N >> 1; j > 0; j >>= 1)
#pragma unroll
        for (int i = 0; i < N; ++i) { const int l = i ^ j; if (l > i) CE_DESC(v[i], v[l]) }
}
__device__ __forceinline__ void merge_top16(int (&a)[16], int srclane) {
    int b[16];
#pragma unroll
    for (int i = 0; i < 16; ++i) b[i] = __builtin_amdgcn_ds_bpermute(srclane << 2, a[i]);
#pragma unroll
    for (int i = 0; i < 16; ++i) a[i] = max(a[i], b[15 - i]);
    bitonic_merge_desc<16>(a);
}
struct CandTab { int i[64], j[64]; int n;
    constexpr CandTab() : i{}, j{}, n(0) { for (int a = 0; a < 16; ++a) for (int b = 0; b < 16; ++b) if ((a + 1) * (b + 1) <= 16) { i[n] = a; j[n] = b; ++n; } for (int q = n; q < 64; ++q) { i[q] = -1; j[q] = -1; } } };
constexpr CandTab kCand{};
static_assert(kCand.n == 50, "50 product-key candidates can reach the top 16");

__device__ __forceinline__ float max_x16(float x) { const auto r = __builtin_amdgcn_permlane16_swap(__float_as_uint(x), __float_as_uint(x), false, false); return fmaxf(__uint_as_float(r[0]), __uint_as_float(r[1])); }
__device__ __forceinline__ float max_x32(float x) { const auto r = __builtin_amdgcn_permlane32_swap(__float_as_uint(x), __float_as_uint(x), false, false); return fmaxf(__uint_as_float(r[0]), __uint_as_float(r[1])); }
__device__ __forceinline__ float add_x16(float x) { const auto r = __builtin_amdgcn_permlane16_swap(__float_as_uint(x), __float_as_uint(x), false, false); return __uint_as_float(r[0]) + __uint_as_float(r[1]); }
__device__ __forceinline__ float add_x32(float x) { const auto r = __builtin_amdgcn_permlane32_swap(__float_as_uint(x), __float_as_uint(x), false, false); return __uint_as_float(r[0]) + __uint_as_float(r[1]); }

__device__ __forceinline__ void p0_transpose_item(const float* W, int K, int ldw, int src0, int ncols, const float* gain, bf16* WT, int dst0, int nblk, LAS float* scr, int item, int lane) {
    const int kb = item / nblk, nb = item % nblk, k0 = 64 * kb, n0 = 32 * nb;
    const int n = n0 + (lane & 31);
#pragma unroll 8
    for (int i = 0; i < 32; ++i) { const int kk = 2 * i + (lane >> 5); float v = 0.f; if (n < ncols) { v = W[(size_t)(k0 + kk) * ldw + src0 + n]; if (gain) v *= gain[k0 + kk]; } scr[kk * 33 + (lane & 31)] = v; }
    LDS_WAIT(); asm volatile("" ::: "memory");
    const int c = lane & 7;
#pragma unroll
    for (int j = 0; j < 4; ++j) { const int nn = (lane >> 3) + 8 * j; const LAS float* s = scr + (8 * c) * 33 + nn;
        v4u o; o.x = pk2(s[0 * 33], s[1 * 33]); o.y = pk2(s[2 * 33], s[3 * 33]); o.z = pk2(s[4 * 33], s[5 * 33]); o.w = pk2(s[6 * 33], s[7 * 33]);
        *(GAS v4u*)(WT + (size_t)(dst0 + n0 + nn) * K + k0 + 8 * c) = o; }
    LDS_WAIT(); asm volatile("" ::: "memory");
}

struct Args { const float* in[18]; float* outp; unsigned char* ws; };

#define xin      (args.in[0])
#define p_in     (args.in[1])
#define positions ((const int*)args.in[2])
#define g_mix    (args.in[3])
#define w_in     (args.in[4])
#define w_up     (args.in[5])
#define b_gate   (args.in[6])
#define g_gla    (args.in[7])
#define w_out    (args.in[8])
#define g_peer   (args.in[9])
#define w_pq     (args.in[10])
#define skeys    (args.in[11])
#define pu       (args.in[12])
#define pv       (args.in[13])
#define g_ple    (args.in[14])
#define w_pg     (args.in[15])
#define w_pp     (args.in[16])
#define g_final  (args.in[17])
#define out      (args.outp)
#define Bt_in    ((bf16*)(args.ws + WS_BT_IN))
#define Bt_out   ((bf16*)(args.ws + WS_BT_OUT))
#define Bt_pq    ((bf16*)(args.ws + WS_BT_PQ))
#define Bt_pg    ((bf16*)(args.ws + WS_BT_PG))
#define Bt_pp    ((bf16*)(args.ws + WS_BT_PP))
#define rope     ((float*)(args.ws + WS_ROPE))
#define ssq1     ((float*)(args.ws + WS_SSQ1))
#define rstd2    ((float*)(args.ws + WS_RSTD2))
#define h1       ((bf16*)(args.ws + WS_H1))
#define x1b      ((bf16*)(args.ws + WS_H1))
#define proj     ((bf16*)(args.ws + WS_PROJ))
#define qr       ((bf16*)(args.ws + WS_QR))
#define sel2     ((i32x2*)(args.ws + WS_SEL))
#define Ub       ((unsigned char*)(args.ws + WS_UB))
#define Vb       ((unsigned char*)(args.ws + WS_VB))
#define keysb    ((bf16*)(args.ws + WS_KEYSB))
#define mix      ((bf16*)(args.ws + WS_MIX))
#define pb       ((bf16*)(args.ws + WS_PB))
#define pproj    ((bf16*)(args.ws + WS_PPROJ))
#define x2b      ((bf16*)(args.ws + WS_X2B))


__global__ void __launch_bounds__(NWAVES * 64, 2) mk_fwd(Args args) {
    extern __shared__ __attribute__((aligned(16))) unsigned char lds[];
    LAS unsigned char* const L = (LAS unsigned char*)lds;
    volatile LAS unsigned* const MISC = (volatile LAS unsigned*)(L + MISC_OFF);
    const int wave = __builtin_amdgcn_readfirstlane((int)threadIdx.x >> 6);
#define LANE_DECL int lane; asm volatile("v_mbcnt_lo_u32_b32 %0, -1, 0\n\tv_mbcnt_hi_u32_b32 %0, -1, %0" : "=v"(lane))
    const int G = gridDim.x; const int bx = blockIdx.x;
    const int vcu = (G % 8 == 0) ? (bx % 8) * (G / 8) + bx / 8 : bx;
    const int gw = vcu * NWAVES + wave, NGW = G * NWAVES;
    gu32* const ctl = (gu32*)(args.ws + WS_CTL);
    for (int u = threadIdx.x; u < (LDS_BYTES - LDSCTL_OFF) / 4; u += NWAVES * 64) ((LAS unsigned*)(L + LDSCTL_OFF))[u] = 0u;
    __syncthreads();
    XcdBarrier bar = xcd_barrier_post((unsigned*)(ctl + CW_BAR), MISC + 8);

    for (int rep_ = 0; rep_ < REP_P0; ++rep_) {
        LANE_DECL;
        LAS float* scr = (LAS float*)(L + RING_OFF + wave * 16384);
        constexpr int I_INA = 16 * 48, I_INB = 16 * 48, I_OUT = 16 * 32, I_PQ = 16 * 64, I_PG = 16 * 32, I_PP = 4 * 32;
        constexpr int NITEMS = I_INA + I_INB + I_OUT + I_PQ + I_PG + I_PP;
        for (int it = gw; it < NITEMS; it += NGW) {
            int r = it;
            if (r < I_INA) { p0_transpose_item(w_in, 1024, INC_OLD, 0, 1536, nullptr, Bt_in, 0, 48, scr, r, lane); continue; } r -= I_INA;
            if (r < I_INB) { p0_transpose_item(w_in, 1024, INC_OLD, 1552, 1536, nullptr, Bt_in, 1792, 48, scr, r, lane); continue; } r -= I_INB;
            if (r < I_OUT) { p0_transpose_item(w_out, 1024, 1024, 0, 1024, nullptr, Bt_out, 0, 32, scr, r, lane); continue; } r -= I_OUT;
            if (r < I_PQ) { p0_transpose_item(w_pq, 1024, 2048, 0, 2048, g_peer, Bt_pq, 0, 64, scr, r, lane); continue; } r -= I_PQ;
            if (r < I_PG) { p0_transpose_item(w_pg, 1024, 1024, 0, 1024, g_ple, Bt_pg, 0, 32, scr, r, lane); continue; } r -= I_PG;
            p0_transpose_item(w_pp, 256, 1024, 0, 1024, nullptr, Bt_pp, 0, 32, scr, r, lane);
        }
        for (int i = gw * 64 + lane; i < 256 * 128; i += NGW * 64) {
            const int n = i >> 7, k0 = (i & 127) * 8;
            float wu[16];
#pragma unroll
            for (int r = 0; r < 16; ++r) wu[r] = w_up[r * 256 + n];
            float o8[8];
#pragma unroll
            for (int kk = 0; kk < 8; ++kk) { const GAS f32x4* wr4 = (const GAS f32x4*)(w_in + (size_t)(k0 + kk) * INC_OLD + 1536); float a = 0.f;
#pragma unroll
                for (int q = 0; q < 4; ++q) { const f32x4 w4 = wr4[q]; a += w4.x * wu[4 * q] + w4.y * wu[4 * q + 1] + w4.z * wu[4 * q + 2] + w4.w * wu[4 * q + 3]; }
                o8[kk] = a; }
            v4u o; o.x = pk2(o8[0], o8[1]); o.y = pk2(o8[2], o8[3]); o.z = pk2(o8[4], o8[5]); o.w = pk2(o8[6], o8[7]);
            *(GAS v4u*)(Bt_in + (size_t)(1536 + n) * 1024 + k0) = o;
        }
        for (int row = gw; row < T; row += NGW) {
            const GAS f32x4* xr = (const GAS f32x4*)(xin + (size_t)row * D) + lane;
            f32x4 v[4]; float s = 0.f;
#pragma unroll
            for (int j = 0; j < 4; ++j) { v[j] = xr[64 * j]; s += (v[j].x * v[j].x + v[j].y * v[j].y) + (v[j].z * v[j].z + v[j].w * v[j].w); }
            const float rstd = rsqrtf(wave_sum(s) * (1.f / D) + EPS);
            GAS unsigned long long* o8 = (GAS unsigned long long*)(h1 + (size_t)row * D) + lane;
#pragma unroll
            for (int j = 0; j < 4; ++j) { const f32x4 gg = ((const GAS f32x4*)g_mix)[64 * j + lane];
                o8[64 * j] = (unsigned long long)pk2(v[j].x * rstd * gg.x, v[j].y * rstd * gg.y) | ((unsigned long long)pk2(v[j].z * rstd * gg.z, v[j].w * rstd * gg.w) << 32); }
        }
        for (size_t i = (size_t)gw * 64 + lane; i < (size_t)T * 256 / 4; i += (size_t)NGW * 64) {
            const f32x4 v = ((const GAS f32x4*)p_in)[i];
            ((GAS unsigned long long*)pb)[i] = (unsigned long long)pk2(v.x, v.y) | ((unsigned long long)pk2(v.z, v.w) << 32);
        }
        for (int i = gw * 64 + lane; i < 16384 * 16 * 2; i += NGW * 64) {
            const int tab = i >> 18, row = (i >> 4) & 16383, li = i & 15;
            const float* src = (tab ? pv : pu) + (size_t)row * D;
            const float scl = tab ? 4.f : 64.f;
            unsigned dw[12];
#pragma unroll
            for (int q = 0; q < 12; ++q) dw[q] = 0u;
#pragma unroll
            for (int j = 0; j < 4; ++j)
#pragma unroll
                for (int e4 = 0; e4 < 4; ++e4) {
                    f32x4 v = ((const GAS f32x4*)(src + 256 * j + 16 * li))[e4];
                    if (!tab) v = v * ((const GAS f32x4*)(g_peer + 256 * j + 16 * li))[e4];
                    v = v * scl;
#pragma unroll
                    for (int e = 0; e < 4; ++e) {
                        const int k = (j & 1) * 16 + e4 * 4 + e, grp = j >> 1;
                        if (!tab) { const int bit = 6 * k, w = bit >> 5, sh = bit & 31; const unsigned c = enc6(v[e]); dw[grp * 6 + w] |= c << sh; if (sh > 26) dw[grp * 6 + w + 1] |= c >> (32 - sh); }
                        else dw[grp * 4 + (k >> 3)] |= enc4(v[e]) << (4 * (k & 7));
                    }
                }
            if (!tab) { GAS v4u* dst = (GAS v4u*)(Ub + (size_t)row * 768) + li;
                v4u o0, o1, o2; o0.x = dw[0]; o0.y = dw[1]; o0.z = dw[2]; o0.w = dw[3]; o1.x = dw[4]; o1.y = dw[5]; o1.z = dw[6]; o1.w = dw[7]; o2.x = dw[8]; o2.y = dw[9]; o2.z = dw[10]; o2.w = dw[11];
                dst[0] = o0; dst[16] = o1; dst[32] = o2; }
            else { GAS v4u* dst = (GAS v4u*)(Vb + (size_t)row * 512) + li;
                v4u o0, o1; o0.x = dw[0]; o0.y = dw[1]; o0.z = dw[2]; o0.w = dw[3]; o1.x = dw[4]; o1.y = dw[5]; o1.z = dw[6]; o1.w = dw[7];
                dst[0] = o0; dst[16] = o1; }
        }
        for (int i = gw * 64 + lane; i < 16 * 128 * 128 / 4; i += NGW * 64) {
            const f32x4 v = ((const GAS f32x4*)skeys)[i];
            ((GAS unsigned long long*)keysb)[i] = (unsigned long long)pk2(v.x, v.y) | ((unsigned long long)pk2(v.z, v.w) << 32);
        }
        for (int i = gw * 64 + lane; i < T * 8; i += NGW * 64) {
            const int t = i >> 3, j = i & 7;
            const float inv_freq = powf(500000.0f, -(float)j / 8.0f);
            const float ang = (float)positions[t] * inv_freq;
            rope[2 * i] = cosf(ang); rope[2 * i + 1] = sinf(ang);
        }
    }
    { LANE_DECL; xcd_barrier(bar, wave == 0 && lane == 0); }

    for (int rep_ = 0; rep_ < REP_P1; ++rep_) {
        pg8::Gemm g{h1, Bt_in, T, INCP, D}; pg8::StaticOrder S; S.init(T, INCP, G, bx);
        pg8::EpiInProj E{proj, rope, b_gate};
        pg8::gemm_phase<pg8::EpiInProj, pg8::StaticOrder, true, true>(L + RING_OFF, g, S, E, wave);
        pg8::Gemm g2{pb, Bt_pp, T, D, 256}; pg8::StaticOrder S2;
        { const int nfull = (T / 256) * (INCP / 256) - ((T / 256) * (INCP / 256) / G) * G;
          if (nfull > 0 && nfull < G && ((G - nfull) % 8) == 0 && (nfull % 8) == 0) S2.init(T, D, G - nfull, bx >= nfull ? bx - nfull : (1 << 28)); else S2.init(T, D, G, bx); }
        pg8::EpiBf16<0> E2{pproj, D, nullptr, 0, 0, 1.f};
        pg8::gemm_phase<pg8::EpiBf16<0>, pg8::StaticOrder, true, true>(L + RING_OFF, g2, S2, E2, wave);
    }
    { LANE_DECL; xcd_barrier(bar, wave == 0 && lane == 0); }

    {
        LANE_DECL;
        const int fr = lane & 15, g = lane >> 4;
        constexpr int RS = 144;
        LAS unsigned char* const qd = L + RING_OFF;
        LAS unsigned char* const kd = qd + 64 * RS;
        LAS unsigned char* const keT = kd + 64 * RS;
        LAS unsigned char* const vT = keT + 64 * RS;
        LAS unsigned char* const Am = vT + 128 * RS;
        LAS float* const dec = (LAS float*)(Am + 64 * RS);
        for (int i = wave * 64 + lane; i < 64 * RS / 4; i += NWAVES * 64) ((LAS unsigned*)Am)[i] = 0u;
        __syncthreads();
        for (int rep4_ = 0; rep4_ < REP_P2A; ++rep4_) {
        int u = bx;
        const bf16* prow = proj + (size_t)((u >> 6) * 64 + lane) * INC + 0;
        v4u lav, qv, kv, vv0, vv1;
        {
            const int hh = (u >> 6) & 3, t0 = (u >> 8) * SEQ + (u & 63) * 64;
            prow = proj + (size_t)(t0 + lane) * INC;
            lav = *(const GAS v4u*)(prow + OFF_LA + hh * 64 + 8 * wave); qv = *(const GAS v4u*)(prow + OFF_QA + hh * 64 + 8 * wave); kv = *(const GAS v4u*)(prow + OFF_KA + hh * 64 + 8 * wave);
            vv0 = *(const GAS v4u*)(prow + OFF_VA + hh * 128 + 16 * wave); vv1 = *(const GAS v4u*)(prow + OFF_VA + hh * 128 + 16 * wave + 8);
        }
        for (; u < 2048; u += G) {
            const int h = (u >> 6) & 3, t0 = (u >> 8) * SEQ + (u & 63) * 64;
            float laf[8];
            laf[0] = bflo(lav.x); laf[1] = bfhi(lav.x); laf[2] = bflo(lav.y); laf[3] = bfhi(lav.y); laf[4] = bflo(lav.z); laf[5] = bfhi(lav.z); laf[6] = bflo(lav.w); laf[7] = bfhi(lav.w);
            float qf[8], kf[8];
            qf[0] = bflo(qv.x); qf[1] = bfhi(qv.x); qf[2] = bflo(qv.y); qf[3] = bfhi(qv.y); qf[4] = bflo(qv.z); qf[5] = bfhi(qv.z); qf[6] = bflo(qv.w); qf[7] = bfhi(qv.w);
            kf[0] = bflo(kv.x); kf[1] = bfhi(kv.x); kf[2] = bflo(kv.y); kf[3] = bfhi(kv.y); kf[4] = bflo(kv.z); kf[5] = bfhi(kv.z); kf[6] = bflo(kv.w); kf[7] = bfhi(kv.w);
            float qdv[8], kdv[8], kev[8];
#pragma unroll
            for (int c = 0; c < 8; ++c) {
                float bsum = laf[c];
                bsum += __int_as_float(__builtin_amdgcn_update_dpp(0, __float_as_int(bsum), 0x111, 0xF, 0xF, false));
                bsum += __int_as_float(__builtin_amdgcn_update_dpp(0, __float_as_int(bsum), 0x112, 0xF, 0xF, false));
                bsum += __int_as_float(__builtin_amdgcn_update_dpp(0, __float_as_int(bsum), 0x114, 0xF, 0xF, false));
                bsum += __int_as_float(__builtin_amdgcn_update_dpp(0, __float_as_int(bsum), 0x118, 0xF, 0xF, false));
                bsum += __int_as_float(__builtin_amdgcn_update_dpp(0, __float_as_int(bsum), 0x142, 0xA, 0xF, false));
                bsum += __int_as_float(__builtin_amdgcn_update_dpp(0, __float_as_int(bsum), 0x143, 0xC, 0xF, false));
                const float blast = __int_as_float(__builtin_amdgcn_readlane(__float_as_int(bsum), 63));
                qdv[c] = qf[c] * 0.125f * __expf(bsum);
                kdv[c] = kf[c] * __expf(-bsum);
                kev[c] = kf[c] * __expf(blast - bsum);
                if (lane == 0) dec[8 * wave + c] = __expf(blast);
            }
#pragma unroll
            for (int c = 0; c < 8; c += 2) { const unsigned w2 = cvtpk(kev[c], kev[c + 1]);
                *(LAS bf16*)(keT + (8 * wave + c) * RS + lane * 2) = (bf16)(w2 & 0xffffu); *(LAS bf16*)(keT + (8 * wave + c + 1) * RS + lane * 2) = (bf16)(w2 >> 16); }
            { v4u o; o.x = cvtpk(qdv[0], qdv[1]); o.y = cvtpk(qdv[2], qdv[3]); o.z = cvtpk(qdv[4], qdv[5]); o.w = cvtpk(qdv[6], qdv[7]); *(LAS v4u*)(qd + lane * RS + 16 * wave) = o;
              v4u o2; o2.x = cvtpk(kdv[0], kdv[1]); o2.y = cvtpk(kdv[2], kdv[3]); o2.z = cvtpk(kdv[4], kdv[5]); o2.w = cvtpk(kdv[6], kdv[7]); *(LAS v4u*)(kd + lane * RS + 16 * wave) = o2; }
            {
                const unsigned vw[8] = {vv0.x, vv0.y, vv0.z, vv0.w, vv1.x, vv1.y, vv1.z, vv1.w};
#pragma unroll
                for (int e = 0; e < 8; ++e) { *(LAS bf16*)(vT + (16 * wave + 2 * e) * RS + lane * 2) = (bf16)(vw[e] & 0xffffu); *(LAS bf16*)(vT + (16 * wave + 2 * e + 1) * RS + lane * 2) = (bf16)(vw[e] >> 16); }
            }
            if (u + G < 2048) {
                const int un = u + G, hn = (un >> 6) & 3, tn = (un >> 8) * SEQ + (un & 63) * 64;
                const bf16* pn = proj + (size_t)(tn + lane) * INC;
                lav = *(const GAS v4u*)(pn + OFF_LA + hn * 64 + 8 * wave); qv = *(const GAS v4u*)(pn + OFF_QA + hn * 64 + 8 * wave); kv = *(const GAS v4u*)(pn + OFF_KA + hn * 64 + 8 * wave);
                vv0 = *(const GAS v4u*)(pn + OFF_VA + hn * 128 + 16 * wave); vv1 = *(const GAS v4u*)(pn + OFF_VA + hn * 128 + 16 * wave + 8);
            }
            unsigned long long rav[4];
#pragma unroll
            for (int tt = 0; tt < 4; ++tt) rav[tt] = *(const GAS unsigned long long*)(proj + (size_t)(t0 + 16 * tt + fr) * INC + OFF_RA + h * 128 + 16 * wave + 4 * g);
            const f32x4 ggl = *(const GAS f32x4*)(g_gla + h * 128 + 16 * wave + 4 * g);
            LDS_WAIT(); __syncthreads();
#pragma unroll
            for (int rep = 0; rep < 2; ++rep) {
                const int ti = wave + 8 * rep;
                if (ti < 10) {
                    const int tt = (ti >= 6) ? 3 : ((ti >= 3) ? 2 : ((ti >= 1) ? 1 : 0));
                    const int tk = ti - ((tt * (tt + 1)) >> 1);
                    f32x4 acc = {0.f, 0.f, 0.f, 0.f};
#pragma unroll
                    for (int ks = 0; ks < 2; ++ks) { const bf16x8 a = *(const LAS bf16x8*)(qd + (16 * tt + fr) * RS + (32 * ks + 8 * g) * 2), bb = *(const LAS bf16x8*)(kd + (16 * tk + fr) * RS + (32 * ks + 8 * g) * 2);
                        acc = __builtin_amdgcn_mfma_f32_16x16x32_bf16(a, bb, acc, 0, 0, 0); }
#pragma unroll
                    for (int r = 0; r < 4; ++r) { const int tq = 16 * tt + 4 * g + r, tc = 16 * tk + fr; *(LAS bf16*)(Am + tq * RS + tc * 2) = (bf16)f2bf(tq >= tc ? acc[r] : 0.f); }
                }
            }
            {
                const int tt = wave >> 1, ks = wave & 1;
                const unsigned long long lo = *(const LAS unsigned long long*)(qd + (16 * tt + fr) * RS + (32 * ks + 4 * g) * 2), hi = *(const LAS unsigned long long*)(qd + (16 * tt + fr) * RS + (32 * ks + 16 + 4 * g) * 2);
                v4u w; w.x = (unsigned)lo; w.y = (unsigned)(lo >> 32); w.z = (unsigned)hi; w.w = (unsigned)(hi >> 32);
                ((GAS v4u*)(args.ws + WS_GQD))[((size_t)u * 8 + wave) * 64 + lane] = w;
                if (wave == 0) ((GAS float*)(args.ws + WS_GDEC))[(size_t)u * 64 + lane] = dec[lane];
            }
            LDS_WAIT(); __syncthreads();
            bf16x8 vb[2];
#pragma unroll
            for (int ks = 0; ks < 2; ++ks) vb[ks] = *(const LAS bf16x8*)(vT + (16 * wave + fr) * RS + (32 * ks + 8 * g) * 2);
#pragma unroll
            for (int tt = 0; tt < 4; ++tt) {
                f32x4 acc = {0.f, 0.f, 0.f, 0.f};
#pragma unroll
                for (int ks = 0; ks < 2; ++ks) { const bf16x8 a = *(const LAS bf16x8*)(Am + (16 * tt + fr) * RS + (32 * ks + 8 * g) * 2); acc = __builtin_amdgcn_mfma_f32_16x16x32_bf16(vb[ks], a, acc, 0, 0, 0); }
                const unsigned rlo = (unsigned)rav[tt], rhi = (unsigned)(rav[tt] >> 32);
                const float rr[4] = {bflo(rlo), bfhi(rlo), bflo(rhi), bfhi(rhi)};
                v4u w;
#pragma unroll
                for (int r = 0; r < 4; ++r) { const float gate = ggl[r] * rr[r] * __builtin_amdgcn_rcpf(1.f + __expf(-rr[r])); w[r] = cvtpk(acc[r], gate); }
                ((GAS v4u*)(args.ws + WS_GOG))[(((size_t)u * 8 + wave) * 4 + tt) * 64 + lane] = w;
            }
#pragma unroll
            for (int dt = 0; dt < 4; ++dt) {
                f32x4 acc = {0.f, 0.f, 0.f, 0.f};
#pragma unroll
                for (int ks = 0; ks < 2; ++ks) { const bf16x8 a = *(const LAS bf16x8*)(keT + (16 * dt + fr) * RS + (32 * ks + 8 * g) * 2); acc = __builtin_amdgcn_mfma_f32_16x16x32_bf16(a, vb[ks], acc, 0, 0, 0); }
                const unsigned long long w = (unsigned long long)cvtpk(acc[0], acc[1]) | ((unsigned long long)cvtpk(acc[2], acc[3]) << 32);
                ((GAS unsigned long long*)(args.ws + WS_GKV))[(((size_t)u * 8 + wave) * 4 + dt) * 64 + lane] = w;
            }
            LDS_WAIT(); __syncthreads();
        }
        }
    }
    { LANE_DECL; xcd_barrier(bar, wave == 0 && lane == 0); }

    for (int rep_ = 0; rep_ < REP_P2; ++rep_) {
    for (int rep3_ = 0; rep3_ < REP_SEQ; ++rep3_)
    if (bx < 32) {
        LANE_DECL;
        const int fr = lane & 15, g = lane >> 4;
        const int b = bx >> 2, h = bx & 3;
        LAS float* const ssqb = (LAS float*)(L + RING_OFF);
        LAS float* const rstdl = ssqb + 1024 + wave * 64;
        f32x4 S[4];
#pragma unroll
        for (int dt = 0; dt < 4; ++dt) S[dt] = (f32x4){0.f, 0.f, 0.f, 0.f};
        const GAS v4u* const gog = (const GAS v4u*)(args.ws + WS_GOG);
        const GAS unsigned long long* const gkv = (const GAS unsigned long long*)(args.ws + WS_GKV);
        const GAS v4u* const gqd = (const GAS v4u*)(args.ws + WS_GQD);
        const GAS f32x4* const gdec = (const GAS f32x4*)(args.ws + WS_GDEC);
        const int u0 = bx * 64;
        v4u ogA[4], ogB[4]; unsigned long long kvA[4], kvB[4]; v4u qdA[8], qdB[8]; f32x4 dcA[4], dcB[4];
#define GLA_LOAD(og_, kv_, qd_, dc_, uu) do { const size_t u_ = (size_t)(uu); \
        _Pragma("unroll") for (int q = 0; q < 4; ++q) { og_[q] = gog[((u_ * 8 + wave) * 4 + q) * 64 + lane]; kv_[q] = gkv[((u_ * 8 + wave) * 4 + q) * 64 + lane]; dc_[q] = gdec[u_ * 16 + 4 * q + g]; } \
        _Pragma("unroll") for (int q = 0; q < 8; ++q) qd_[q] = gqd[(u_ * 8 + q) * 64 + lane]; } while (0)
#define GLA_STEP(og_, kv_, qd_, dc_, n_) do { \
            const int t0 = b * SEQ + (n_) * 64; \
            bf16x8 sa[2];                                                   \
            _Pragma("unroll") for (int ks = 0; ks < 2; ++ks) { v4u w; w.x = cvtpk(S[2 * ks][0], S[2 * ks][1]); w.y = cvtpk(S[2 * ks][2], S[2 * ks][3]); w.z = cvtpk(S[2 * ks + 1][0], S[2 * ks + 1][1]); w.w = cvtpk(S[2 * ks + 1][2], S[2 * ks + 1][3]); sa[ks] = __builtin_bit_cast(bf16x8, w); } \
            f32x4 o[4]; f32x4 gt[4];                                        \
            _Pragma("unroll") for (int tt = 0; tt < 4; ++tt) { \
                f32x4 acc; \
                _Pragma("unroll") for (int r = 0; r < 4; ++r) { acc[r] = bflo(og_[tt][r]); gt[tt][r] = bfhi(og_[tt][r]); } \
                _Pragma("unroll") for (int ks = 0; ks < 2; ++ks) acc = __builtin_amdgcn_mfma_f32_16x16x32_bf16(sa[ks], __builtin_bit_cast(bf16x8, qd_[2 * tt + ks]), acc, 0, 0, 0); \
                o[tt] = acc; } \
            _Pragma("unroll") for (int dt = 0; dt < 4; ++dt) { const unsigned lo = (unsigned)kv_[dt], hi = (unsigned)(kv_[dt] >> 32); \
                S[dt][0] = S[dt][0] * dc_[dt][0] + bflo(lo); S[dt][1] = S[dt][1] * dc_[dt][1] + bfhi(lo); S[dt][2] = S[dt][2] * dc_[dt][2] + bflo(hi); S[dt][3] = S[dt][3] * dc_[dt][3] + bfhi(hi); } \
            LAS float* const sq = ssqb + ((n_) & 1) * 512; \
            _Pragma("unroll") for (int tt = 0; tt < 4; ++tt) { float s2 = (o[tt][0] * o[tt][0] + o[tt][1] * o[tt][1]) + (o[tt][2] * o[tt][2] + o[tt][3] * o[tt][3]); s2 = add_x32(add_x16(s2)); if (g == 0) sq[wave * 64 + 16 * tt + fr] = s2; } \
            LDS_WAIT(); __syncthreads(); \
            { float tot = 0.f; \
              _Pragma("unroll") for (int w2 = 0; w2 < 8; ++w2) tot += sq[w2 * 64 + lane]; \
              rstdl[lane] = __builtin_amdgcn_rsqf(tot * (1.f / 128.f) + EPS); } \
            LDS_WAIT(); asm volatile("" ::: "memory"); \
            _Pragma("unroll") for (int tt = 0; tt < 4; ++tt) { \
                const float rs = rstdl[16 * tt + fr]; \
                const unsigned long long w = (unsigned long long)cvtpk(o[tt][0] * rs * gt[tt][0], o[tt][1] * rs * gt[tt][1]) | ((unsigned long long)cvtpk(o[tt][2] * rs * gt[tt][2], o[tt][3] * rs * gt[tt][3]) << 32); \
                *(GAS unsigned long long*)(mix + (size_t)(t0 + 16 * tt + fr) * D + h * 128 + 16 * wave + 4 * g) = w; } \
            LDS_WAIT(); asm volatile("" ::: "memory"); } while (0)
        GLA_LOAD(ogA, kvA, qdA, dcA, u0);
        for (int n = 0; n < 64; n += 2) {
            GLA_LOAD(ogB, kvB, qdB, dcB, u0 + n + 1);
            GLA_STEP(ogA, kvA, qdA, dcA, n);
            if (n + 2 < 64) GLA_LOAD(ogA, kvA, qdA, dcA, u0 + n + 2);
            GLA_STEP(ogB, kvB, qdB, dcB, n + 1);
        }
#undef GLA_LOAD
#undef GLA_STEP
        __syncthreads();
    }
    for (int rep2_ = 0; rep2_ < REP_DSW; ++rep2_)
    {
        LANE_DECL;
        const int fr = lane & 15, g = lane >> 4;
        constexpr int OROW = 68;
        LAS float* const Ob = (LAS float*)(L + RING_OFF);
        constexpr int VROW = 160;
        LAS unsigned char* const Vst = L + RING_OFF + 256 * OROW * 4 + wave * (32 * VROW);
        volatile LAS int* const ubox = (volatile LAS int*)(L + MISC_OFF + 64);
        const float C2 = 0.125f * 1.4426950408889634f;
        for (;;) {
            if (wave == 0 && lane == 0) ubox[0] = (int)__hip_atomic_fetch_add(ctl + CW_DSW + 64 * (rep_ * 4 + rep2_), 1u, __ATOMIC_RELAXED, __HIP_MEMORY_SCOPE_AGENT);
            __syncthreads();
            const int unit = __builtin_amdgcn_readfirstlane(ubox[0]);
            if (unit >= 1024) break;
            const int sp = unit & 15, h = (unit >> 4) & 7, b = unit >> 7;
            const int s0 = sp * 256;
            const bf16* const base = proj + (size_t)b * SEQ * INC;
#pragma unroll 1
            for (int pt = 0; pt < 3; ++pt) {
                const int dl = (pt == 0) ? 0 : ((pt == 1) ? 2 : 4), d = 1 << dl;
#pragma unroll 1
                for (int rep = 0; rep < 2; ++rep) {
                    const int qt = wave + 8 * rep;
                    const int rr = qt & (d - 1), jj = qt >> dl;
                    const int tq0 = s0 + rr + ((16 * jj) << dl);
                    const int tkb = tq0 - (128 << dl);
                    bf16x8 qf[2];
#pragma unroll
                    for (int ks = 0; ks < 2; ++ks) qf[ks] = *(const GAS bf16x8*)(base + (size_t)(tq0 + (fr << dl)) * INC + OFF_QB + h * 64 + 32 * ks + 8 * g);
                    f32x4 O[4];
#pragma unroll
                    for (int dvt = 0; dvt < 4; ++dvt) O[dvt] = (f32x4){0.f, 0.f, 0.f, 0.f};
                    float m = -INFINITY, l = 0.f;
                    int cmin = 0;
                    while (tkb + ((32 * cmin + 31) << dl) < 0) ++cmin;
                    bf16x8 kfA[2][2], kfB[2][2]; v4u vrA[4], vrB[4];
#define DSW_LOAD(kf_, vr_, c_) do { const int k0_ = 32 * (c_); \
                        _Pragma("unroll") for (int kt = 0; kt < 2; ++kt) { int tk = tkb + ((k0_ + 16 * kt + fr) << dl); tk = tk < 0 ? 0 : (tk > SEQ - 1 ? SEQ - 1 : tk); \
                            _Pragma("unroll") for (int ks = 0; ks < 2; ++ks) kf_[kt][ks] = *(const GAS bf16x8*)(base + (size_t)tk * INC + OFF_KB + h * 64 + 32 * ks + 8 * g); } \
                        _Pragma("unroll") for (int it = 0; it < 4; ++it) { const int pc = lane + 64 * it, key = pc >> 3, ch = pc & 7; int tk = tkb + ((k0_ + key) << dl); tk = tk < 0 ? 0 : (tk > SEQ - 1 ? SEQ - 1 : tk); \
                            vr_[it] = *(const GAS v4u*)(base + (size_t)tk * INC + OFF_VB + h * 64 + 8 * ch); } } while (0)
#define DSW_STEP(kf_, vr_, c_) do { const int k0 = 32 * (c_); \
                        _Pragma("unroll") for (int it = 0; it < 4; ++it) { const int pc = lane + 64 * it, key = pc >> 3, ch = pc & 7; *(LAS v4u*)(Vst + key * VROW + ch * 16) = vr_[it]; } \
                        f32x4 sc[2]; \
                        _Pragma("unroll") for (int kt = 0; kt < 2; ++kt) { f32x4 acc = {0.f, 0.f, 0.f, 0.f}; \
                            _Pragma("unroll") for (int ks = 0; ks < 2; ++ks) acc = __builtin_amdgcn_mfma_f32_16x16x32_bf16(kf_[kt][ks], qf[ks], acc, 0, 0, 0); \
                            sc[kt] = acc; } \
                        float sv[8]; float cmax = -INFINITY; \
                        _Pragma("unroll") for (int kt = 0; kt < 2; ++kt) \
                            _Pragma("unroll") for (int r = 0; r < 4; ++r) { const int kk = k0 + 16 * kt + 4 * g + r; const bool ok = (kk >= fr) & (kk <= fr + 128) & (tkb + (kk << dl) >= 0); \
                                const float v = ok ? sc[kt][r] * C2 : -INFINITY; sv[4 * kt + r] = v; cmax = fmaxf(cmax, v); } \
                        cmax = max_x32(max_x16(cmax)); \
                        const float mn = fmaxf(m, cmax);                    \
                        const float alpha = __builtin_amdgcn_exp2f(m - mn); \
                        float pex[8]; float ps = 0.f; \
                        _Pragma("unroll") for (int e = 0; e < 8; ++e) { pex[e] = __builtin_amdgcn_exp2f(sv[e] - mn); ps += pex[e]; } \
                        l = l * alpha + ps; m = mn; \
                        v4u pw; pw.x = cvtpk(pex[0], pex[1]); pw.y = cvtpk(pex[2], pex[3]); pw.z = cvtpk(pex[4], pex[5]); pw.w = cvtpk(pex[6], pex[7]); \
                        const bf16x8 pb8 = __builtin_bit_cast(bf16x8, pw); \
                        LDS_WAIT(); asm volatile("" ::: "memory"); \
                        _Pragma("unroll") for (int dvt = 0; dvt < 4; ++dvt) { \
                            const s16x4 lo = __builtin_amdgcn_ds_read_tr16_b64_v4i16((LAS s16x4*)(Vst + (4 * g + (fr >> 2)) * VROW + (16 * dvt + 4 * (fr & 3)) * 2)); \
                            const s16x4 hi = __builtin_amdgcn_ds_read_tr16_b64_v4i16((LAS s16x4*)(Vst + (16 + 4 * g + (fr >> 2)) * VROW + (16 * dvt + 4 * (fr & 3)) * 2)); \
                            bf16x8 va; va[0] = lo[0]; va[1] = lo[1]; va[2] = lo[2]; va[3] = lo[3]; va[4] = hi[0]; va[5] = hi[1]; va[6] = hi[2]; va[7] = hi[3]; \
                            O[dvt] = __builtin_amdgcn_mfma_f32_16x16x32_bf16(va, pb8, O[dvt] * alpha, 0, 0, 0); } \
                        LDS_WAIT(); asm volatile("" ::: "memory");         \
                    } while (0)
                    DSW_LOAD(kfA, vrA, 4);
                    if (3 >= cmin) DSW_LOAD(kfB, vrB, 3);
                    DSW_STEP(kfA, vrA, 4);
                    if (3 >= cmin) {
                        if (2 >= cmin) DSW_LOAD(kfA, vrA, 2);
                        DSW_STEP(kfB, vrB, 3);
                        if (2 >= cmin) {
                            if (1 >= cmin) DSW_LOAD(kfB, vrB, 1);
                            DSW_STEP(kfA, vrA, 2);
                            if (1 >= cmin) {
                                if (0 >= cmin) DSW_LOAD(kfA, vrA, 0);
                                DSW_STEP(kfB, vrB, 1);
                                if (0 >= cmin) DSW_STEP(kfA, vrA, 0);
                            }
                        }
                    }
#undef DSW_LOAD
#undef DSW_STEP
                    l = add_x32(add_x16(l));
                    const int row = (tq0 - s0) + (fr << dl);
                    LAS float* orow = Ob + row * OROW;
                    if (pt > 0) {
                        const float m1 = orow[64], l1 = orow[65];
                        const float mn = fmaxf(m, m1), a0 = __builtin_amdgcn_exp2f(m - mn), a1 = __builtin_amdgcn_exp2f(m1 - mn);
#pragma unroll
                        for (int dvt = 0; dvt < 4; ++dvt) { const f32x4 o1 = *(const LAS f32x4*)(orow + 16 * dvt + 4 * g); O[dvt] = O[dvt] * a0 + o1 * a1; }
                        l = l * a0 + l1 * a1; m = mn;
                    }
                    if (pt < 2) {
#pragma unroll
                        for (int dvt = 0; dvt < 4; ++dvt) *(LAS f32x4*)(orow + 16 * dvt + 4 * g) = O[dvt];
                        if (g == 0) { orow[64] = m; orow[65] = l; }
                    } else {
                        const float rl = 1.f / l;
#pragma unroll
                        for (int dvt = 0; dvt < 4; ++dvt) { const unsigned long long w = (unsigned long long)pk2(O[dvt][0] * rl, O[dvt][1] * rl) | ((unsigned long long)pk2(O[dvt][2] * rl, O[dvt][3] * rl) << 32);
                            *(GAS unsigned long long*)(mix + (size_t)(b * SEQ + s0 + row) * D + 512 + h * 64 + 16 * dvt + 4 * g) = w; }
                    }
                }
                LDS_WAIT(); __syncthreads();
            }
        }
    }
    }
    { LANE_DECL; xcd_barrier(bar, wave == 0 && lane == 0); }

    for (int rep_ = 0; rep_ < REP_P3; ++rep_) {
        pg8::Gemm g{mix, Bt_out, T, D, D}; pg8::StaticOrder S; S.init(T, D, G, bx);
        pg8::EpiOutProj E{xin, x1b, ssq1};
        pg8::gemm_phase<pg8::EpiOutProj, pg8::StaticOrder, true, true>(L + RING_OFF, g, S, E, wave);
    }
    { LANE_DECL; xcd_barrier(bar, wave == 0 && lane == 0); }

    for (int rep_ = 0; rep_ < REP_P4; ++rep_) {
        pg8::Gemm g{x1b, Bt_pq, T, 2048, D}; pg8::StaticOrder S; S.init(T, 2048, G, bx);
        pg8::EpiPeerQ E{qr, ssq1};
        pg8::gemm_phase<pg8::EpiPeerQ, pg8::StaticOrder, true, true>(L + RING_OFF, g, S, E, wave);
    }
    { LANE_DECL; xcd_barrier(bar, wave == 0 && lane == 0); }

    for (int rep_ = 0; rep_ < REP_P5; ++rep_) {
        LANE_DECL;
        const int fr = lane & 15, g = lane >> 4;
        constexpr int KROW = 272;
        const int h = bx & 7, nbh = G >> 3;
        {
            const GAS v4u* src = (const GAS v4u*)(keysb + (size_t)h * 2 * 128 * 128);
            for (int pc = wave * 64 + lane; pc < 4096; pc += NWAVES * 64) { const int R = pc >> 4, ch = pc & 15; *(LAS v4u*)(L + RING_OFF + R * KROW + ch * 16) = src[pc]; }
        }
        LAS int* const scr = (LAS int*)(L + RING_OFF + 256 * KROW + wave * (16 * 33 * 4));
        __syncthreads();
        for (int tg = (bx >> 3) * NWAVES + wave; tg < T / 16; tg += nbh * NWAVES) {
            const int tok0 = tg * 16;
            int top[2][16];
#pragma unroll
            for (int c = 0; c < 2; ++c) {
                bf16x8 bq[4];
#pragma unroll
                for (int ks = 0; ks < 4; ++ks) bq[ks] = *(const GAS bf16x8*)(qr + (size_t)(tok0 + fr) * 2048 + h * 256 + c * 128 + 32 * ks + 8 * g);
                int v[32];
#pragma unroll
                for (int tl = 0; tl < 8; ++tl) {
                    f32x4 acc = {0.f, 0.f, 0.f, 0.f};
#pragma unroll
                    for (int ks = 0; ks < 4; ++ks) { const bf16x8 a = *(const LAS bf16x8*)(L + RING_OFF + (c * 128 + 16 * tl + fr) * KROW + (32 * ks + 8 * g) * 2);
                        acc = __builtin_amdgcn_mfma_f32_16x16x32_bf16(a, bq[ks], acc, 0, 0, 0); }
#pragma unroll
                    for (int r = 0; r < 4; ++r) v[4 * tl + r] = (f2key(acc[r]) & ~0x7f) | (16 * tl + 4 * g + r);
                }
                bitonic_sort_desc<32>(v);
#pragma unroll
                for (int i = 0; i < 16; ++i) top[c][i] = v[i];
                merge_top16(top[c], lane ^ 16);
                merge_top16(top[c], lane ^ 32);
            }
            float fa[16], fb[16];
#pragma unroll
            for (int i = 0; i < 16; ++i) { fa[i] = key2f(top[0][i]); fb[i] = key2f(top[1][i]); }
            int cand[16];
#pragma unroll
            for (int sl = 0; sl < 16; ++sl) {
                int cv[4];
#pragma unroll
                for (int gg = 0; gg < 4; ++gg) { constexpr int NEG = (int)0x80000000;
                    const int n = 16 * gg + sl;
                    if (kCand.i[n] >= 0) cv[gg] = (f2key(fa[kCand.i[n] < 0 ? 0 : kCand.i[n]] + fb[kCand.j[n] < 0 ? 0 : kCand.j[n]]) & ~0xff) | (kCand.i[n] * 16 + kCand.j[n]); else cv[gg] = NEG; }
                cand[sl] = (g == 0) ? cv[0] : ((g == 1) ? cv[1] : ((g == 2) ? cv[2] : cv[3]));
            }
            bitonic_sort_desc<16>(cand);
            merge_top16(cand, lane ^ 16);
            merge_top16(cand, lane ^ 32);
#pragma unroll
            for (int i = 0; i < 16; ++i) { if (g == (i >> 3)) scr[fr * 33 + i] = top[0][i] & 0x7f; if (g == 2 + (i >> 3)) scr[fr * 33 + 16 + i] = top[1][i] & 0x7f; }
            float ex[16]; float den = 0.f; const float m0 = key2f(cand[0]);
#pragma unroll
            for (int r = 0; r < 16; ++r) { ex[r] = __expf(key2f(cand[r]) - m0); den += ex[r]; }
            const float rden = 1.f / den;
            LDS_WAIT(); asm volatile("" ::: "memory");
            int oi[4]; float og[4];
#pragma unroll
            for (int q = 0; q < 4; ++q) {
                const int kq = (g == 0) ? cand[q] : ((g == 1) ? cand[4 + q] : ((g == 2) ? cand[8 + q] : cand[12 + q]));
                const float eq = (g == 0) ? ex[q] : ((g == 1) ? ex[4 + q] : ((g == 2) ? ex[8 + q] : ex[12 + q]));
                const int code = kq & 0xff;
                oi[q] = scr[fr * 33 + (code >> 4)] * 128 + scr[fr * 33 + 16 + (code & 15)]; og[q] = eq * rden;
            }
            GAS v4u* op = (GAS v4u*)(sel2 + (size_t)(tok0 + fr) * 128 + h * 16 + 4 * g);
            v4u o0, o1; o0.x = (unsigned)oi[0]; o0.y = __float_as_uint(og[0]); o0.z = (unsigned)oi[1]; o0.w = __float_as_uint(og[1]);
            o1.x = (unsigned)oi[2]; o1.y = __float_as_uint(og[2]); o1.z = (unsigned)oi[3]; o1.w = __float_as_uint(og[3]);
            op[0] = o0; op[1] = o1;
            LDS_WAIT(); asm volatile("" ::: "memory");
        }
        __syncthreads();
    }
    { LANE_DECL; xcd_barrier(bar, wave == 0 && lane == 0); }

    for (int rep_ = 0; rep_ < REP_P6; ++rep_) {
        LANE_DECL;
        const int g4 = lane >> 4, li = lane & 15;
        LAS i32x2* const selw = (LAS i32x2*)(L + RING_OFF + wave * 1024);
        for (int tok = gw; tok < T; tok += NGW) {
            const float s1 = (lane < 16) ? ssq1[(size_t)lane * T + tok] : 0.f;
            const float rstd1 = rsqrtf(wave_sum(s1) * (1.f / D) + EPS);
            v4u xw[8];
#pragma unroll
            for (int j = 0; j < 4; ++j) { xw[2 * j] = ((const GAS v4u*)(x1b + (size_t)tok * D))[32 * j + 2 * li]; xw[2 * j + 1] = ((const GAS v4u*)(x1b + (size_t)tok * D))[32 * j + 2 * li + 1]; }
            float acc[64];
#pragma unroll
            for (int k = 0; k < 64; ++k) acc[k] = 0.f;
            {
                const GAS i32x2* selg = (const GAS i32x2*)sel2 + (size_t)tok * 128;
                const i32x2 p0 = selg[lane], p1 = selg[lane + 64];
                const int b0 = p0.x >> 11, b1 = p1.x >> 11;
                const unsigned long long lt = (1ull << lane) - 1ull;
                int base = 0, r0 = 0, r1 = 0;
#pragma unroll
                for (int bk = 0; bk < 8; ++bk) {
                    const unsigned long long m0 = __ballot(b0 == bk), m1 = __ballot(b1 == bk);
                    const int c0 = __popcll(m0), c1 = __popcll(m1);
                    if (b0 == bk) r0 = base + __popcll(m0 & lt);
                    if (b1 == bk) r1 = base + c0 + __popcll(m1 & lt);
                    base += c0 + c1;
                }
                selw[r0] = p0; selw[r1] = p1;
                LDS_WAIT(); asm volatile("" ::: "memory");
            }
            const float ascale = rstd1 * (1.f / 64.f);
            i32x2 cur = selw[g4];
            for (int it = 0; it < 32; ++it) {
                const i32x2 nxt = selw[((it < 31) ? 4 * (it + 1) : 0) + g4];
                const GAS v4u* up = (const GAS v4u*)(Ub + (size_t)cur.x * 768) + li;
                const GAS v4u* vp = (const GAS v4u*)(Vb + (size_t)cur.x * 512) + li;
                const v4u u0 = up[0], u1 = up[16], u2 = up[32], v0 = vp[0], v1 = vp[16];
                float s = 0.f;
                { const u32x6 ga = {u0.x, u0.y, u0.z, u0.w, u1.x, u1.y};
                  const u32x16 d = __builtin_bit_cast(u32x16, __builtin_amdgcn_cvt_scalef32_pk32_bf16_fp6(ga, 1.0f));
#pragma unroll
                  for (int k = 0; k < 16; ++k) s = dot2bf(xw[k >> 2][k & 3], d[k], s); }
                { const u32x6 gb = {u1.z, u1.w, u2.x, u2.y, u2.z, u2.w};
                  const u32x16 d = __builtin_bit_cast(u32x16, __builtin_amdgcn_cvt_scalef32_pk32_bf16_fp6(gb, 1.0f));
#pragma unroll
                  for (int k = 0; k < 16; ++k) s = dot2bf(xw[4 + (k >> 2)][k & 3], d[k], s); }
                s = row_sum16(s);
                const float a = s * ascale;
                const float act = 0.5f * a * (1.f + erff(a * 0.70710678118654752f)) * __int_as_float(cur.y) * 0.25f;
#define PG_V4(bsel) { const f32x2 fa = __builtin_amdgcn_cvt_scalef32_pk_f32_fp4(v0[w], 1.0f, bsel), fb = __builtin_amdgcn_cvt_scalef32_pk_f32_fp4(v1[w], 1.0f, bsel); \
                        acc[8 * w + 2 * bsel] += act * fa.x; acc[8 * w + 2 * bsel + 1] += act * fa.y; acc[32 + 8 * w + 2 * bsel] += act * fb.x; acc[32 + 8 * w + 2 * bsel + 1] += act * fb.y; }
#pragma unroll
                for (int w = 0; w < 4; ++w) { PG_V4(0) PG_V4(1) PG_V4(2) PG_V4(3) }
#undef PG_V4
                cur = nxt;
            }
            float s2 = 0.f;
#pragma unroll
            for (int j = 0; j < 4; ++j) {
                float r[16];
#pragma unroll
                for (int e = 0; e < 16; ++e) { float v = acc[16 * j + e]; v += xshfl(v, lane ^ 16); v += xshfl(v, lane ^ 32);
                    const unsigned xwd = xw[2 * j + (e >> 3)][(e >> 1) & 3]; r[e] = v + ((e & 1) ? bfhi(xwd) : bflo(xwd)); s2 += r[e] * r[e]; }
                if (g4 == j) { v4u o0, o1; o0.x = pk2(r[0], r[1]); o0.y = pk2(r[2], r[3]); o0.z = pk2(r[4], r[5]); o0.w = pk2(r[6], r[7]); o1.x = pk2(r[8], r[9]); o1.y = pk2(r[10], r[11]); o1.z = pk2(r[12], r[13]); o1.w = pk2(r[14], r[15]);
                    ((GAS v4u*)(x2b + (size_t)tok * D))[32 * j + 2 * li] = o0; ((GAS v4u*)(x2b + (size_t)tok * D))[32 * j + 2 * li + 1] = o1; }
            }
            s2 = row_sum16(s2);
            if (lane == 0) rstd2[tok] = rsqrtf(s2 * (1.f / D) + EPS);
            LDS_WAIT(); asm volatile("" ::: "memory");
        }
    }
    { LANE_DECL; xcd_barrier(bar, wave == 0 && lane == 0); }

    for (int rep_ = 0; rep_ < REP_P7; ++rep_) {
        pg8::Gemm g{x2b, Bt_pg, T, D, D}; pg8::StaticOrder S; S.init(T, D, G, bx);
        pg8::EpiPle E{x2b, pproj, rstd2, x1b};
        pg8::gemm_phase<pg8::EpiPle, pg8::StaticOrder, true, true>(L + RING_OFF, g, S, E, wave);
    }
    { LANE_DECL; xcd_barrier(bar, wave == 0 && lane == 0); }

    {
    LANE_DECL;
    for (int row = gw; row < T; row += NGW) {
        const GAS v4u* xr = (const GAS v4u*)(x1b + (size_t)row * D);
        const v4u a = xr[lane], c = xr[64 + lane];
        float v[16];
        v[0] = bflo(a.x); v[1] = bfhi(a.x); v[2] = bflo(a.y); v[3] = bfhi(a.y); v[4] = bflo(a.z); v[5] = bfhi(a.z); v[6] = bflo(a.w); v[7] = bfhi(a.w);
        v[8] = bflo(c.x); v[9] = bfhi(c.x); v[10] = bflo(c.y); v[11] = bfhi(c.y); v[12] = bflo(c.z); v[13] = bfhi(c.z); v[14] = bflo(c.w); v[15] = bfhi(c.w);
        float s = 0.f;
#pragma unroll
        for (int k = 0; k < 16; ++k) s += v[k] * v[k];
        const float rstd = rsqrtf(wave_sum(s) * (1.f / D) + EPS);
        GAS f32x4* orow = (GAS f32x4*)(out + (size_t)row * D);
#pragma unroll
        for (int q = 0; q < 4; ++q) {
            const int e0 = (q < 2) ? (8 * lane + 4 * q) : (512 + 8 * lane + 4 * (q - 2));
            const f32x4 gg = *(const GAS f32x4*)(g_final + e0);
            f32x4 o; o.x = v[4 * q] * rstd * gg.x; o.y = v[4 * q + 1] * rstd * gg.y; o.z = v[4 * q + 2] * rstd * gg.z; o.w = v[4 * q + 3] * rstd * gg.w;
            orow[e0 >> 2] = o;
        }
    }
    }
}

#undef xin
#undef p_in
#undef positions
#undef g_mix
#undef w_in
#undef w_up
#undef b_gate
#undef g_gla
#undef w_out
#undef g_peer
#undef w_pq
#undef skeys
#undef pu
#undef pv
#undef g_ple
#undef w_pg
#undef w_pp
#undef g_final
#undef out
#undef Bt_in
#undef Bt_out
#undef Bt_pq
#undef Bt_pg
#undef Bt_pp
#undef rope
#undef ssq1
#undef rstd2
#undef h1
#undef x1b
#undef proj
#undef qr
#undef sel2
#undef Ub
#undef Vb
#undef keysb
#undef mix
#undef pb
#undef pproj
#undef x2b
extern "C" void kernel_launch(void* const* d_in, const int* in_sizes, int n_in, void* d_out, int out_size, void* d_ws, size_t ws_size, hipStream_t stream) {
    static int grid = 0;
    if (grid == 0) {
        if (n_in != 18 || out_size != T * D || ws_size < WS_END) { fprintf(stderr, "kernel_launch: unexpected shapes n_in %d out %d ws %zu\n", n_in, out_size, ws_size); grid = -1; return; }
        int dev = 0, cus = 0, per_cu = 0;
        if (hipGetDevice(&dev) != hipSuccess || hipDeviceGetAttribute(&cus, hipDeviceAttributeMultiprocessorCount, dev) != hipSuccess) { grid = -1; return; }
        if (hipFuncSetAttribute((const void*)mk_fwd, hipFuncAttributeMaxDynamicSharedMemorySize, LDS_BYTES) != hipSuccess) { fprintf(stderr, "kernel_launch: hipFuncSetAttribute failed\n"); grid = -1; return; }
        if (hipOccupancyMaxActiveBlocksPerMultiprocessor(&per_cu, (const void*)mk_fwd, NWAVES * 64, LDS_BYTES) != hipSuccess || per_cu < 1) fprintf(stderr, "kernel_launch: occupancy query reports %d\n", per_cu);
        (void)hipGetLastError();
        grid = cus;
    }
    if (grid < 0) return;
    if (hipMemsetAsync((char*)d_ws + WS_CTL, 0, CTL_ZERO_BYTES, stream) != hipSuccess) return;
    Args a{};
    for (int i = 0; i < 18; ++i) a.in[i] = (const float*)d_in[i];
    a.outp = (float*)d_out; a.ws = (unsigned char*)d_ws;
    hipLaunchKernelGGL(mk_fwd, dim3(grid), dim3(NWAVES * 64), LDS_BYTES, stream, a);
}
```

```cpp
#include <hip/hip_runtime.h>
#include <cstdio>
#include <cstdint>
namespace pg8 {
#define PG8_LAS __attribute__((address_space(3)))
typedef unsigned short bf16_t;
typedef short bf16x8 __attribute__((ext_vector_type(8)));
typedef float f32x4 __attribute__((ext_vector_type(4)));
typedef unsigned u32x4 __attribute__((ext_vector_type(4)));
constexpr int BM = 256, BK = 64, HALF = 128, HTB = HALF * BK * 2  , STAGE_BYTES = 8 * HTB, NXCD = 8, WGM = 8;

__host__ __device__ __forceinline__ int lds_byte(int r, int c) { const int st = (r >> 4) * 2 + (c >> 5), rr = r & 15, cc = c & 31, ob = rr * 64 + cc * 2; return st * 1024 + (ob ^ (((ob >> 9) & 1) << 5)); }
__host__ __device__ __forceinline__ void stage_rc(int b, int& R, int& C) { const int st = b / 1024, sb = b % 1024, swz = sb ^ (((sb >> 9) & 1) << 5); R = (st >> 1) * 16 + swz / 64; C = (st & 1) * 32 + (swz % 64) / 2; }
__host__ __device__ __forceinline__ int perm32(int rho) { const int n = rho >> 4, i = rho & 15; return 8 * (i >> 2) + 4 * n + (i & 3); }

struct Unit { int pm, pn; };
struct Gemm { const bf16_t* A; const bf16_t* Bt; int M, N, K; };

struct StaticOrder {
    int nM, nN, nwg, G, c;
    __host__ __device__ void init(int M, int N, int G_, int c_) { nM = M / BM; nN = N / BM; nwg = nM * nN; G = G_; c = c_; }
    __host__ __device__ bool next(int i, Unit& u) const {
        const long L = (long)i * G + c; if (L >= nwg) return false;
        int wgid = (int)L; { const int q = nwg / NXCD, r = nwg % NXCD, xcd = wgid % NXCD, off = wgid / NXCD; wgid = (xcd < r ? xcd * (q + 1) : r * (q + 1) + (xcd - r) * q) + off; }
        const int nig = WGM * nN, gid = wgid / nig, fm = gid * WGM, gsz = (nM - fm) < WGM ? (nM - fm) : WGM;
        u.pm = fm + ((wgid % nig) % gsz); u.pn = (wgid % nig) / gsz; return true;
    }
    __device__ __forceinline__ void a_ready(const Unit&) const {}
    __device__ __forceinline__ void done(const Unit&) const {}
};

__device__ __forceinline__ unsigned cvt_pk_bf16(float lo, float hi) { unsigned r; asm volatile("v_cvt_pk_bf16_f32 %0, %1, %2" : "=v"(r) : "v"(lo), "v"(hi)); return r; }
typedef float f32x2 __attribute__((ext_vector_type(2)));
__device__ __forceinline__ f32x2 gelu_pk(f32x2 v) {
    const f32x2 av = __builtin_elementwise_abs(v), d = av * 0.2316418882f + 1.0f;
    f32x2 t; t.x = __builtin_amdgcn_rcpf(d.x); t.y = __builtin_amdgcn_rcpf(d.y);
    f32x2 q = t * 0.5307027145f + (-0.7265760135f); q = q * t + 0.7107068705f; q = q * t + (-0.142248368f); q = q * t + 0.127414796f; q = q * t;
    const f32x2 s = (v * v) * (-0.72134752044f);
    f32x2 e; e.x = __builtin_amdgcn_exp2f(s.x); e.y = __builtin_amdgcn_exp2f(s.y);
    const f32x2 m = v * (q * e), r = v - m;
    f32x2 o; o.x = v.x < 0.f ? m.x : r.x; o.y = v.y < 0.f ? m.y : r.y; return o;
}

template <int ACT  > struct EpiBf16 {
    static constexpr bool PERM = true, AFTER_DRAIN = false; static_assert(ACT == 0 || ACT == 1, "EpiBf16: ACT is 0 (none) or 1 (gelu_pk)");
    bf16_t* O; int ldc; const float* bias; int split_cols; size_t split_stride; float scale0;
    __device__ __forceinline__ void operator()(const f32x4 (&acc)[2][2][4][2], const Unit& u, int wr, int wc, int fr, int fq) const {
        const int row0 = u.pm * BM + wr * 64 + fr; int colt = u.pn * BM; bf16_t* base = O;
        float sc = 1.f; if (split_cols) { const int t = colt / split_cols; base += (size_t)t * split_stride; colt -= t * split_cols; if (t == 0) sc = scale0; }
        const int col0 = colt + wc * 32 + 8 * fq, bcol0 = u.pn * BM + wc * 32 + 8 * fq;
        f32x4 bv[2][2];
#pragma unroll
        for (int bj = 0; bj < 2; ++bj)
#pragma unroll
            for (int n = 0; n < 2; ++n) bv[bj][n] = bias ? *(const f32x4*)(bias + bcol0 + bj * HALF + 4 * n) : (f32x4){0.f, 0.f, 0.f, 0.f};
#pragma unroll
        for (int ai = 0; ai < 2; ++ai)
#pragma unroll
            for (int m = 0; m < 4; ++m) { bf16_t* rowp = base + (size_t)(row0 + ai * HALF + m * 16) * ldc + col0;
#pragma unroll
                for (int bj = 0; bj < 2; ++bj) { f32x4 v0 = acc[ai][bj][m][0] + bv[bj][0], v1 = acc[ai][bj][m][1] + bv[bj][1];
                    if (ACT == 1) { f32x2 a = gelu_pk((f32x2){v0[0], v0[1]}), b = gelu_pk((f32x2){v0[2], v0[3]}), c = gelu_pk((f32x2){v1[0], v1[1]}), d = gelu_pk((f32x2){v1[2], v1[3]});
                        v0 = (f32x4){a.x, a.y, b.x, b.y}; v1 = (f32x4){c.x, c.y, d.x, d.y}; }
                    v0 = v0 * sc; v1 = v1 * sc; u32x4 w; w.x = cvt_pk_bf16(v0[0], v0[1]); w.y = cvt_pk_bf16(v0[2], v0[3]); w.z = cvt_pk_bf16(v1[0], v1[1]); w.w = cvt_pk_bf16(v1[2], v1[3]);
                    *(u32x4*)(rowp + bj * HALF) = w; } }
    }
};

__device__ __forceinline__ float xshfl(float v, int srclane) { return __int_as_float(__builtin_amdgcn_ds_bpermute(srclane << 2, __float_as_int(v))); }
constexpr int P_INC = 3328;
struct EpiInProj {
    static constexpr bool PERM = true, AFTER_DRAIN = false;
    bf16_t* O; const float* rope; const float* bgate;
    __device__ __forceinline__ void operator()(const f32x4 (&acc)[2][2][4][2], const Unit& u, int wr, int wc, int fr, int fq) const {
        const int row0 = u.pm * BM + wr * 64 + fr;
#pragma unroll
        for (int bj = 0; bj < 2; ++bj) {
            const int cb = u.pn * BM + bj * HALF + wc * 32;
            const int c0 = cb + 8 * fq;
            const bool ropechunk = (cb >= 1792) && (cb < 2816) && ((cb & 63) == 0);
            const bool lachunk = (cb >= 1536) && (cb < 1792);
            f32x4 bg0 = {0.f, 0.f, 0.f, 0.f}, bg1 = {0.f, 0.f, 0.f, 0.f};
            if (lachunk) { bg0 = *(const f32x4*)(bgate + c0 - 1536); bg1 = *(const f32x4*)(bgate + c0 - 1536 + 4); }
#pragma unroll
            for (int ai = 0; ai < 2; ++ai)
#pragma unroll
                for (int m = 0; m < 4; ++m) {
                    const int row = row0 + ai * HALF + m * 16;
                    f32x4 v0 = acc[ai][bj][m][0], v1 = acc[ai][bj][m][1];
                    if (lachunk) {
#pragma unroll
                        for (int e = 0; e < 4; ++e) { const float z0 = v0[e] + bg0[e], z1 = v1[e] + bg1[e];
                            v0[e] = (fminf(z0, 0.f) - __logf(1.f + __expf(-fabsf(z0)))) * (1.f / 16.f); v1[e] = (fminf(z1, 0.f) - __logf(1.f + __expf(-fabsf(z1)))) * (1.f / 16.f); }
                    }
                    if (ropechunk) {
                        f32x4 p0, p1;
#pragma unroll
                        for (int e = 0; e < 4; ++e) { p0[e] = xshfl(v0[e], (fq * 16 + fr) ^ 16); p1[e] = xshfl(v1[e], (fq * 16 + fr) ^ 16); }
                        if (fq < 2) {
                            const f32x4* cs = (const f32x4*)(rope + (size_t)row * 16);
                            const f32x4 t0 = cs[0], t1 = cs[1], t2 = cs[2], t3 = cs[3];
                            const float sg = (fq == 0) ? -1.f : 1.f;
                            v0[0] = v0[0] * t0[0] + sg * p0[0] * t0[1]; v0[1] = v0[1] * t0[2] + sg * p0[1] * t0[3];
                            v0[2] = v0[2] * t1[0] + sg * p0[2] * t1[1]; v0[3] = v0[3] * t1[2] + sg * p0[3] * t1[3];
                            v1[0] = v1[0] * t2[0] + sg * p1[0] * t2[1]; v1[1] = v1[1] * t2[2] + sg * p1[1] * t2[3];
                            v1[2] = v1[2] * t3[0] + sg * p1[2] * t3[1]; v1[3] = v1[3] * t3[2] + sg * p1[3] * t3[3];
                        }
                    }
                    { u32x4 w; w.x = cvt_pk_bf16(v0[0], v0[1]); w.y = cvt_pk_bf16(v0[2], v0[3]); w.z = cvt_pk_bf16(v1[0], v1[1]); w.w = cvt_pk_bf16(v1[2], v1[3]);
                        *(u32x4*)(O + (size_t)row * P_INC + c0) = w; }
                }
        }
    }
};
struct EpiOutProj {
    static constexpr bool PERM = true, AFTER_DRAIN = false;
    const float* X; bf16_t* O; float* ssq;
    __device__ __forceinline__ void operator()(const f32x4 (&acc)[2][2][4][2], const Unit& u, int wr, int wc, int fr, int fq) const {
        const int row0 = u.pm * BM + wr * 64 + fr, col0 = u.pn * BM + wc * 32 + 8 * fq;
#pragma unroll
        for (int ai = 0; ai < 2; ++ai)
#pragma unroll
            for (int m = 0; m < 4; ++m) {
                const int row = row0 + ai * HALF + m * 16; float s = 0.f;
#pragma unroll
                for (int bj = 0; bj < 2; ++bj) {
                    const float* xp = X + (size_t)row * 1024 + col0 + bj * HALF;
                    const f32x4 x0 = *(const f32x4*)xp, x1 = *(const f32x4*)(xp + 4);
                    const f32x4 v0 = acc[ai][bj][m][0] + x0, v1 = acc[ai][bj][m][1] + x1;
                    s += (v0[0] * v0[0] + v0[1] * v0[1]) + (v0[2] * v0[2] + v0[3] * v0[3]) + (v1[0] * v1[0] + v1[1] * v1[1]) + (v1[2] * v1[2] + v1[3] * v1[3]);
                    u32x4 w; w.x = cvt_pk_bf16(v0[0], v0[1]); w.y = cvt_pk_bf16(v0[2], v0[3]); w.z = cvt_pk_bf16(v1[0], v1[1]); w.w = cvt_pk_bf16(v1[2], v1[3]);
                    *(u32x4*)(O + (size_t)row * 1024 + col0 + bj * HALF) = w;
                }
                s += xshfl(s, (fq * 16 + fr) ^ 16); s += xshfl(s, (fq * 16 + fr) ^ 32);
                if (fq == 0) ssq[(size_t)(u.pn * 4 + wc) * 32768 + row] = s;
            }
    }
};
struct EpiPeerQ {
    static constexpr bool PERM = true, AFTER_DRAIN = false;
    bf16_t* O; const float* ssq;
    __device__ __forceinline__ void operator()(const f32x4 (&acc)[2][2][4][2], const Unit& u, int wr, int wc, int fr, int fq) const {
        const int row0 = u.pm * BM + wr * 64 + fr, col0 = u.pn * BM + wc * 32 + 8 * fq;
#pragma unroll
        for (int ai = 0; ai < 2; ++ai)
#pragma unroll
            for (int m = 0; m < 4; ++m) {
                const int row = row0 + ai * HALF + m * 16;
                float s = 0.f;
#pragma unroll
                for (int q = 0; q < 4; ++q) s += ssq[(size_t)(4 * fq + q) * 32768 + row];
                s += xshfl(s, (fq * 16 + fr) ^ 16); s += xshfl(s, (fq * 16 + fr) ^ 32);
                const float rstd = rsqrtf(s * (1.f / 1024.f) + 1e-6f);
#pragma unroll
                for (int bj = 0; bj < 2; ++bj) {
                    const f32x4 v0 = acc[ai][bj][m][0] * rstd, v1 = acc[ai][bj][m][1] * rstd;
                    u32x4 w; w.x = cvt_pk_bf16(v0[0], v0[1]); w.y = cvt_pk_bf16(v0[2], v0[3]); w.z = cvt_pk_bf16(v1[0], v1[1]); w.w = cvt_pk_bf16(v1[2], v1[3]);
                    *(u32x4*)(O + (size_t)row * 2048 + col0 + bj * HALF) = w;
                }
            }
    }
};
struct EpiPle {
    static constexpr bool PERM = true, AFTER_DRAIN = false;
    const bf16_t* X2; const bf16_t* PP; const float* rstd2; bf16_t* O;
    __device__ __forceinline__ void operator()(const f32x4 (&acc)[2][2][4][2], const Unit& u, int wr, int wc, int fr, int fq) const {
        const int row0 = u.pm * BM + wr * 64 + fr, col0 = u.pn * BM + wc * 32 + 8 * fq;
#pragma unroll
        for (int ai = 0; ai < 2; ++ai)
#pragma unroll
            for (int m = 0; m < 4; ++m) {
                const int row = row0 + ai * HALF + m * 16;
                const float rstd = rstd2[row];
#pragma unroll
                for (int bj = 0; bj < 2; ++bj) {
                    const size_t off = (size_t)row * 1024 + col0 + bj * HALF;
                    const u32x4 xw = *(const u32x4*)(X2 + off), pw = *(const u32x4*)(PP + off);
                    f32x4 o0, o1;
#pragma unroll
                    for (int e = 0; e < 4; ++e) {
                        const unsigned xe = (e < 2) ? ((e == 0) ? xw.x : xw.y) : ((e == 2) ? xw.z : xw.w);
                        const unsigned pe = (e < 2) ? ((e == 0) ? pw.x : pw.y) : ((e == 2) ? pw.z : pw.w);
                        const float xlo = __uint_as_float(xe << 16), xhi = __uint_as_float(xe & 0xffff0000u);
                        const float plo = __uint_as_float(pe << 16), phi = __uint_as_float(pe & 0xffff0000u);
                        const float a0 = (e < 2) ? acc[ai][bj][m][0][2 * e] : acc[ai][bj][m][1][2 * e - 4];
                        const float a1 = (e < 2) ? acc[ai][bj][m][0][2 * e + 1] : acc[ai][bj][m][1][2 * e - 3];
                        const float g0 = 1.f / (1.f + __expf(-a0 * rstd)), g1 = 1.f / (1.f + __expf(-a1 * rstd));
                        const float r0 = xlo + plo * g0, r1 = xhi + phi * g1;
                        if (e < 2) { o0[2 * e] = r0; o0[2 * e + 1] = r1; } else { o1[2 * e - 4] = r0; o1[2 * e - 3] = r1; }
                    }
                    { u32x4 w; w.x = cvt_pk_bf16(o0[0], o0[1]); w.y = cvt_pk_bf16(o0[2], o0[3]); w.z = cvt_pk_bf16(o1[0], o1[1]); w.w = cvt_pk_bf16(o1[2], o1[3]); *(u32x4*)(O + off) = w; }
                }
            }
    }
};
template <class Epi, class Sched, bool ALIGN_EPI = false, bool SP2 = false>
__device__ __forceinline__ void gemm_phase(PG8_LAS unsigned char* lds, const Gemm g, const Sched& S, const Epi& E, const int wave_id  ) {
    int lane_; asm volatile("v_mbcnt_lo_u32_b32 %0, -1, 0\n\tv_mbcnt_hi_u32_b32 %0, -1, %0" : "=v"(lane_)); int tid_ = wave_id * 64 + lane_;
    const int tid = tid_, wid = wave_id, lane = tid & 63, wr = wid >> 2, wc = wid & 3, fr = lane & 15, fq = lane >> 4;
    const int K = g.K, nt = K / BK;
    unsigned voffA[2], voffB[2];
#pragma unroll
    for (int i = 0; i < 2; ++i) { int R, C; stage_rc(tid * 16 + i * 8192, R, C); const int Rb = Epi::PERM ? ((R & ~31) + perm32(R & 31)) : R;
        voffA[i] = (unsigned)(R * K + C) * 2u; voffB[i] = (unsigned)(Rb * K + C) * 2u; }
    const size_t kstep = (size_t)(BK * 2);
    const size_t hstep = (size_t)HALF * K * 2;
    const size_t tstep = 2 * hstep;
    const unsigned ldsw = (unsigned)wid * 1024u;
    const int aoff = lds_byte(wr * 64 + fr, fq * 8), boff = lds_byte(wc * 32 + fr, fq * 8);
#define PG8_SA(b, h) (((b) * 2 + (h)) * HTB)
#define PG8_SB(b, h) ((4 + (b) * 2 + (h)) * HTB)
#define PG8_STAGE(bufoff, gbase, voff) do { _Pragma("unroll") for (int _i = 0; _i < 2; ++_i) \
        __builtin_amdgcn_global_load_lds((const unsigned*)((const char*)(gbase) + (voff)[_i]), (PG8_LAS unsigned*)(lds + (bufoff) + ldsw + _i * 8192), 16, 0, 0); } while (0)
#define PG8_LDA(dst, b, h) do { _Pragma("unroll") for (int m = 0; m < 4; ++m) _Pragma("unroll") for (int k = 0; k < 2; ++k) dst[m][k] = *(const PG8_LAS bf16x8*)(lds + PG8_SA(b, h) + aoff + m * 2048 + k * 1024); } while (0)
#define PG8_LDB(dst, b, h) do { _Pragma("unroll") for (int n = 0; n < 2; ++n) _Pragma("unroll") for (int k = 0; k < 2; ++k) dst[n][k] = *(const PG8_LAS bf16x8*)(lds + PG8_SB(b, h) + boff + n * 2048 + k * 1024); } while (0)
#define PG8_MMA(ai, bj, At, Bt) do { __builtin_amdgcn_s_setprio(1); _Pragma("unroll") for (int m = 0; m < 4; ++m) _Pragma("unroll") for (int n = 0; n < 2; ++n) _Pragma("unroll") for (int k = 0; k < 2; ++k) \
        acc[ai][bj][m][n] = __builtin_amdgcn_mfma_f32_16x16x32_bf16(Bt[n][k], At[m][k], acc[ai][bj][m][n], 0, 0, 0); __builtin_amdgcn_s_setprio(0); } while (0)
#define PG8_WAIT_V(n) asm volatile("s_waitcnt vmcnt(" #n ")" ::: "memory")
#define PG8_WAIT_L(n) asm volatile("s_waitcnt lgkmcnt(" #n ")" ::: "memory")
#define PG8_BAR __builtin_amdgcn_s_barrier()
#define PG8_SCHED __builtin_amdgcn_sched_barrier(0)
    Unit cur, nxt; int ui = 0;
    if (!S.next(0, cur)) return;
    f32x4 acc[2][2][4][2];
#pragma unroll
    for (int a = 0; a < 2; ++a)
#pragma unroll
        for (int b = 0; b < 2; ++b)
#pragma unroll
            for (int m = 0; m < 4; ++m)
#pragma unroll
                for (int n = 0; n < 2; ++n) acc[a][b][m][n] = (f32x4){0.f, 0.f, 0.f, 0.f};
    bf16x8 At[4][2], B0[2][2], B1[2][2];
    const char* cA = (const char*)g.A + (size_t)cur.pm * tstep; const char* cB = (const char*)g.Bt + (size_t)cur.pn * tstep;
    S.a_ready(cur);
    if constexpr (SP2) {
        PG8_STAGE(PG8_SB(0, 0), cB, voffB); PG8_STAGE(PG8_SB(0, 1), cB + hstep, voffB); PG8_STAGE(PG8_SA(0, 0), cA, voffA); PG8_STAGE(PG8_SA(0, 1), cA + hstep, voffA);
        if (wr == 1) PG8_BAR;
        PG8_WAIT_V(2); PG8_BAR;
        PG8_STAGE(PG8_SB(1, 0), cB + kstep, voffB); PG8_STAGE(PG8_SA(1, 0), cA + kstep, voffA); PG8_STAGE(PG8_SB(1, 1), cB + hstep + kstep, voffB);
        PG8_WAIT_V(6); PG8_BAR;
    } else {
        PG8_STAGE(PG8_SB(0, 0), cB, voffB); PG8_STAGE(PG8_SA(0, 0), cA, voffA); PG8_STAGE(PG8_SB(0, 1), cB + hstep, voffB); PG8_STAGE(PG8_SA(0, 1), cA + hstep, voffA);
        if (wr == 1) PG8_BAR;
        PG8_WAIT_V(4); PG8_BAR;
        PG8_STAGE(PG8_SB(1, 0), cB + kstep, voffB); PG8_STAGE(PG8_SA(1, 0), cA + kstep, voffA); PG8_STAGE(PG8_SB(1, 1), cB + hstep + kstep, voffB);
        PG8_WAIT_V(6); PG8_BAR;
    }
    for (;;) {
        const bool has_next = S.next(ui + 1, nxt);
        const char* nA = has_next ? (const char*)g.A + (size_t)nxt.pm * tstep : cA; const char* nB = has_next ? (const char*)g.Bt + (size_t)nxt.pn * tstep : cB;
        for (int t = 0; t < nt; t += 2) {
            const bool last = (t == nt - 2);
            const char* a1 = cA + (size_t)(t + 1) * kstep;
            const char* a2 = last ? nA : cA + (size_t)(t + 2) * kstep; const char* b2 = last ? nB : cB + (size_t)(t + 2) * kstep;
            const char* a3 = a2 + kstep; const char* b3 = b2 + kstep;
            if (last && has_next) S.a_ready(nxt);
            if constexpr (SP2) {
            PG8_LDB(B0, 0, 0); PG8_LDB(B1, 0, 1); PG8_SCHED; PG8_LDA(At, 0, 0); PG8_STAGE(PG8_SA(1, 1), a1 + hstep, voffA);
            PG8_WAIT_V(8); PG8_WAIT_L(0); PG8_BAR; PG8_MMA(0, 0, At, B0); PG8_MMA(0, 1, At, B1); PG8_BAR; PG8_SCHED;
            PG8_LDA(At, 0, 1); PG8_STAGE(PG8_SB(0, 0), b2, voffB); PG8_STAGE(PG8_SB(0, 1), b2 + hstep, voffB); PG8_STAGE(PG8_SA(0, 0), a2, voffA);
            PG8_WAIT_V(8); PG8_WAIT_L(0); PG8_BAR; PG8_MMA(1, 0, At, B0); PG8_MMA(1, 1, At, B1); PG8_BAR; PG8_SCHED;
            PG8_LDB(B0, 1, 0); PG8_LDB(B1, 1, 1); PG8_SCHED; PG8_LDA(At, 1, 0); PG8_STAGE(PG8_SA(0, 1), a2 + hstep, voffA);
            PG8_WAIT_V(8); PG8_WAIT_L(0); PG8_BAR; PG8_MMA(0, 0, At, B0); PG8_MMA(0, 1, At, B1); PG8_BAR; PG8_SCHED;
            PG8_LDA(At, 1, 1); PG8_STAGE(PG8_SB(1, 0), b3, voffB); PG8_STAGE(PG8_SB(1, 1), b3 + hstep, voffB); PG8_STAGE(PG8_SA(1, 0), a3, voffA);
            PG8_WAIT_V(8); PG8_WAIT_L(0); PG8_BAR; PG8_MMA(1, 0, At, B0); PG8_MMA(1, 1, At, B1); PG8_BAR; PG8_SCHED;
            } else {
            PG8_LDB(B0, 0, 0); PG8_SCHED; PG8_LDA(At, 0, 0); PG8_STAGE(PG8_SA(1, 1), a1 + hstep, voffA);
            PG8_WAIT_L(8); PG8_BAR; PG8_WAIT_L(0); PG8_MMA(0, 0, At, B0); PG8_BAR; PG8_SCHED;
            PG8_LDB(B1, 0, 1); PG8_STAGE(PG8_SB(0, 0), b2, voffB);
            PG8_BAR; PG8_WAIT_L(0); PG8_MMA(0, 1, At, B1); PG8_BAR;
            PG8_LDA(At, 0, 1); PG8_STAGE(PG8_SA(0, 0), a2, voffA);
            PG8_BAR; PG8_WAIT_L(0); PG8_MMA(1, 0, At, B0); PG8_BAR; PG8_SCHED;
            PG8_STAGE(PG8_SB(0, 1), b2 + hstep, voffB);
            PG8_WAIT_V(6); PG8_BAR; PG8_MMA(1, 1, At, B1); PG8_BAR;
            PG8_LDB(B0, 1, 0); PG8_SCHED; PG8_LDA(At, 1, 0); PG8_STAGE(PG8_SA(0, 1), a2 + hstep, voffA);
            PG8_WAIT_L(8); PG8_BAR; PG8_WAIT_L(0); PG8_MMA(0, 0, At, B0); PG8_BAR; PG8_SCHED;
            PG8_LDB(B1, 1, 1); PG8_STAGE(PG8_SB(1, 0), b3, voffB);
            PG8_BAR; PG8_WAIT_L(0); PG8_MMA(0, 1, At, B1); PG8_BAR;
            PG8_LDA(At, 1, 1); PG8_STAGE(PG8_SA(1, 0), a3, voffA);
            PG8_BAR; PG8_WAIT_L(0); PG8_MMA(1, 0, At, B0); PG8_BAR; PG8_SCHED;
            PG8_STAGE(PG8_SB(1, 1), b3 + hstep, voffB);
            PG8_WAIT_V(6); PG8_BAR; PG8_MMA(1, 1, At, B1); PG8_BAR;
            }
        }
        if constexpr (ALIGN_EPI) { if (wr == 0) PG8_BAR; }
        if constexpr (!Epi::AFTER_DRAIN) { E(acc, cur, wr, wc, fr, fq); S.done(cur); }
        if (!has_next) break;
#pragma unroll
        for (int a = 0; a < 2; ++a)
#pragma unroll
            for (int b = 0; b < 2; ++b)
#pragma unroll
                for (int m = 0; m < 4; ++m)
#pragma unroll
                    for (int n = 0; n < 2; ++n) acc[a][b][m][n] = (f32x4){0.f, 0.f, 0.f, 0.f};
        cur = nxt; cA = nA; cB = nB; ++ui;
        if constexpr (ALIGN_EPI) { if (wr == 1) PG8_BAR; }
    }
    PG8_WAIT_V(0);
    if constexpr (!ALIGN_EPI) { if (wr == 0) PG8_BAR; }
    PG8_BAR;
    if constexpr (Epi::AFTER_DRAIN) { E.fused(acc, cur, wr, wc, fr, fq, lds, wid, lane); S.done(cur); }
#undef PG8_SA
#undef PG8_SB
#undef PG8_STAGE
#undef PG8_LDA
#undef PG8_LDB
#undef PG8_MMA
#undef PG8_WAIT_V
#undef PG8_WAIT_L
#undef PG8_BAR
#undef PG8_SCHED
}
}

#define GAS __attribute__((address_space(1)))
#define LAS __attribute__((address_space(3)))
typedef unsigned short bf16;
typedef unsigned v4u __attribute__((ext_vector_type(4)));
typedef float f32x4 __attribute__((ext_vector_type(4)));
typedef short bf16x8 __attribute__((ext_vector_type(8)));
typedef GAS unsigned gu32;
typedef GAS unsigned long long gu64;
#define RLX_AGENT __ATOMIC_RELAXED, __HIP_MEMORY_SCOPE_AGENT
#define LDS_WAIT() asm volatile("s_waitcnt lgkmcnt(0)" ::: "memory")
#define VM_WAIT() asm volatile("s_waitcnt vmcnt(0)" ::: "memory")
__device__ __forceinline__ unsigned long long rt() { return __builtin_amdgcn_s_memrealtime(); }
__device__ __forceinline__ unsigned f2bf(float f) { unsigned u = __builtin_bit_cast(unsigned, f); return (u + 0x7fffu + ((u >> 16) & 1u)) >> 16; }
__device__ __forceinline__ unsigned pk2(float lo, float hi) { return f2bf(lo) | (f2bf(hi) << 16); }

#define XB_TMO      128
#define XB_XCNT(j)  (256  + 64 * (j))
#define XB_XSUB(j)  (1280 + 64 * (j))
#define XB_XGEN(j)  (2304 + 64 * (j))
#define XB_TOP      3328
#define XB_TOPGEN   3392
#define XCD_BAR_WORDS 3456
#define XB_SPIN_CAP (1u << 18)

__device__ __forceinline__ unsigned xb_ld(unsigned* p)              { return __hip_atomic_load(p, __ATOMIC_RELAXED, __HIP_MEMORY_SCOPE_AGENT); }
__device__ __forceinline__ unsigned xb_add(unsigned* p, unsigned v) { return __hip_atomic_fetch_add(p, v, __ATOMIC_RELAXED, __HIP_MEMORY_SCOPE_AGENT); }
__device__ __forceinline__ unsigned xb_xcc_id() { return (unsigned)__builtin_amdgcn_s_getreg((3 << 11) | 20) & 0xFu; }
#define XB_SPIN(cond, bar) do { unsigned _sp = 0; while (cond) { __builtin_amdgcn_s_sleep(1); \
    if ((++_sp & 255u) == 0u) { if (xb_ld(&(bar)[XB_TMO])) break; if (_sp > XB_SPIN_CAP) { atomicAdd(&(bar)[XB_TMO], 1u); break; } } } } while (0)

struct XcdBarrier {
    unsigned* bar; unsigned x;
    volatile LAS unsigned* st;
};

__device__ __forceinline__ XcdBarrier xcd_barrier_post(unsigned* bar, volatile LAS unsigned* st) {
    XcdBarrier b; b.bar = bar; b.x = xb_xcc_id(); b.st = st;
    if (threadIdx.x == 0) (void)xb_add(&bar[XB_XCNT(b.x)], 1u);
    return b;
}
__device__ __forceinline__ void xcd_barrier_complete(unsigned* bar, unsigned x, unsigned& nloc, unsigned& nx) {
    const unsigned G = gridDim.x * gridDim.y * gridDim.z;
    unsigned sum, cnt, mine, sp = 0u;
    for (;;) {
        sum = 0u; cnt = 0u; mine = 0u;
#pragma unroll
        for (unsigned j = 0; j < 16; ++j) { const unsigned c = xb_ld(&bar[XB_XCNT(j)]); sum += c; cnt += (c > 0u) ? 1u : 0u; mine = (j == x) ? c : mine; }
        if (sum == G) break;
        __builtin_amdgcn_s_sleep(1);
        if ((++sp & 255u) == 0u) { if (xb_ld(&bar[XB_TMO])) break; if (sp > XB_SPIN_CAP) { atomicAdd(&bar[XB_TMO], 1u); break; } }
    }
    nloc = mine > 0u ? mine : 1u; nx = cnt > 0u ? cnt : 1u;
}

__device__ __forceinline__ void xcd_barrier(const XcdBarrier& b, const bool leader  ) {
    asm volatile("s_waitcnt vmcnt(0)" ::: "memory");
    __syncthreads();
    if (leader) {
        unsigned* bar = b.bar;
        __builtin_amdgcn_s_waitcnt(0);
        unsigned nloc = b.st[0], nx = b.st[1];
        if (nloc == 0u) { xcd_barrier_complete(bar, b.x, nloc, nx); b.st[0] = nloc; b.st[1] = nx; }
        const unsigned old = xb_add(&bar[XB_XSUB(b.x)], 1u);
        const unsigned gen = old / nloc;
        if (old + 1u == (gen + 1u) * nloc) {
            __builtin_amdgcn_fence(__ATOMIC_RELEASE, "agent");
            asm volatile("s_waitcnt vmcnt(0)" ::: "memory");
            const unsigned og = xb_add(&bar[XB_TOP], 1u);
            const unsigned tg = og / nx;
            if (og + 1u == (tg + 1u) * nx) xb_add(&bar[XB_TOPGEN], 1u);
            else XB_SPIN(xb_ld(&bar[XB_TOPGEN]) == tg, bar);
            __builtin_amdgcn_fence(__ATOMIC_ACQUIRE, "agent");
            xb_add(&bar[XB_XGEN(b.x)], 1u);
            asm volatile("s_waitcnt vmcnt(0)" ::: "memory");
        } else {
            XB_SPIN(xb_ld(&bar[XB_XGEN(b.x)]) == gen, bar);
            __builtin_amdgcn_fence(__ATOMIC_ACQUIRE, "agent");
            asm volatile("s_waitcnt vmcnt(0)" ::: "memory");
        }
    }
    __syncthreads();
}
#ifndef REP_P0
#define REP_P0 1
#endif
#ifndef REP_P1
#define REP_P1 1
#endif
#ifndef REP_P2
#define REP_P2 1
#endif
#ifndef REP_P2A
#define REP_P2A 1
#endif
#ifndef REP_SEQ
#define REP_SEQ 1
#endif
#ifndef REP_DSW
#define REP_DSW 1
#endif
#ifndef REP_P3
#define REP_P3 1
#endif
#ifndef REP_P4
#define REP_P4 1
#endif
#ifndef REP_P5
#define REP_P5 1
#endif
#ifndef REP_P6
#define REP_P6 1
#endif
#ifndef REP_P7
#define REP_P7 1
#endif
constexpr int NWAVES = 8;
constexpr int T = 32768, D = 1024, SEQ = 4096;
constexpr int INC = 3328, INCP = 3328, INC_OLD = 3088;
constexpr int OFF_QA = 0, OFF_KA = 256, OFF_VA = 512, OFF_RA = 1024, OFF_LA = 1536, OFF_QB = 1792, OFF_KB = 2304, OFF_VB = 2816;
constexpr float EPS = 1e-6f;
constexpr size_t MiB = 1u << 20;
constexpr size_t WS_CTL = 0, CTL_ZERO_BYTES = 1 * MiB;
constexpr size_t WS_BT_IN = 2 * MiB, WS_BT_OUT = 10 * MiB, WS_BT_PQ = 12 * MiB, WS_BT_PG = 16 * MiB, WS_BT_PP = 18 * MiB;
constexpr size_t WS_ROPE = 20 * MiB, WS_SSQ1 = 22 * MiB, WS_RSTD2 = 24 * MiB, WS_KEYSB = 26 * MiB, WS_GDEC = 27 * MiB;
constexpr size_t WS_H1 = 32 * MiB;
constexpr size_t WS_PROJ = 96 * MiB;
constexpr size_t WS_QR = 96 * MiB, WS_SEL = 224 * MiB;
constexpr size_t WS_MIX = 304 * MiB;
constexpr size_t WS_PB = 368 * MiB;
constexpr size_t WS_PPROJ = 384 * MiB;
constexpr size_t WS_X2B = 304 * MiB;
constexpr size_t WS_UB = 448 * MiB, WS_VB = 464 * MiB;
constexpr size_t WS_GOG = 32 * MiB;
constexpr size_t WS_GQD = 368 * MiB;
constexpr size_t WS_GKV = 480 * MiB;
constexpr size_t WS_END = 512 * MiB;
constexpr int CW_BAR = 4096;
constexpr int CW_DSW = 16384;
constexpr int RING_OFF = 0, RING_BYTES = 131072;
constexpr int LDSCTL_OFF = 159 * 1024, MISC_OFF = LDSCTL_OFF + 320;
constexpr int LDS_BYTES = 163840;

__device__ __forceinline__ float bf2f(bf16 v) { return __uint_as_float(((unsigned)v) << 16); }
__device__ __forceinline__ float wave_sum(float v) {
    v += __int_as_float(__builtin_amdgcn_update_dpp(0, __float_as_int(v), 0xB1, 0xF, 0xF, true));
    v += __int_as_float(__builtin_amdgcn_update_dpp(0, __float_as_int(v), 0x4E, 0xF, 0xF, true));
    v += __int_as_float(__builtin_amdgcn_update_dpp(0, __float_as_int(v), 0x141, 0xF, 0xF, true));
    v += __int_as_float(__builtin_amdgcn_update_dpp(0, __float_as_int(v), 0x140, 0xF, 0xF, true));
    v += __int_as_float(__builtin_amdgcn_update_dpp(0, __float_as_int(v), 0x142, 0xA, 0xF, false));
    v += __int_as_float(__builtin_amdgcn_update_dpp(0, __float_as_int(v), 0x143, 0xC, 0xF, false));
    return __int_as_float(__builtin_amdgcn_readlane(__float_as_int(v), 63));
}
__device__ __forceinline__ float xshfl(float v, int srclane) { return __int_as_float(__builtin_amdgcn_ds_bpermute(srclane << 2, __float_as_int(v))); }
__device__ __forceinline__ int xshfl_i(int v, int srclane) { return __builtin_amdgcn_ds_bpermute(srclane << 2, v); }


typedef __bf16 bf16x2_t __attribute__((ext_vector_type(2)));
typedef int i32x2 __attribute__((ext_vector_type(2)));
typedef short s16x4 __attribute__((ext_vector_type(4)));
typedef float f32x2 __attribute__((ext_vector_type(2)));
typedef float f32x32 __attribute__((ext_vector_type(32)));
typedef float f32x16 __attribute__((ext_vector_type(16)));
typedef __bf16 bf16x32 __attribute__((ext_vector_type(32)));
typedef unsigned u32x6 __attribute__((ext_vector_type(6)));
typedef unsigned u32x16 __attribute__((ext_vector_type(16)));
__device__ __forceinline__ unsigned enc6(float y) { const float q = fabsf(y) * 8.f; float c;
    if (q < 16.f) c = rintf(q); else if (q < 32.f) c = 16.f + rintf((q - 16.f) * 0.5f); else c = 24.f + rintf((q - 32.f) * 0.25f);
    c = fminf(c, 31.f); return (unsigned)c | ((__float_as_uint(y) >> 31) << 5); }
__device__ __forceinline__ unsigned enc4(float y) { const float a = fabsf(y);
    const unsigned c = (a > 0.25f) + (a > 0.75f) + (a > 1.25f) + (a > 1.75f) + (a > 2.5f) + (a > 3.5f) + (a > 5.0f); return c | ((__float_as_uint(y) >> 31) << 3); }
__device__ __forceinline__ unsigned cvtpk(float a, float b) { const f32x2 v = {a, b}; return __builtin_bit_cast(unsigned, __builtin_convertvector(v, bf16x2_t)); }
template <int CTRL> __device__ __forceinline__ float dpp_mov(float v) { return __int_as_float(__builtin_amdgcn_update_dpp(0, __float_as_int(v), CTRL, 0xF, 0xF, true)); }
__device__ __forceinline__ float row_sum16(float v) { v += dpp_mov<0xB1>(v); v += dpp_mov<0x4E>(v); v += dpp_mov<0x141>(v); v += dpp_mov<0x140>(v); return v; }
__device__ __forceinline__ float dot2bf(unsigned a, unsigned b, float c) { return __builtin_amdgcn_fdot2_f32_bf16(__builtin_bit_cast(bf16x2_t, a), __builtin_bit_cast(bf16x2_t, b), c, false); }
__device__ __forceinline__ float bflo(unsigned w) { return __uint_as_float(w << 16); }
__device__ __forceinline__ float bfhi(unsigned w) { return __uint_as_float(w & 0xffff0000u); }


__device__ __forceinline__ int f2key(float f) { const int b = __float_as_int(f); return b ^ ((b >> 31) & 0x7fffffff); }
__device__ __forceinline__ float key2f(int k) { return __int_as_float(k ^ ((k >> 31) & 0x7fffffff)); }
#define CE_DESC(a, b) { const int _hi = max((a), (b)), _lo = min((a), (b)); (a) = _hi; (b) = _lo; }
template <int N> __device__ __forceinline__ void bitonic_sort_desc(int (&v)[N]) {
#pragma unroll
    for (int k = 2; k <= N; k <<= 1)
#pragma unroll
        for (int j = k >> 1; j > 0; j >>= 1)
#pragma unroll
            for (int i = 0; i < N; ++i) { const int l = i ^ j; if (l > i) { if ((i & k) == 0) CE_DESC(v[i], v[l]) else CE_DESC(v[l], v[i]) } }
}
template <int N> __device__ __forceinline__ void bitonic_merge_desc(int (&v)[N]) {
#pragma unroll
    for (int j = N >> 1; j > 0; j >>= 1)
#pragma unroll
        for (int i = 0; i < N; ++i) { const int l = i ^ j; if (l > i) CE_DESC(v[i], v[l]) }
}
__device__ __forceinline__ void merge_top16(int (&a)[16], int srclane) {
    int b[16];
#pragma unroll
    for (int i = 0; i < 16; ++i) b[i] = __builtin_amdgcn_ds_bpermute(srclane << 2, a[i]);
#pragma unroll
    for (int i = 0; i < 16; ++i) a[i] = max(a[i], b[15 - i]);
    bitonic_merge_desc<16>(a);
}
struct CandTab { int i[64], j[64]; int n;
    constexpr CandTab() : i{}, j{}, n(0) { for (int a = 0; a < 16; ++a) for (int b = 0; b < 16; ++b) if ((a + 1) * (b + 1) <= 16) { i[n] = a; j[n] = b; ++n; } for (int q = n; q < 64; ++q) { i[q] = -1; j[q] = -1; } } };
constexpr CandTab kCand{};
static_assert(kCand.n == 50, "50 product-key candidates can reach the top 16");

__device__ __forceinline__ float max_x16(float x) { const auto r = __builtin_amdgcn_permlane16_swap(__float_as_uint(x), __float_as_uint(x), false, false); return fmaxf(__uint_as_float(r[0]), __uint_as_float(r[1])); }
__device__ __forceinline__ float max_x32(float x) { const auto r = __builtin_amdgcn_permlane32_swap(__float_as_uint(x), __float_as_uint(x), false, false); return fmaxf(__uint_as_float(r[0]), __uint_as_float(r[1])); }
__device__ __forceinline__ float add_x16(float x) { const auto r = __builtin_amdgcn_permlane16_swap(__float_as_uint(x), __float_as_uint(x), false, false); return __uint_as_float(r[0]) + __uint_as_float(r[1]); }
__device__ __forceinline__ float add_x32(float x) { const auto r = __builtin_amdgcn_permlane32_swap(__float_as_uint(x), __float_as_uint(x), false, false); return __uint_as_float(r[0]) + __uint_as_float(r[1]); }

__device__ __forceinline__ void p0_transpose_item(const float* W, int K, int ldw, int src0, int ncols, const float* gain, bf16* WT, int dst0, int nblk, LAS float* scr, int item, int lane) {
    const int kb = item / nblk, nb = item % nblk, k0 = 64 * kb, n0 = 32 * nb;
    const int n = n0 + (lane & 31);
#pragma unroll 8
    for (int i = 0; i < 32; ++i) { const int kk = 2 * i + (lane >> 5); float v = 0.f; if (n < ncols) { v = W[(size_t)(k0 + kk) * ldw + src0 + n]; if (gain) v *= gain[k0 + kk]; } scr[kk * 33 + (lane & 31)] = v; }
    LDS_WAIT(); asm volatile("" ::: "memory");
    const int c = lane & 7;
#pragma unroll
    for (int j = 0; j < 4; ++j) { const int nn = (lane >> 3) + 8 * j; const LAS float* s = scr + (8 * c) * 33 + nn;
        v4u o; o.x = pk2(s[0 * 33], s[1 * 33]); o.y = pk2(s[2 * 33], s[3 * 33]); o.z = pk2(s[4 * 33], s[5 * 33]); o.w = pk2(s[6 * 33], s[7 * 33]);
        *(GAS v4u*)(WT + (size_t)(dst0 + n0 + nn) * K + k0 + 8 * c) = o; }
    LDS_WAIT(); asm volatile("" ::: "memory");
}

struct Args { const float* in[18]; float* outp; unsigned char* ws; };

#define xin      (args.in[0])
#define p_in     (args.in[1])
#define positions ((const int*)args.in[2])
#define g_mix    (args.in[3])
#define w_in     (args.in[4])
#define w_up     (args.in[5])
#define b_gate   (args.in[6])
#define g_gla    (args.in[7])
#define w_out    (args.in[8])
#define g_peer   (args.in[9])
#define w_pq     (args.in[10])
#define skeys    (args.in[11])
#define pu       (args.in[12])
#define pv       (args.in[13])
#define g_ple    (args.in[14])
#define w_pg     (args.in[15])
#define w_pp     (args.in[16])
#define g_final  (args.in[17])
#define out      (args.outp)
#define Bt_in    ((bf16*)(args.ws + WS_BT_IN))
#define Bt_out   ((bf16*)(args.ws + WS_BT_OUT))
#define Bt_pq    ((bf16*)(args.ws + WS_BT_PQ))
#define Bt_pg    ((bf16*)(args.ws + WS_BT_PG))
#define Bt_pp    ((bf16*)(args.ws + WS_BT_PP))
#define rope     ((float*)(args.ws + WS_ROPE))
#define ssq1     ((float*)(args.ws + WS_SSQ1))
#define rstd2    ((float*)(args.ws + WS_RSTD2))
#define h1       ((bf16*)(args.ws + WS_H1))
#define x1b      ((bf16*)(args.ws + WS_H1))
#define proj     ((bf16*)(args.ws + WS_PROJ))
#define qr       ((bf16*)(args.ws + WS_QR))
#define sel2     ((i32x2*)(args.ws + WS_SEL))
#define Ub       ((unsigned char*)(args.ws + WS_UB))
#define Vb       ((unsigned char*)(args.ws + WS_VB))
#define keysb    ((bf16*)(args.ws + WS_KEYSB))
#define mix      ((bf16*)(args.ws + WS_MIX))
#define pb       ((bf16*)(args.ws + WS_PB))
#define pproj    ((bf16*)(args.ws + WS_PPROJ))
#define x2b      ((bf16*)(args.ws + WS_X2B))


__global__ void __launch_bounds__(NWAVES * 64, 2) mk_fwd(Args args) {
    extern __shared__ __attribute__((aligned(16))) unsigned char lds[];
    LAS unsigned char* const L = (LAS unsigned char*)lds;
    volatile LAS unsigned* const MISC = (volatile LAS unsigned*)(L + MISC_OFF);
    const int wave = __builtin_amdgcn_readfirstlane((int)threadIdx.x >> 6);
#define LANE_DECL int lane; asm volatile("v_mbcnt_lo_u32_b32 %0, -1, 0\n\tv_mbcnt_hi_u32_b32 %0, -1, %0" : "=v"(lane))
    const int G = gridDim.x; const int bx = blockIdx.x;
    const int vcu = (G % 8 == 0) ? (bx % 8) * (G / 8) + bx / 8 : bx;
    const int gw = vcu * NWAVES + wave, NGW = G * NWAVES;
    gu32* const ctl = (gu32*)(args.ws + WS_CTL);
    for (int u = threadIdx.x; u < (LDS_BYTES - LDSCTL_OFF) / 4; u += NWAVES * 64) ((LAS unsigned*)(L + LDSCTL_OFF))[u] = 0u;
    __syncthreads();
    XcdBarrier bar = xcd_barrier_post((unsigned*)(ctl + CW_BAR), MISC + 8);

    for (int rep_ = 0; rep_ < REP_P0; ++rep_) {
        LANE_DECL;
        LAS float* scr = (LAS float*)(L + RING_OFF + wave * 16384);
        constexpr int I_INA = 16 * 48, I_INB = 16 * 48, I_OUT = 16 * 32, I_PQ = 16 * 64, I_PG = 16 * 32, I_PP = 4 * 32;
        constexpr int NITEMS = I_INA + I_INB + I_OUT + I_PQ + I_PG + I_PP;
        for (int it = gw; it < NITEMS; it += NGW) {
            int r = it;
            if (r < I_INA) { p0_transpose_item(w_in, 1024, INC_OLD, 0, 1536, nullptr, Bt_in, 0, 48, scr, r, lane); continue; } r -= I_INA;
            if (r < I_INB) { p0_transpose_item(w_in, 1024, INC_OLD, 1552, 1536, nullptr, Bt_in, 1792, 48, scr, r, lane); continue; } r -= I_INB;
            if (r < I_OUT) { p0_transpose_item(w_out, 1024, 1024, 0, 1024, nullptr, Bt_out, 0, 32, scr, r, lane); continue; } r -= I_OUT;
            if (r < I_PQ) { p0_transpose_item(w_pq, 1024, 2048, 0, 2048, g_peer, Bt_pq, 0, 64, scr, r, lane); continue; } r -= I_PQ;
            if (r < I_PG) { p0_transpose_item(w_pg, 1024, 1024, 0, 1024, g_ple, Bt_pg, 0, 32, scr, r, lane); continue; } r -= I_PG;
            p0_transpose_item(w_pp, 256, 1024, 0, 1024, nullptr, Bt_pp, 0, 32, scr, r, lane);
        }
        for (int i = gw * 64 + lane; i < 256 * 128; i += NGW * 64) {
            const int n = i >> 7, k0 = (i & 127) * 8;
            float wu[16];
#pragma unroll
            for (int r = 0; r < 16; ++r) wu[r] = w_up[r * 256 + n];
            float o8[8];
#pragma unroll
            for (int kk = 0; kk < 8; ++kk) { const GAS f32x4* wr4 = (const GAS f32x4*)(w_in + (size_t)(k0 + kk) * INC_OLD + 1536); float a = 0.f;
#pragma unroll
                for (int q = 0; q < 4; ++q) { const f32x4 w4 = wr4[q]; a += w4.x * wu[4 * q] + w4.y * wu[4 * q + 1] + w4.z * wu[4 * q + 2] + w4.w * wu[4 * q + 3]; }
                o8[kk] = a; }
            v4u o; o.x = pk2(o8[0], o8[1]); o.y = pk2(o8[2], o8[3]); o.z = pk2(o8[4], o8[5]); o.w = pk2(o8[6], o8[7]);
            *(GAS v4u*)(Bt_in + (size_t)(1536 + n) * 1024 + k0) = o;
        }
        for (int row = gw; row < T; row += NGW) {
            const GAS f32x4* xr = (const GAS f32x4*)(xin + (size_t)row * D) + lane;
            f32x4 v[4]; float s = 0.f;
#pragma unroll
            for (int j = 0; j < 4; ++j) { v[j] = xr[64 * j]; s += (v[j].x * v[j].x + v[j].y * v[j].y) + (v[j].z * v[j].z + v[j].w * v[j].w); }
            const float rstd = rsqrtf(wave_sum(s) * (1.f / D) + EPS);
            GAS unsigned long long* o8 = (GAS unsigned long long*)(h1 + (size_t)row * D) + lane;
#pragma unroll
            for (int j = 0; j < 4; ++j) { const f32x4 gg = ((const GAS f32x4*)g_mix)[64 * j + lane];
                o8[64 * j] = (unsigned long long)pk2(v[j].x * rstd * gg.x, v[j].y * rstd * gg.y) | ((unsigned long long)pk2(v[j].z * rstd * gg.z, v[j].w * rstd * gg.w) << 32); }
        }
        for (size_t i = (size_t)gw * 64 + lane; i < (size_t)T * 256 / 4; i += (size_t)NGW * 64) {
            const f32x4 v = ((const GAS f32x4*)p_in)[i];
            ((GAS unsigned long long*)pb)[i] = (unsigned long long)pk2(v.x, v.y) | ((unsigned long long)pk2(v.z, v.w) << 32);
        }
        for (int i = gw * 64 + lane; i < 16384 * 16 * 2; i += NGW * 64) {
            const int tab = i >> 18, row = (i >> 4) & 16383, li = i & 15;
            const float* src = (tab ? pv : pu) + (size_t)row * D;
            const float scl = tab ? 4.f : 64.f;
            unsigned dw[12];
#pragma unroll
            for (int q = 0; q < 12; ++q) dw[q] = 0u;
#pragma unroll
            for (int j = 0; j < 4; ++j)
#pragma unroll
                for (int e4 = 0; e4 < 4; ++e4) {
                    f32x4 v = ((const GAS f32x4*)(src + 256 * j + 16 * li))[e4];
                    if (!tab) v = v * ((const GAS f32x4*)(g_peer + 256 * j + 16 * li))[e4];
                    v = v * scl;
#pragma unroll
                    for (int e = 0; e < 4; ++e) {
                        const int k = (j & 1) * 16 + e4 * 4 + e, grp = j >> 1;
                        if (!tab) { const int bit = 6 * k, w = bit >> 5, sh = bit & 31; const unsigned c = enc6(v[e]); dw[grp * 6 + w] |= c << sh; if (sh > 26) dw[grp * 6 + w + 1] |= c >> (32 - sh); }
                        else dw[grp * 4 + (k >> 3)] |= enc4(v[e]) << (4 * (k & 7));
                    }
                }
            if (!tab) { GAS v4u* dst = (GAS v4u*)(Ub + (size_t)row * 768) + li;
                v4u o0, o1, o2; o0.x = dw[0]; o0.y = dw[1]; o0.z = dw[2]; o0.w = dw[3]; o1.x = dw[4]; o1.y = dw[5]; o1.z = dw[6]; o1.w = dw[7]; o2.x = dw[8]; o2.y = dw[9]; o2.z = dw[10]; o2.w = dw[11];
                dst[0] = o0; dst[16] = o1; dst[32] = o2; }
            else { GAS v4u* dst = (GAS v4u*)(Vb + (size_t)row * 512) + li;
                v4u o0, o1; o0.x = dw[0]; o0.y = dw[1]; o0.z = dw[2]; o0.w = dw[3]; o1.x = dw[4]; o1.y = dw[5]; o1.z = dw[6]; o1.w = dw[7];
                dst[0] = o0; dst[16] = o1; }
        }
        for (int i = gw * 64 + lane; i < 16 * 128 * 128 / 4; i += NGW * 64) {
            const f32x4 v = ((const GAS f32x4*)skeys)[i];
            ((GAS unsigned long long*)keysb)[i] = (unsigned long long)pk2(v.x, v.y) | ((unsigned long long)pk2(v.z, v.w) << 32);
        }
        for (int i = gw * 64 + lane; i < T * 8; i += NGW * 64) {
            const int t = i >> 3, j = i & 7;
            const float inv_freq = powf(500000.0f, -(float)j / 8.0f);
            const float ang = (float)positions[t] * inv_freq;
            rope[2 * i] = cosf(ang); rope[2 * i + 1] = sinf(ang);
        }
    }
    { LANE_DECL; xcd_barrier(bar, wave == 0 && lane == 0); }

    for (int rep_ = 0; rep_ < REP_P1; ++rep_) {
        pg8::Gemm g{h1, Bt_in, T, INCP, D}; pg8::StaticOrder S; S.init(T, INCP, G, bx);
        pg8::EpiInProj E{proj, rope, b_gate};
        pg8::gemm_phase<pg8::EpiInProj, pg8::StaticOrder, true, true>(L + RING_OFF, g, S, E, wave);
        pg8::Gemm g2{pb, Bt_pp, T, D, 256}; pg8::StaticOrder S2;
        { const int nfull = (T / 256) * (INCP / 256) - ((T / 256) * (INCP / 256) / G) * G;
          if (nfull > 0 && nfull < G && ((G - nfull) % 8) == 0 && (nfull % 8) == 0) S2.init(T, D, G - nfull, bx >= nfull ? bx - nfull : (1 << 28)); else S2.init(T, D, G, bx); }
        pg8::EpiBf16<0> E2{pproj, D, nullptr, 0, 0, 1.f};
        pg8::gemm_phase<pg8::EpiBf16<0>, pg8::StaticOrder, true, true>(L + RING_OFF, g2, S2, E2, wave);
    }
    { LANE_DECL; xcd_barrier(bar, wave == 0 && lane == 0); }

    {
        LANE_DECL;
        const int fr = lane & 15, g = lane >> 4;
        constexpr int RS = 144;
        LAS unsigned char* const qd = L + RING_OFF;
        LAS unsigned char* const kd = qd + 64 * RS;
        LAS unsigned char* const keT = kd + 64 * RS;
        LAS unsigned char* const vT = keT + 64 * RS;
        LAS unsigned char* const Am = vT + 128 * RS;
        LAS float* const dec = (LAS float*)(Am + 64 * RS);
        for (int i = wave * 64 + lane; i < 64 * RS / 4; i += NWAVES * 64) ((LAS unsigned*)Am)[i] = 0u;
        __syncthreads();
        for (int rep4_ = 0; rep4_ < REP_P2A; ++rep4_) {
        int u = bx;
        const bf16* prow = proj + (size_t)((u >> 6) * 64 + lane) * INC + 0;
        v4u lav, qv, kv, vv0, vv1;
        {
            const int hh = (u >> 6) & 3, t0 = (u >> 8) * SEQ + (u & 63) * 64;
            prow = proj + (size_t)(t0 + lane) * INC;
            lav = *(const GAS v4u*)(prow + OFF_LA + hh * 64 + 8 * wave); qv = *(const GAS v4u*)(prow + OFF_QA + hh * 64 + 8 * wave); kv = *(const GAS v4u*)(prow + OFF_KA + hh * 64 + 8 * wave);
            vv0 = *(const GAS v4u*)(prow + OFF_VA + hh * 128 + 16 * wave); vv1 = *(const GAS v4u*)(prow + OFF_VA + hh * 128 + 16 * wave + 8);
        }
        for (; u < 2048; u += G) {
            const int h = (u >> 6) & 3, t0 = (u >> 8) * SEQ + (u & 63) * 64;
            float laf[8];
            laf[0] = bflo(lav.x); laf[1] = bfhi(lav.x); laf[2] = bflo(lav.y); laf[3] = bfhi(lav.y); laf[4] = bflo(lav.z); laf[5] = bfhi(lav.z); laf[6] = bflo(lav.w); laf[7] = bfhi(lav.w);
            float qf[8], kf[8];
            qf[0] = bflo(qv.x); qf[1] = bfhi(qv.x); qf[2] = bflo(qv.y); qf[3] = bfhi(qv.y); qf[4] = bflo(qv.z); qf[5] = bfhi(qv.z); qf[6] = bflo(qv.w); qf[7] = bfhi(qv.w);
            kf[0] = bflo(kv.x); kf[1] = bfhi(kv.x); kf[2] = bflo(kv.y); kf[3] = bfhi(kv.y); kf[4] = bflo(kv.z); kf[5] = bfhi(kv.z); kf[6] = bflo(kv.w); kf[7] = bfhi(kv.w);
            float qdv[8], kdv[8], kev[8];
#pragma unroll
            for (int c = 0; c < 8; ++c) {
                float bsum = laf[c];
                bsum += __int_as_float(__builtin_amdgcn_update_dpp(0, __float_as_int(bsum), 0x111, 0xF, 0xF, false));
                bsum += __int_as_float(__builtin_amdgcn_update_dpp(0, __float_as_int(bsum), 0x112, 0xF, 0xF, false));
                bsum += __int_as_float(__builtin_amdgcn_update_dpp(0, __float_as_int(bsum), 0x114, 0xF, 0xF, false));
                bsum += __int_as_float(__builtin_amdgcn_update_dpp(0, __float_as_int(bsum), 0x118, 0xF, 0xF, false));
                bsum += __int_as_float(__builtin_amdgcn_update_dpp(0, __float_as_int(bsum), 0x142, 0xA, 0xF, false));
                bsum += __int_as_float(__builtin_amdgcn_update_dpp(0, __float_as_int(bsum), 0x143, 0xC, 0xF, false));
                const float blast = __int_as_float(__builtin_amdgcn_readlane(__float_as_int(bsum), 63));
                qdv[c] = qf[c] * 0.125f * __expf(bsum);
                kdv[c] = kf[c] * __expf(-bsum);
                kev[c] = kf[c] * __expf(blast - bsum);
                if (lane == 0) dec[8 * wave + c] = __expf(blast);
            }
#pragma unroll
            for (int c = 0; c < 8; c += 2) { const unsigned w2 = cvtpk(kev[c], kev[c + 1]);
                *(LAS bf16*)(keT + (8 * wave + c) * RS + lane * 2) = (bf16)(w2 & 0xffffu); *(LAS bf16*)(keT + (8 * wave + c + 1) * RS + lane * 2) = (bf16)(w2 >> 16); }
            { v4u o; o.x = cvtpk(qdv[0], qdv[1]); o.y = cvtpk(qdv[2], qdv[3]); o.z = cvtpk(qdv[4], qdv[5]); o.w = cvtpk(qdv[6], qdv[7]); *(LAS v4u*)(qd + lane * RS + 16 * wave) = o;
              v4u o2; o2.x = cvtpk(kdv[0], kdv[1]); o2.y = cvtpk(kdv[2], kdv[3]); o2.z = cvtpk(kdv[4], kdv[5]); o2.w = cvtpk(kdv[6], kdv[7]); *(LAS v4u*)(kd + lane * RS + 16 * wave) = o2; }
            {
                const unsigned vw[8] = {vv0.x, vv0.y, vv0.z, vv0.w, vv1.x, vv1.y, vv1.z, vv1.w};
#pragma unroll
                for (int e = 0; e < 8; ++e) { *(LAS bf16*)(vT + (16 * wave + 2 * e) * RS + lane * 2) = (bf16)(vw[e] & 0xffffu); *(LAS bf16*)(vT + (16 * wave + 2 * e + 1) * RS + lane * 2) = (bf16)(vw[e] >> 16); }
            }
            if (u + G < 2048) {
                const int un = u + G, hn = (un >> 6) & 3, tn = (un >> 8) * SEQ + (un & 63) * 64;
                const bf16* pn = proj + (size_t)(tn + lane) * INC;
                lav = *(const GAS v4u*)(pn + OFF_LA + hn * 64 + 8 * wave); qv = *(const GAS v4u*)(pn + OFF_QA + hn * 64 + 8 * wave); kv = *(const GAS v4u*)(pn + OFF_KA + hn * 64 + 8 * wave);
                vv0 = *(const GAS v4u*)(pn + OFF_VA + hn * 128 + 16 * wave); vv1 = *(const GAS v4u*)(pn + OFF_VA + hn * 128 + 16 * wave + 8);
            }
            unsigned long long rav[4];
#pragma unroll
            for (int tt = 0; tt < 4; ++tt) rav[tt] = *(const GAS unsigned long long*)(proj + (size_t)(t0 + 16 * tt + fr) * INC + OFF_RA + h * 128 + 16 * wave + 4 * g);
            const f32x4 ggl = *(const GAS f32x4*)(g_gla + h * 128 + 16 * wave + 4 * g);
            LDS_WAIT(); __syncthreads();
#pragma unroll
            for (int rep = 0; rep < 2; ++rep) {
                const int ti = wave + 8 * rep;
                if (ti < 10) {
                    const int tt = (ti >= 6) ? 3 : ((ti >= 3) ? 2 : ((ti >= 1) ? 1 : 0));
                    const int tk = ti - ((tt * (tt + 1)) >> 1);
                    f32x4 acc = {0.f, 0.f, 0.f, 0.f};
#pragma unroll
                    for (int ks = 0; ks < 2; ++ks) { const bf16x8 a = *(const LAS bf16x8*)(qd + (16 * tt + fr) * RS + (32 * ks + 8 * g) * 2), bb = *(const LAS bf16x8*)(kd + (16 * tk + fr) * RS + (32 * ks + 8 * g) * 2);
                        acc = __builtin_amdgcn_mfma_f32_16x16x32_bf16(a, bb, acc, 0, 0, 0); }
#pragma unroll
                    for (int r = 0; r < 4; ++r) { const int tq = 16 * tt + 4 * g + r, tc = 16 * tk + fr; *(LAS bf16*)(Am + tq * RS + tc * 2) = (bf16)f2bf(tq >= tc ? acc[r] : 0.f); }
                }
            }
            {
                const int tt = wave >> 1, ks = wave & 1;
                const unsigned long long lo = *(const LAS unsigned long long*)(qd + (16 * tt + fr) * RS + (32 * ks + 4 * g) * 2), hi = *(const LAS unsigned long long*)(qd + (16 * tt + fr) * RS + (32 * ks + 16 + 4 * g) * 2);
                v4u w; w.x = (unsigned)lo; w.y = (unsigned)(lo >> 32); w.z = (unsigned)hi; w.w = (unsigned)(hi >> 32);
                ((GAS v4u*)(args.ws + WS_GQD))[((size_t)u * 8 + wave) * 64 + lane] = w;
                if (wave == 0) ((GAS float*)(args.ws + WS_GDEC))[(size_t)u * 64 + lane] = dec[lane];
            }
            LDS_WAIT(); __syncthreads();
            bf16x8 vb[2];
#pragma unroll
            for (int ks = 0; ks < 2; ++ks) vb[ks] = *(const LAS bf16x8*)(vT + (16 * wave + fr) * RS + (32 * ks + 8 * g) * 2);
#pragma unroll
            for (int tt = 0; tt < 4; ++tt) {
                f32x4 acc = {0.f, 0.f, 0.f, 0.f};
#pragma unroll
                for (int ks = 0; ks < 2; ++ks) { const bf16x8 a = *(const LAS bf16x8*)(Am + (16 * tt + fr) * RS + (32 * ks + 8 * g) * 2); acc = __builtin_amdgcn_mfma_f32_16x16x32_bf16(vb[ks], a, acc, 0, 0, 0); }
                const unsigned rlo = (unsigned)rav[tt], rhi = (unsigned)(rav[tt] >> 32);
                const float rr[4] = {bflo(rlo), bfhi(rlo), bflo(rhi), bfhi(rhi)};
                v4u w;
#pragma unroll
                for (int r = 0; r < 4; ++r) { const float gate = ggl[r] * rr[r] * __builtin_amdgcn_rcpf(1.f + __expf(-rr[r])); w[r] = cvtpk(acc[r], gate); }
                ((GAS v4u*)(args.ws + WS_GOG))[(((size_t)u * 8 + wave) * 4 + tt) * 64 + lane] = w;
            }
#pragma unroll
            for (int dt = 0; dt < 4; ++dt) {
                f32x4 acc = {0.f, 0.f, 0.f, 0.f};
#pragma unroll
                for (int ks = 0; ks < 2; ++ks) { const bf16x8 a = *(const LAS bf16x8*)(keT + (16 * dt + fr) * RS + (32 * ks + 8 * g) * 2); acc = __builtin_amdgcn_mfma_f32_16x16x32_bf16(a, vb[ks], acc, 0, 0, 0); }
                const unsigned long long w = (unsigned long long)cvtpk(acc[0], acc[1]) | ((unsigned long long)cvtpk(acc[2], acc[3]) << 32);
                ((GAS unsigned long long*)(args.ws + WS_GKV))[(((size_t)u * 8 + wave) * 4 + dt) * 64 + lane] = w;
            }
            LDS_WAIT(); __syncthreads();
        }
        }
    }
    { LANE_DECL; xcd_barrier(bar, wave == 0 && lane == 0); }

    for (int rep_ = 0; rep_ < REP_P2; ++rep_) {
    for (int rep3_ = 0; rep3_ < REP_SEQ; ++rep3_)
    if (bx < 32) {
        LANE_DECL;
        const int fr = lane & 15, g = lane >> 4;
        const int b = bx >> 2, h = bx & 3;
        LAS float* const ssqb = (LAS float*)(L + RING_OFF);
        LAS float* const rstdl = ssqb + 1024 + wave * 64;
        f32x4 S[4];
#pragma unroll
        for (int dt = 0; dt < 4; ++dt) S[dt] = (f32x4){0.f, 0.f, 0.f, 0.f};
        const GAS v4u* const gog = (const GAS v4u*)(args.ws + WS_GOG);
        const GAS unsigned long long* const gkv = (const GAS unsigned long long*)(args.ws + WS_GKV);
        const GAS v4u* const gqd = (const GAS v4u*)(args.ws + WS_GQD);
        const GAS f32x4* const gdec = (const GAS f32x4*)(args.ws + WS_GDEC);
        const int u0 = bx * 64;
        v4u ogA[4], ogB[4]; unsigned long long kvA[4], kvB[4]; v4u qdA[8], qdB[8]; f32x4 dcA[4], dcB[4];
#define GLA_LOAD(og_, kv_, qd_, dc_, uu) do { const size_t u_ = (size_t)(uu); \
        _Pragma("unroll") for (int q = 0; q < 4; ++q) { og_[q] = gog[((u_ * 8 + wave) * 4 + q) * 64 + lane]; kv_[q] = gkv[((u_ * 8 + wave) * 4 + q) * 64 + lane]; dc_[q] = gdec[u_ * 16 + 4 * q + g]; } \
        _Pragma("unroll") for (int q = 0; q < 8; ++q) qd_[q] = gqd[(u_ * 8 + q) * 64 + lane]; } while (0)
#define GLA_STEP(og_, kv_, qd_, dc_, n_) do { \
            const int t0 = b * SEQ + (n_) * 64; \
            bf16x8 sa[2];                                                   \
            _Pragma("unroll") for (int ks = 0; ks < 2; ++ks) { v4u w; w.x = cvtpk(S[2 * ks][0], S[2 * ks][1]); w.y = cvtpk(S[2 * ks][2], S[2 * ks][3]); w.z = cvtpk(S[2 * ks + 1][0], S[2 * ks + 1][1]); w.w = cvtpk(S[2 * ks + 1][2], S[2 * ks + 1][3]); sa[ks] = __builtin_bit_cast(bf16x8, w); } \
            f32x4 o[4]; f32x4 gt[4];                                        \
            _Pragma("unroll") for (int tt = 0; tt < 4; ++tt) { \
                f32x4 acc; \
                _Pragma("unroll") for (int r = 0; r < 4; ++r) { acc[r] = bflo(og_[tt][r]); gt[tt][r] = bfhi(og_[tt][r]); } \
                _Pragma("unroll") for (int ks = 0; ks < 2; ++ks) acc = __builtin_amdgcn_mfma_f32_16x16x32_bf16(sa[ks], __builtin_bit_cast(bf16x8, qd_[2 * tt + ks]), acc, 0, 0, 0); \
                o[tt] = acc; } \
            _Pragma("unroll") for (int dt = 0; dt < 4; ++dt) { const unsigned lo = (unsigned)kv_[dt], hi = (unsigned)(kv_[dt] >> 32); \
                S[dt][0] = S[dt][0] * dc_[dt][0] + bflo(lo); S[dt][1] = S[dt][1] * dc_[dt][1] + bfhi(lo); S[dt][2] = S[dt][2] * dc_[dt][2] + bflo(hi); S[dt][3] = S[dt][3] * dc_[dt][3] + bfhi(hi); } \
            LAS float* const sq = ssqb + ((n_) & 1) * 512; \
            _Pragma("unroll") for (int tt = 0; tt < 4; ++tt) { float s2 = (o[tt][0] * o[tt][0] + o[tt][1] * o[tt][1]) + (o[tt][2] * o[tt][2] + o[tt][3] * o[tt][3]); s2 = add_x32(add_x16(s2)); if (g == 0) sq[wave * 64 + 16 * tt + fr] = s2; } \
            LDS_WAIT(); __syncthreads(); \
            { float tot = 0.f; \
              _Pragma("unroll") for (int w2 = 0; w2 < 8; ++w2) tot += sq[w2 * 64 + lane]; \
              rstdl[lane] = __builtin_amdgcn_rsqf(tot * (1.f / 128.f) + EPS); } \
            LDS_WAIT(); asm volatile("" ::: "memory"); \
            _Pragma("unroll") for (int tt = 0; tt < 4; ++tt) { \
                const float rs = rstdl[16 * tt + fr]; \
                const unsigned long long w = (unsigned long long)cvtpk(o[tt][0] * rs * gt[tt][0], o[tt][1] * rs * gt[tt][1]) | ((unsigned long long)cvtpk(o[tt][2] * rs * gt[tt][2], o[tt][3] * rs * gt[tt][3]) << 32); \
                *(GAS unsigned long long*)(mix + (size_t)(t0 + 16 * tt + fr) * D + h * 128 + 16 * wave + 4 * g) = w; } \
            LDS_WAIT(); asm volatile("" ::: "memory"); } while (0)
        GLA_LOAD(ogA, kvA, qdA, dcA, u0);
        for (int n = 0; n < 64; n += 2) {
            GLA_LOAD(ogB, kvB, qdB, dcB, u0 + n + 1);
            GLA_STEP(ogA, kvA, qdA, dcA, n);
            if (n + 2 < 64) GLA_LOAD(ogA, kvA, qdA, dcA, u0 + n + 2);
            GLA_STEP(ogB, kvB, qdB, dcB, n + 1);
        }
#undef GLA_LOAD
#undef GLA_STEP
        __syncthreads();
    }
    for (int rep2_ = 0; rep2_ < REP_DSW; ++rep2_)
    {
        LANE_DECL;
        const int qc = lane & 31, hh = lane >> 5;
        constexpr int OROW = 136;
        LAS unsigned char* const Ob = L + RING_OFF;
        constexpr int KROW = 144;
        LAS unsigned char* const Kst = L + RING_OFF + 512 * OROW + wave * (2 * 32 * KROW);
        LAS unsigned char* const Vst = Kst + 32 * KROW;
        volatile LAS int* const ubox = (volatile LAS int*)(L + MISC_OFF + 64);
        const float C2 = 0.125f * 1.4426950408889634f;
        for (;;) {
            if (wave == 0 && lane == 0) ubox[0] = (int)__hip_atomic_fetch_add(ctl + CW_DSW + 64 * (rep_ * 4 + rep2_), 1u, __ATOMIC_RELAXED, __HIP_MEMORY_SCOPE_AGENT);
            __syncthreads();
            const int unit = __builtin_amdgcn_readfirstlane(ubox[0]);
            if (unit >= 512) break;
            const int sp = unit & 7, h = (unit >> 3) & 7, b = unit >> 6;
            const int s0 = sp * 512;
            const bf16* const base = proj + (size_t)b * SEQ * INC;
#pragma unroll 1
            for (int pt = 0; pt < 3; ++pt) {
                const int dl = (pt == 0) ? 0 : ((pt == 1) ? 2 : 4), d = 1 << dl;
#pragma unroll 1
                for (int rep = 0; rep < 2; ++rep) {
                    const int qt = wave + 8 * rep;
                    const int rr = qt & (d - 1), jj = qt >> dl;
                    const int tq0 = s0 + rr + ((32 * jj) << dl);
                    const int tkb = tq0 - (128 << dl);
                    int kkmin = 0;
                    if (tkb < 0) kkmin = (-tkb + d - 1) >> dl;
                    bf16x8 qf[4];
#pragma unroll
                    for (int ks = 0; ks < 4; ++ks) qf[ks] = *(const GAS bf16x8*)(base + (size_t)(tq0 + (qc << dl)) * INC + OFF_QB + h * 64 + 16 * ks + 8 * hh);
                    f32x16 O0, O1;
#pragma unroll
                    for (int r = 0; r < 16; ++r) { O0[r] = 0.f; O1[r] = 0.f; }
                    float m = -INFINITY, l = 0.f;
                    const int cmin = kkmin >> 5;
                    v4u kA[4], vA[4], kB[4], vB[4];
#define DSW_LOAD(kr_, vr_, c_) do { const int k0_ = 32 * (c_); \
                        _Pragma("unroll") for (int it = 0; it < 4; ++it) { const int pc = lane + 64 * it, key = pc >> 3, ch = pc & 7; int tk = tkb + ((k0_ + key) << dl); tk = tk < 0 ? 0 : (tk > SEQ - 1 ? SEQ - 1 : tk); \
                            const bf16* rp = base + (size_t)tk * INC + h * 64 + 8 * ch; kr_[it] = *(const GAS v4u*)(rp + OFF_KB); vr_[it] = *(const GAS v4u*)(rp + OFF_VB); } } while (0)
#define DSW_STEP(kr_, vr_, c_) do { const int k0 = 32 * (c_); \
                        _Pragma("unroll") for (int it = 0; it < 4; ++it) { const int pc = lane + 64 * it, key = pc >> 3, ch = pc & 7; *(LAS v4u*)(Kst + key * KROW + ch * 16) = kr_[it]; *(LAS v4u*)(Vst + key * KROW + ch * 16) = vr_[it]; } \
                        LDS_WAIT(); asm volatile("" ::: "memory"); \
                        f32x16 sc; \
                        _Pragma("unroll") for (int r = 0; r < 16; ++r) sc[r] = 0.f; \
                        _Pragma("unroll") for (int ks = 0; ks < 4; ++ks) { const bf16x8 ka = *(const LAS bf16x8*)(Kst + qc * KROW + (16 * ks + 8 * hh) * 2);     \
                            sc = __builtin_amdgcn_mfma_f32_32x32x16_bf16(ka, qf[ks], sc, 0, 0, 0); } \
                        const bool edge = ((c_) == 0) | ((c_) == 4) | (k0 < kkmin);     \
                        float cmax = -INFINITY; \
                        _Pragma("unroll") for (int r = 0; r < 16; ++r) { float v = sc[r] * C2; \
                            if (edge) { const int kk = k0 + (r & 3) + 8 * (r >> 2) + 4 * hh; const bool ok = (kk >= qc) & (kk <= qc + 128) & (kk >= kkmin); v = ok ? v : -INFINITY; } \
                            sc[r] = v; cmax = fmaxf(cmax, v); } \
                        cmax = max_x32(cmax); \
                        const float mn = fmaxf(m, cmax);                    \
                        const float alpha = __builtin_amdgcn_exp2f(m - mn); \
                        float ps = 0.f; \
                        _Pragma("unroll") for (int r = 0; r < 16; ++r) { sc[r] = __builtin_amdgcn_exp2f(sc[r] - mn); ps += sc[r]; } \
                        l = l * alpha + ps; m = mn; \
                        bf16x8 pf[2];                                       \
                        _Pragma("unroll") for (int sx = 0; sx < 2; ++sx) { v4u w; w.x = cvtpk(sc[8 * sx], sc[8 * sx + 1]); w.y = cvtpk(sc[8 * sx + 2], sc[8 * sx + 3]); w.z = cvtpk(sc[8 * sx + 4], sc[8 * sx + 5]); w.w = cvtpk(sc[8 * sx + 6], sc[8 * sx + 7]); pf[sx] = __builtin_bit_cast(bf16x8, w); } \
                        _Pragma("unroll") for (int r = 0; r < 16; ++r) { O0[r] *= alpha; O1[r] *= alpha; } \
                        _Pragma("unroll") for (int sx = 0; sx < 2; ++sx) { \
                            const int vrow = 16 * sx + 4 * hh + ((lane & 15) >> 2), vcol = 16 * ((lane >> 4) & 1) + 4 * (lane & 3); \
                            const s16x4 a0 = __builtin_amdgcn_ds_read_tr16_b64_v4i16((LAS s16x4*)(Vst + vrow * KROW + vcol * 2)); \
                            const s16x4 a1 = __builtin_amdgcn_ds_read_tr16_b64_v4i16((LAS s16x4*)(Vst + (vrow + 8) * KROW + vcol * 2)); \
                            const s16x4 c0 = __builtin_amdgcn_ds_read_tr16_b64_v4i16((LAS s16x4*)(Vst + vrow * KROW + (32 + vcol) * 2)); \
                            const s16x4 c1 = __builtin_amdgcn_ds_read_tr16_b64_v4i16((LAS s16x4*)(Vst + (vrow + 8) * KROW + (32 + vcol) * 2)); \
                            bf16x8 va, vc; va[0] = a0[0]; va[1] = a0[1]; va[2] = a0[2]; va[3] = a0[3]; va[4] = a1[0]; va[5] = a1[1]; va[6] = a1[2]; va[7] = a1[3]; \
                            vc[0] = c0[0]; vc[1] = c0[1]; vc[2] = c0[2]; vc[3] = c0[3]; vc[4] = c1[0]; vc[5] = c1[1]; vc[6] = c1[2]; vc[7] = c1[3]; \
                            O0 = __builtin_amdgcn_mfma_f32_32x32x16_bf16(va, pf[sx], O0, 0, 0, 0); \
                            O1 = __builtin_amdgcn_mfma_f32_32x32x16_bf16(vc, pf[sx], O1, 0, 0, 0); } \
                        LDS_WAIT(); asm volatile("" ::: "memory");         \
                    } while (0)
                    DSW_LOAD(kA, vA, 4);
                    if (3 >= cmin) DSW_LOAD(kB, vB, 3);
                    DSW_STEP(kA, vA, 4);
                    if (3 >= cmin) {
                        if (2 >= cmin) DSW_LOAD(kA, vA, 2);
                        DSW_STEP(kB, vB, 3);
                        if (2 >= cmin) {
                            if (1 >= cmin) DSW_LOAD(kB, vB, 1);
                            DSW_STEP(kA, vA, 2);
                            if (1 >= cmin) {
                                if (0 >= cmin) DSW_LOAD(kA, vA, 0);
                                DSW_STEP(kB, vB, 1);
                                if (0 >= cmin) DSW_STEP(kA, vA, 0);
                            }
                        }
                    }
#undef DSW_LOAD
#undef DSW_STEP
                    l = add_x32(l);
                    const int row = (tq0 - s0) + (qc << dl);
                    LAS unsigned char* orow = Ob + row * OROW;
                    if (pt > 0) {
                        const float m1 = *(const LAS float*)(orow + 128), l1 = *(const LAS float*)(orow + 132);
                        const float mn = fmaxf(m, m1), a0 = __builtin_amdgcn_exp2f(m - mn), a1 = __builtin_amdgcn_exp2f(m1 - mn);
#pragma unroll
                        for (int rq = 0; rq < 4; ++rq) {
                            const unsigned long long w0 = *(const LAS unsigned long long*)(orow + (8 * rq + 4 * hh) * 2), w1 = *(const LAS unsigned long long*)(orow + (32 + 8 * rq + 4 * hh) * 2);
                            O0[4 * rq] = O0[4 * rq] * a0 + bflo((unsigned)w0) * a1; O0[4 * rq + 1] = O0[4 * rq + 1] * a0 + bfhi((unsigned)w0) * a1;
                            O0[4 * rq + 2] = O0[4 * rq + 2] * a0 + bflo((unsigned)(w0 >> 32)) * a1; O0[4 * rq + 3] = O0[4 * rq + 3] * a0 + bfhi((unsigned)(w0 >> 32)) * a1;
                            O1[4 * rq] = O1[4 * rq] * a0 + bflo((unsigned)w1) * a1; O1[4 * rq + 1] = O1[4 * rq + 1] * a0 + bfhi((unsigned)w1) * a1;
                            O1[4 * rq + 2] = O1[4 * rq + 2] * a0 + bflo((unsigned)(w1 >> 32)) * a1; O1[4 * rq + 3] = O1[4 * rq + 3] * a0 + bfhi((unsigned)(w1 >> 32)) * a1;
                        }
                        l = l * a0 + l1 * a1; m = mn;
                    }
                    if (pt < 2) {
#pragma unroll
                        for (int rq = 0; rq < 4; ++rq) {
                            *(LAS unsigned long long*)(orow + (8 * rq + 4 * hh) * 2) = (unsigned long long)cvtpk(O0[4 * rq], O0[4 * rq + 1]) | ((unsigned long long)cvtpk(O0[4 * rq + 2], O0[4 * rq + 3]) << 32);
                            *(LAS unsigned long long*)(orow + (32 + 8 * rq + 4 * hh) * 2) = (unsigned long long)cvtpk(O1[4 * rq], O1[4 * rq + 1]) | ((unsigned long long)cvtpk(O1[4 * rq + 2], O1[4 * rq + 3]) << 32);
                        }
                        if (hh == 0) { *(LAS float*)(orow + 128) = m; *(LAS float*)(orow + 132) = l; }
                    } else {
                        const float rl = 1.f / l;
                        bf16* op = mix + (size_t)(b * SEQ + s0 + row) * D + 512 + h * 64;
#pragma unroll
                        for (int rq = 0; rq < 4; ++rq) {
                            *(GAS unsigned long long*)(op + 8 * rq + 4 * hh) = (unsigned long long)cvtpk(O0[4 * rq] * rl, O0[4 * rq + 1] * rl) | ((unsigned long long)cvtpk(O0[4 * rq + 2] * rl, O0[4 * rq + 3] * rl) << 32);
                            *(GAS unsigned long long*)(op + 32 + 8 * rq + 4 * hh) = (unsigned long long)cvtpk(O1[4 * rq] * rl, O1[4 * rq + 1] * rl) | ((unsigned long long)cvtpk(O1[4 * rq + 2] * rl, O1[4 * rq + 3] * rl) << 32);
                        }
                    }
                }
                LDS_WAIT(); __syncthreads();
            }
        }
    }
    }
    { LANE_DECL; xcd_barrier(bar, wave == 0 && lane == 0); }

    for (int rep_ = 0; rep_ < REP_P3; ++rep_) {
        pg8::Gemm g{mix, Bt_out, T, D, D}; pg8::StaticOrder S; S.init(T, D, G, bx);
        pg8::EpiOutProj E{xin, x1b, ssq1};
        pg8::gemm_phase<pg8::EpiOutProj, pg8::StaticOrder, true, true>(L + RING_OFF, g, S, E, wave);
    }
    { LANE_DECL; xcd_barrier(bar, wave == 0 && lane == 0); }

    for (int rep_ = 0; rep_ < REP_P4; ++rep_) {
        pg8::Gemm g{x1b, Bt_pq, T, 2048, D}; pg8::StaticOrder S; S.init(T, 2048, G, bx);
        pg8::EpiPeerQ E{qr, ssq1};
        pg8::gemm_phase<pg8::EpiPeerQ, pg8::StaticOrder, true, true>(L + RING_OFF, g, S, E, wave);
    }
    { LANE_DECL; xcd_barrier(bar, wave == 0 && lane == 0); }

    for (int rep_ = 0; rep_ < REP_P5; ++rep_) {
        LANE_DECL;
        const int fr = lane & 15, g = lane >> 4;
        constexpr int KROW = 272;
        const int h = bx & 7, nbh = G >> 3;
        {
            const GAS v4u* src = (const GAS v4u*)(keysb + (size_t)h * 2 * 128 * 128);
            for (int pc = wave * 64 + lane; pc < 4096; pc += NWAVES * 64) { const int R = pc >> 4, ch = pc & 15; *(LAS v4u*)(L + RING_OFF + R * KROW + ch * 16) = src[pc]; }
        }
        LAS int* const scr = (LAS int*)(L + RING_OFF + 256 * KROW + wave * (16 * 33 * 4));
        __syncthreads();
        for (int tg = (bx >> 3) * NWAVES + wave; tg < T / 16; tg += nbh * NWAVES) {
            const int tok0 = tg * 16;
            int top[2][16];
#pragma unroll
            for (int c = 0; c < 2; ++c) {
                bf16x8 bq[4];
#pragma unroll
                for (int ks = 0; ks < 4; ++ks) bq[ks] = *(const GAS bf16x8*)(qr + (size_t)(tok0 + fr) * 2048 + h * 256 + c * 128 + 32 * ks + 8 * g);
                int v[32];
#pragma unroll
                for (int tl = 0; tl < 8; ++tl) {
                    f32x4 acc = {0.f, 0.f, 0.f, 0.f};
#pragma unroll
                    for (int ks = 0; ks < 4; ++ks) { const bf16x8 a = *(const LAS bf16x8*)(L + RING_OFF + (c * 128 + 16 * tl + fr) * KROW + (32 * ks + 8 * g) * 2);
                        acc = __builtin_amdgcn_mfma_f32_16x16x32_bf16(a, bq[ks], acc, 0, 0, 0); }
#pragma unroll
                    for (int r = 0; r < 4; ++r) v[4 * tl + r] = (f2key(acc[r]) & ~0x7f) | (16 * tl + 4 * g + r);
                }
                bitonic_sort_desc<32>(v);
#pragma unroll
                for (int i = 0; i < 16; ++i) top[c][i] = v[i];
                merge_top16(top[c], lane ^ 16);
                merge_top16(top[c], lane ^ 32);
            }
            float fa[16], fb[16];
#pragma unroll
            for (int i = 0; i < 16; ++i) { fa[i] = key2f(top[0][i]); fb[i] = key2f(top[1][i]); }
            int cand[16];
#pragma unroll
            for (int sl = 0; sl < 16; ++sl) {
                int cv[4];
#pragma unroll
                for (int gg = 0; gg < 4; ++gg) { constexpr int NEG = (int)0x80000000;
                    const int n = 16 * gg + sl;
                    if (kCand.i[n] >= 0) cv[gg] = (f2key(fa[kCand.i[n] < 0 ? 0 : kCand.i[n]] + fb[kCand.j[n] < 0 ? 0 : kCand.j[n]]) & ~0xff) | (kCand.i[n] * 16 + kCand.j[n]); else cv[gg] = NEG; }
                cand[sl] = (g == 0) ? cv[0] : ((g == 1) ? cv[1] : ((g == 2) ? cv[2] : cv[3]));
            }
            bitonic_sort_desc<16>(cand);
            merge_top16(cand, lane ^ 16);
            merge_top16(cand, lane ^ 32);
#pragma unroll
            for (int i = 0; i < 16; ++i) { if (g == (i >> 3)) scr[fr * 33 + i] = top[0][i] & 0x7f; if (g == 2 + (i >> 3)) scr[fr * 33 + 16 + i] = top[1][i] & 0x7f; }
            float ex[16]; float den = 0.f; const float m0 = key2f(cand[0]);
#pragma unroll
            for (int r = 0; r < 16; ++r) { ex[r] = __expf(key2f(cand[r]) - m0); den += ex[r]; }
            const float rden = 1.f / den;
            LDS_WAIT(); asm volatile("" ::: "memory");
            int oi[4]; float og[4];
#pragma unroll
            for (int q = 0; q < 4; ++q) {
                const int kq = (g == 0) ? cand[q] : ((g == 1) ? cand[4 + q] : ((g == 2) ? cand[8 + q] : cand[12 + q]));
                const float eq = (g == 0) ? ex[q] : ((g == 1) ? ex[4 + q] : ((g == 2) ? ex[8 + q] : ex[12 + q]));
                const int code = kq & 0xff;
                oi[q] = scr[fr * 33 + (code >> 4)] * 128 + scr[fr * 33 + 16 + (code & 15)]; og[q] = eq * rden;
            }
            GAS v4u* op = (GAS v4u*)(sel2 + (size_t)(tok0 + fr) * 128 + h * 16 + 4 * g);
            v4u o0, o1; o0.x = (unsigned)oi[0]; o0.y = __float_as_uint(og[0]); o0.z = (unsigned)oi[1]; o0.w = __float_as_uint(og[1]);
            o1.x = (unsigned)oi[2]; o1.y = __float_as_uint(og[2]); o1.z = (unsigned)oi[3]; o1.w = __float_as_uint(og[3]);
            op[0] = o0; op[1] = o1;
            LDS_WAIT(); asm volatile("" ::: "memory");
        }
        __syncthreads();
    }
    { LANE_DECL; xcd_barrier(bar, wave == 0 && lane == 0); }

    for (int rep_ = 0; rep_ < REP_P6; ++rep_) {
        LANE_DECL;
        const int g4 = lane >> 4, li = lane & 15;
        LAS i32x2* const selw = (LAS i32x2*)(L + RING_OFF + wave * 1024);
        for (int tok = gw; tok < T; tok += NGW) {
            const float s1 = (lane < 16) ? ssq1[(size_t)lane * T + tok] : 0.f;
            const float rstd1 = rsqrtf(wave_sum(s1) * (1.f / D) + EPS);
            v4u xw[8];
#pragma unroll
            for (int j = 0; j < 4; ++j) { xw[2 * j] = ((const GAS v4u*)(x1b + (size_t)tok * D))[32 * j + 2 * li]; xw[2 * j + 1] = ((const GAS v4u*)(x1b + (size_t)tok * D))[32 * j + 2 * li + 1]; }
            float acc[64];
#pragma unroll
            for (int k = 0; k < 64; ++k) acc[k] = 0.f;
            {
                const GAS i32x2* selg = (const GAS i32x2*)sel2 + (size_t)tok * 128;
                const i32x2 p0 = selg[lane], p1 = selg[lane + 64];
                const int b0 = p0.x >> 11, b1 = p1.x >> 11;
                const unsigned long long lt = (1ull << lane) - 1ull;
                int base = 0, r0 = 0, r1 = 0;
#pragma unroll
                for (int bk = 0; bk < 8; ++bk) {
                    const unsigned long long m0 = __ballot(b0 == bk), m1 = __ballot(b1 == bk);
                    const int c0 = __popcll(m0), c1 = __popcll(m1);
                    if (b0 == bk) r0 = base + __popcll(m0 & lt);
                    if (b1 == bk) r1 = base + c0 + __popcll(m1 & lt);
                    base += c0 + c1;
                }
                selw[r0] = p0; selw[r1] = p1;
                LDS_WAIT(); asm volatile("" ::: "memory");
            }
            const float ascale = rstd1 * (1.f / 64.f);
            i32x2 cur = selw[g4];
            for (int it = 0; it < 32; ++it) {
                const i32x2 nxt = selw[((it < 31) ? 4 * (it + 1) : 0) + g4];
                const GAS v4u* up = (const GAS v4u*)(Ub + (size_t)cur.x * 768) + li;
                const GAS v4u* vp = (const GAS v4u*)(Vb + (size_t)cur.x * 512) + li;
                const v4u u0 = up[0], u1 = up[16], u2 = up[32], v0 = vp[0], v1 = vp[16];
                float s = 0.f;
                { const u32x6 ga = {u0.x, u0.y, u0.z, u0.w, u1.x, u1.y};
                  const u32x16 d = __builtin_bit_cast(u32x16, __builtin_amdgcn_cvt_scalef32_pk32_bf16_fp6(ga, 1.0f));
#pragma unroll
                  for (int k = 0; k < 16; ++k) s = dot2bf(xw[k >> 2][k & 3], d[k], s); }
                { const u32x6 gb = {u1.z, u1.w, u2.x, u2.y, u2.z, u2.w};
                  const u32x16 d = __builtin_bit_cast(u32x16, __builtin_amdgcn_cvt_scalef32_pk32_bf16_fp6(gb, 1.0f));
#pragma unroll
                  for (int k = 0; k < 16; ++k) s = dot2bf(xw[4 + (k >> 2)][k & 3], d[k], s); }
                s = row_sum16(s);
                const float a = s * ascale;
                const float act = 0.5f * a * (1.f + erff(a * 0.70710678118654752f)) * __int_as_float(cur.y) * 0.25f;
#define PG_V4(bsel) { const f32x2 fa = __builtin_amdgcn_cvt_scalef32_pk_f32_fp4(v0[w], 1.0f, bsel), fb = __builtin_amdgcn_cvt_scalef32_pk_f32_fp4(v1[w], 1.0f, bsel); \
                        acc[8 * w + 2 * bsel] += act * fa.x; acc[8 * w + 2 * bsel + 1] += act * fa.y; acc[32 + 8 * w + 2 * bsel] += act * fb.x; acc[32 + 8 * w + 2 * bsel + 1] += act * fb.y; }
#pragma unroll
                for (int w = 0; w < 4; ++w) { PG_V4(0) PG_V4(1) PG_V4(2) PG_V4(3) }
#undef PG_V4
                cur = nxt;
            }
            float s2 = 0.f;
#pragma unroll
            for (int j = 0; j < 4; ++j) {
                float r[16];
#pragma unroll
                for (int e = 0; e < 16; ++e) { float v = acc[16 * j + e]; v += xshfl(v, lane ^ 16); v += xshfl(v, lane ^ 32);
                    const unsigned xwd = xw[2 * j + (e >> 3)][(e >> 1) & 3]; r[e] = v + ((e & 1) ? bfhi(xwd) : bflo(xwd)); s2 += r[e] * r[e]; }
                if (g4 == j) { v4u o0, o1; o0.x = pk2(r[0], r[1]); o0.y = pk2(r[2], r[3]); o0.z = pk2(r[4], r[5]); o0.w = pk2(r[6], r[7]); o1.x = pk2(r[8], r[9]); o1.y = pk2(r[10], r[11]); o1.z = pk2(r[12], r[13]); o1.w = pk2(r[14], r[15]);
                    ((GAS v4u*)(x2b + (size_t)tok * D))[32 * j + 2 * li] = o0; ((GAS v4u*)(x2b + (size_t)tok * D))[32 * j + 2 * li + 1] = o1; }
            }
            s2 = row_sum16(s2);
            if (lane == 0) rstd2[tok] = rsqrtf(s2 * (1.f / D) + EPS);
            LDS_WAIT(); asm volatile("" ::: "memory");
        }
    }
    { LANE_DECL; xcd_barrier(bar, wave == 0 && lane == 0); }

    for (int rep_ = 0; rep_ < REP_P7; ++rep_) {
        pg8::Gemm g{x2b, Bt_pg, T, D, D}; pg8::StaticOrder S; S.init(T, D, G, bx);
        pg8::EpiPle E{x2b, pproj, rstd2, x1b};
        pg8::gemm_phase<pg8::EpiPle, pg8::StaticOrder, true, true>(L + RING_OFF, g, S, E, wave);
    }
    { LANE_DECL; xcd_barrier(bar, wave == 0 && lane == 0); }

    {
    LANE_DECL;
    for (int row = gw; row < T; row += NGW) {
        const GAS v4u* xr = (const GAS v4u*)(x1b + (size_t)row * D);
        const v4u a = xr[lane], c = xr[64 + lane];
        float v[16];
        v[0] = bflo(a.x); v[1] = bfhi(a.x); v[2] = bflo(a.y); v[3] = bfhi(a.y); v[4] = bflo(a.z); v[5] = bfhi(a.z); v[6] = bflo(a.w); v[7] = bfhi(a.w);
        v[8] = bflo(c.x); v[9] = bfhi(c.x); v[10] = bflo(c.y); v[11] = bfhi(c.y); v[12] = bflo(c.z); v[13] = bfhi(c.z); v[14] = bflo(c.w); v[15] = bfhi(c.w);
        float s = 0.f;
#pragma unroll
        for (int k = 0; k < 16; ++k) s += v[k] * v[k];
        const float rstd = rsqrtf(wave_sum(s) * (1.f / D) + EPS);
        GAS f32x4* orow = (GAS f32x4*)(out + (size_t)row * D);
#pragma unroll
        for (int q = 0; q < 4; ++q) {
            const int e0 = (q < 2) ? (8 * lane + 4 * q) : (512 + 8 * lane + 4 * (q - 2));
            const f32x4 gg = *(const GAS f32x4*)(g_final + e0);
            f32x4 o; o.x = v[4 * q] * rstd * gg.x; o.y = v[4 * q + 1] * rstd * gg.y; o.z = v[4 * q + 2] * rstd * gg.z; o.w = v[4 * q + 3] * rstd * gg.w;
            orow[e0 >> 2] = o;
        }
    }
    }
}

#undef xin
#undef p_in
#undef positions
#undef g_mix
#undef w_in
#undef w_up
#undef b_gate
#undef g_gla
#undef w_out
#undef g_peer
#undef w_pq
#undef skeys
#undef pu
#undef pv
#undef g_ple
#undef w_pg
#undef w_pp
#undef g_final
#undef out
#undef Bt_in
#undef Bt_out
#undef Bt_pq
#undef Bt_pg
#undef Bt_pp
#undef rope
#undef ssq1
#undef rstd2
#undef h1
#undef x1b
#undef proj
#undef qr
#undef sel2
#undef Ub
#undef Vb
#undef keysb
#undef mix
#undef pb
#undef pproj
#undef x2b
extern "C" void kernel_launch(void* const* d_in, const int* in_sizes, int n_in, void* d_out, int out_size, void* d_ws, size_t ws_size, hipStream_t stream) {
    static int grid = 0;
    if (grid == 0) {
        if (n_in != 18 || out_size != T * D || ws_size < WS_END) { fprintf(stderr, "kernel_launch: unexpected shapes n_in %d out %d ws %zu\n", n_in, out_size, ws_size); grid = -1; return; }
        int dev = 0, cus = 0, per_cu = 0;
        if (hipGetDevice(&dev) != hipSuccess || hipDeviceGetAttribute(&cus, hipDeviceAttributeMultiprocessorCount, dev) != hipSuccess) { grid = -1; return; }
        if (hipFuncSetAttribute((const void*)mk_fwd, hipFuncAttributeMaxDynamicSharedMemorySize, LDS_BYTES) != hipSuccess) { fprintf(stderr, "kernel_launch: hipFuncSetAttribute failed\n"); grid = -1; return; }
        if (hipOccupancyMaxActiveBlocksPerMultiprocessor(&per_cu, (const void*)mk_fwd, NWAVES * 64, LDS_BYTES) != hipSuccess || per_cu < 1) fprintf(stderr, "kernel_launch: occupancy query reports %d\n", per_cu);
        (void)hipGetLastError();
        grid = cus;
    }
    if (grid < 0) return;
    if (hipMemsetAsync((char*)d_ws + WS_CTL, 0, CTL_ZERO_BYTES, stream) != hipSuccess) return;
    Args a{};
    for (int i = 0; i < 18; ++i) a.in[i] = (const float*)d_in[i];
    a.outp = (float*)d_out; a.ws = (unsigned char*)d_ws;
    hipLaunchKernelGGL(mk_fwd, dim3(grid), dim3(NWAVES * 64), LDS_BYTES, stream, a);
}
```

```cpp
#include <hip/hip_runtime.h>
#include <cstdio>
#include <cstdint>
namespace pg8 {
#define PG8_LAS __attribute__((address_space(3)))
typedef unsigned short bf16_t;
typedef short bf16x8 __attribute__((ext_vector_type(8)));
typedef float f32x4 __attribute__((ext_vector_type(4)));
typedef unsigned u32x4 __attribute__((ext_vector_type(4)));
constexpr int BM = 256, BK = 64, HALF = 128, HTB = HALF * BK * 2  , STAGE_BYTES = 8 * HTB, NXCD = 8, WGM = 8;

__host__ __device__ __forceinline__ int lds_byte(int r, int c) { const int st = (r >> 4) * 2 + (c >> 5), rr = r & 15, cc = c & 31, ob = rr * 64 + cc * 2; return st * 1024 + (ob ^ (((ob >> 9) & 1) << 5)); }
__host__ __device__ __forceinline__ void stage_rc(int b, int& R, int& C) { const int st = b / 1024, sb = b % 1024, swz = sb ^ (((sb >> 9) & 1) << 5); R = (st >> 1) * 16 + swz / 64; C = (st & 1) * 32 + (swz % 64) / 2; }
__host__ __device__ __forceinline__ int perm32(int rho) { const int n = rho >> 4, i = rho & 15; return 8 * (i >> 2) + 4 * n + (i & 3); }

struct Unit { int pm, pn; };
struct Gemm { const bf16_t* A; const bf16_t* Bt; int M, N, K; };

struct StaticOrder {
    int nM, nN, nwg, G, c;
    __host__ __device__ void init(int M, int N, int G_, int c_) { nM = M / BM; nN = N / BM; nwg = nM * nN; G = G_; c = c_; }
    __host__ __device__ bool next(int i, Unit& u) const {
        const long L = (long)i * G + c; if (L >= nwg) return false;
        int wgid = (int)L; { const int q = nwg / NXCD, r = nwg % NXCD, xcd = wgid % NXCD, off = wgid / NXCD; wgid = (xcd < r ? xcd * (q + 1) : r * (q + 1) + (xcd - r) * q) + off; }
        const int nig = WGM * nN, gid = wgid / nig, fm = gid * WGM, gsz = (nM - fm) < WGM ? (nM - fm) : WGM;
        u.pm = fm + ((wgid % nig) % gsz); u.pn = (wgid % nig) / gsz; return true;
    }
    __device__ __forceinline__ void a_ready(const Unit&) const {}
    __device__ __forceinline__ void done(const Unit&) const {}
};

__device__ __forceinline__ unsigned cvt_pk_bf16(float lo, float hi) { unsigned r; asm volatile("v_cvt_pk_bf16_f32 %0, %1, %2" : "=v"(r) : "v"(lo), "v"(hi)); return r; }
typedef float f32x2 __attribute__((ext_vector_type(2)));
__device__ __forceinline__ f32x2 gelu_pk(f32x2 v) {
    const f32x2 av = __builtin_elementwise_abs(v), d = av * 0.2316418882f + 1.0f;
    f32x2 t; t.x = __builtin_amdgcn_rcpf(d.x); t.y = __builtin_amdgcn_rcpf(d.y);
    f32x2 q = t * 0.5307027145f + (-0.7265760135f); q = q * t + 0.7107068705f; q = q * t + (-0.142248368f); q = q * t + 0.127414796f; q = q * t;
    const f32x2 s = (v * v) * (-0.72134752044f);
    f32x2 e; e.x = __builtin_amdgcn_exp2f(s.x); e.y = __builtin_amdgcn_exp2f(s.y);
    const f32x2 m = v * (q * e), r = v - m;
    f32x2 o; o.x = v.x < 0.f ? m.x : r.x; o.y = v.y < 0.f ? m.y : r.y; return o;
}

template <int ACT  > struct EpiBf16 {
    static constexpr bool PERM = true, AFTER_DRAIN = false; static_assert(ACT == 0 || ACT == 1, "EpiBf16: ACT is 0 (none) or 1 (gelu_pk)");
    bf16_t* O; int ldc; const float* bias; int split_cols; size_t split_stride; float scale0;
    __device__ __forceinline__ void operator()(const f32x4 (&acc)[2][2][4][2], const Unit& u, int wr, int wc, int fr, int fq) const {
        const int row0 = u.pm * BM + wr * 64 + fr; int colt = u.pn * BM; bf16_t* base = O;
        float sc = 1.f; if (split_cols) { const int t = colt / split_cols; base += (size_t)t * split_stride; colt -= t * split_cols; if (t == 0) sc = scale0; }
        const int col0 = colt + wc * 32 + 8 * fq, bcol0 = u.pn * BM + wc * 32 + 8 * fq;
        f32x4 bv[2][2];
#pragma unroll
        for (int bj = 0; bj < 2; ++bj)
#pragma unroll
            for (int n = 0; n < 2; ++n) bv[bj][n] = bias ? *(const f32x4*)(bias + bcol0 + bj * HALF + 4 * n) : (f32x4){0.f, 0.f, 0.f, 0.f};
#pragma unroll
        for (int ai = 0; ai < 2; ++ai)
#pragma unroll
            for (int m = 0; m < 4; ++m) { bf16_t* rowp = base + (size_t)(row0 + ai * HALF + m * 16) * ldc + col0;
#pragma unroll
                for (int bj = 0; bj < 2; ++bj) { f32x4 v0 = acc[ai][bj][m][0] + bv[bj][0], v1 = acc[ai][bj][m][1] + bv[bj][1];
                    if (ACT == 1) { f32x2 a = gelu_pk((f32x2){v0[0], v0[1]}), b = gelu_pk((f32x2){v0[2], v0[3]}), c = gelu_pk((f32x2){v1[0], v1[1]}), d = gelu_pk((f32x2){v1[2], v1[3]});
                        v0 = (f32x4){a.x, a.y, b.x, b.y}; v1 = (f32x4){c.x, c.y, d.x, d.y}; }
                    v0 = v0 * sc; v1 = v1 * sc; u32x4 w; w.x = cvt_pk_bf16(v0[0], v0[1]); w.y = cvt_pk_bf16(v0[2], v0[3]); w.z = cvt_pk_bf16(v1[0], v1[1]); w.w = cvt_pk_bf16(v1[2], v1[3]);
                    *(u32x4*)(rowp + bj * HALF) = w; } }
    }
};

__device__ __forceinline__ float xshfl(float v, int srclane) { return __int_as_float(__builtin_amdgcn_ds_bpermute(srclane << 2, __float_as_int(v))); }
constexpr int P_INC = 3328;
struct EpiInProj {
    static constexpr bool PERM = true, AFTER_DRAIN = false;
    bf16_t* O; const float* rope; const float* bgate;
    __device__ __forceinline__ void operator()(const f32x4 (&acc)[2][2][4][2], const Unit& u, int wr, int wc, int fr, int fq) const {
        const int row0 = u.pm * BM + wr * 64 + fr;
#pragma unroll
        for (int bj = 0; bj < 2; ++bj) {
            const int cb = u.pn * BM + bj * HALF + wc * 32;
            const int c0 = cb + 8 * fq;
            const bool ropechunk = (cb >= 1792) && (cb < 2816) && ((cb & 63) == 0);
            const bool lachunk = (cb >= 1536) && (cb < 1792);
            f32x4 bg0 = {0.f, 0.f, 0.f, 0.f}, bg1 = {0.f, 0.f, 0.f, 0.f};
            if (lachunk) { bg0 = *(const f32x4*)(bgate + c0 - 1536); bg1 = *(const f32x4*)(bgate + c0 - 1536 + 4); }
#pragma unroll
            for (int ai = 0; ai < 2; ++ai)
#pragma unroll
                for (int m = 0; m < 4; ++m) {
                    const int row = row0 + ai * HALF + m * 16;
                    f32x4 v0 = acc[ai][bj][m][0], v1 = acc[ai][bj][m][1];
                    if (lachunk) {
#pragma unroll
                        for (int e = 0; e < 4; ++e) { const float z0 = v0[e] + bg0[e], z1 = v1[e] + bg1[e];
                            v0[e] = (fminf(z0, 0.f) - __logf(1.f + __expf(-fabsf(z0)))) * (1.f / 16.f); v1[e] = (fminf(z1, 0.f) - __logf(1.f + __expf(-fabsf(z1)))) * (1.f / 16.f); }
                    }
                    if (ropechunk) {
                        f32x4 p0, p1;
#pragma unroll
                        for (int e = 0; e < 4; ++e) { p0[e] = xshfl(v0[e], (fq * 16 + fr) ^ 16); p1[e] = xshfl(v1[e], (fq * 16 + fr) ^ 16); }
                        if (fq < 2) {
                            const f32x4* cs = (const f32x4*)(rope + (size_t)row * 16);
                            const f32x4 t0 = cs[0], t1 = cs[1], t2 = cs[2], t3 = cs[3];
                            const float sg = (fq == 0) ? -1.f : 1.f;
                            v0[0] = v0[0] * t0[0] + sg * p0[0] * t0[1]; v0[1] = v0[1] * t0[2] + sg * p0[1] * t0[3];
                            v0[2] = v0[2] * t1[0] + sg * p0[2] * t1[1]; v0[3] = v0[3] * t1[2] + sg * p0[3] * t1[3];
                            v1[0] = v1[0] * t2[0] + sg * p1[0] * t2[1]; v1[1] = v1[1] * t2[2] + sg * p1[1] * t2[3];
                            v1[2] = v1[2] * t3[0] + sg * p1[2] * t3[1]; v1[3] = v1[3] * t3[2] + sg * p1[3] * t3[3];
                        }
                    }
                    { u32x4 w; w.x = cvt_pk_bf16(v0[0], v0[1]); w.y = cvt_pk_bf16(v0[2], v0[3]); w.z = cvt_pk_bf16(v1[0], v1[1]); w.w = cvt_pk_bf16(v1[2], v1[3]);
                        *(u32x4*)(O + (size_t)row * P_INC + c0) = w; }
                }
        }
    }
};
struct EpiOutProj {
    static constexpr bool PERM = true, AFTER_DRAIN = false;
    const float* X; bf16_t* O; float* ssq;
    __device__ __forceinline__ void operator()(const f32x4 (&acc)[2][2][4][2], const Unit& u, int wr, int wc, int fr, int fq) const {
        const int row0 = u.pm * BM + wr * 64 + fr, col0 = u.pn * BM + wc * 32 + 8 * fq;
#pragma unroll
        for (int ai = 0; ai < 2; ++ai)
#pragma unroll
            for (int m = 0; m < 4; ++m) {
                const int row = row0 + ai * HALF + m * 16; float s = 0.f;
#pragma unroll
                for (int bj = 0; bj < 2; ++bj) {
                    const float* xp = X + (size_t)row * 1024 + col0 + bj * HALF;
                    const f32x4 x0 = *(const f32x4*)xp, x1 = *(const f32x4*)(xp + 4);
                    const f32x4 v0 = acc[ai][bj][m][0] + x0, v1 = acc[ai][bj][m][1] + x1;
                    s += (v0[0] * v0[0] + v0[1] * v0[1]) + (v0[2] * v0[2] + v0[3] * v0[3]) + (v1[0] * v1[0] + v1[1] * v1[1]) + (v1[2] * v1[2] + v1[3] * v1[3]);
                    u32x4 w; w.x = cvt_pk_bf16(v0[0], v0[1]); w.y = cvt_pk_bf16(v0[2], v0[3]); w.z = cvt_pk_bf16(v1[0], v1[1]); w.w = cvt_pk_bf16(v1[2], v1[3]);
                    *(u32x4*)(O + (size_t)row * 1024 + col0 + bj * HALF) = w;
                }
                s += xshfl(s, (fq * 16 + fr) ^ 16); s += xshfl(s, (fq * 16 + fr) ^ 32);
                if (fq == 0) ssq[(size_t)(u.pn * 4 + wc) * 32768 + row] = s;
            }
    }
};
struct EpiPeerQ {
    static constexpr bool PERM = true, AFTER_DRAIN = false;
    bf16_t* O; const float* ssq;
    __device__ __forceinline__ void operator()(const f32x4 (&acc)[2][2][4][2], const Unit& u, int wr, int wc, int fr, int fq) const {
        const int row0 = u.pm * BM + wr * 64 + fr, col0 = u.pn * BM + wc * 32 + 8 * fq;
#pragma unroll
        for (int ai = 0; ai < 2; ++ai)
#pragma unroll
            for (int m = 0; m < 4; ++m) {
                const int row = row0 + ai * HALF + m * 16;
                float s = 0.f;
#pragma unroll
                for (int q = 0; q < 4; ++q) s += ssq[(size_t)(4 * fq + q) * 32768 + row];
                s += xshfl(s, (fq * 16 + fr) ^ 16); s += xshfl(s, (fq * 16 + fr) ^ 32);
                const float rstd = rsqrtf(s * (1.f / 1024.f) + 1e-6f);
#pragma unroll
                for (int bj = 0; bj < 2; ++bj) {
                    const f32x4 v0 = acc[ai][bj][m][0] * rstd, v1 = acc[ai][bj][m][1] * rstd;
                    u32x4 w; w.x = cvt_pk_bf16(v0[0], v0[1]); w.y = cvt_pk_bf16(v0[2], v0[3]); w.z = cvt_pk_bf16(v1[0], v1[1]); w.w = cvt_pk_bf16(v1[2], v1[3]);
                    *(u32x4*)(O + (size_t)row * 2048 + col0 + bj * HALF) = w;
                }
            }
    }
};
struct EpiPle {
    static constexpr bool PERM = true, AFTER_DRAIN = false;
    const bf16_t* X2; const bf16_t* PP; const float* rstd2; bf16_t* O;
    __device__ __forceinline__ void operator()(const f32x4 (&acc)[2][2][4][2], const Unit& u, int wr, int wc, int fr, int fq) const {
        const int row0 = u.pm * BM + wr * 64 + fr, col0 = u.pn * BM + wc * 32 + 8 * fq;
#pragma unroll
        for (int ai = 0; ai < 2; ++ai)
#pragma unroll
            for (int m = 0; m < 4; ++m) {
                const int row = row0 + ai * HALF + m * 16;
                const float rstd = rstd2[row];
#pragma unroll
                for (int bj = 0; bj < 2; ++bj) {
                    const size_t off = (size_t)row * 1024 + col0 + bj * HALF;
                    const u32x4 xw = *(const u32x4*)(X2 + off), pw = *(const u32x4*)(PP + off);
                    f32x4 o0, o1;
#pragma unroll
                    for (int e = 0; e < 4; ++e) {
                        const unsigned xe = (e < 2) ? ((e == 0) ? xw.x : xw.y) : ((e == 2) ? xw.z : xw.w);
                        const unsigned pe = (e < 2) ? ((e == 0) ? pw.x : pw.y) : ((e == 2) ? pw.z : pw.w);
                        const float xlo = __uint_as_float(xe << 16), xhi = __uint_as_float(xe & 0xffff0000u);
                        const float plo = __uint_as_float(pe << 16), phi = __uint_as_float(pe & 0xffff0000u);
                        const float a0 = (e < 2) ? acc[ai][bj][m][0][2 * e] : acc[ai][bj][m][1][2 * e - 4];
                        const float a1 = (e < 2) ? acc[ai][bj][m][0][2 * e + 1] : acc[ai][bj][m][1][2 * e - 3];
                        const float g0 = 1.f / (1.f + __expf(-a0 * rstd)), g1 = 1.f / (1.f + __expf(-a1 * rstd));
                        const float r0 = xlo + plo * g0, r1 = xhi + phi * g1;
                        if (e < 2) { o0[2 * e] = r0; o0[2 * e + 1] = r1; } else { o1[2 * e - 4] = r0; o1[2 * e - 3] = r1; }
                    }
                    { u32x4 w; w.x = cvt_pk_bf16(o0[0], o0[1]); w.y = cvt_pk_bf16(o0[2], o0[3]); w.z = cvt_pk_bf16(o1[0], o1[1]); w.w = cvt_pk_bf16(o1[2], o1[3]); *(u32x4*)(O + off) = w; }
                }
            }
    }
};
template <class Epi, class Sched, bool ALIGN_EPI = false, bool SP2 = false>
__device__ __forceinline__ void gemm_phase(PG8_LAS unsigned char* lds, const Gemm g, const Sched& S, const Epi& E, const int wave_id  ) {
    int lane_; asm volatile("v_mbcnt_lo_u32_b32 %0, -1, 0\n\tv_mbcnt_hi_u32_b32 %0, -1, %0" : "=v"(lane_)); int tid_ = wave_id * 64 + lane_;
    const int tid = tid_, wid = wave_id, lane = tid & 63, wr = wid >> 2, wc = wid & 3, fr = lane & 15, fq = lane >> 4;
    const int K = g.K, nt = K / BK;
    unsigned voffA[2], voffB[2];
#pragma unroll
    for (int i = 0; i < 2; ++i) { int R, C; stage_rc(tid * 16 + i * 8192, R, C); const int Rb = Epi::PERM ? ((R & ~31) + perm32(R & 31)) : R;
        voffA[i] = (unsigned)(R * K + C) * 2u; voffB[i] = (unsigned)(Rb * K + C) * 2u; }
    const size_t kstep = (size_t)(BK * 2);
    const size_t hstep = (size_t)HALF * K * 2;
    const size_t tstep = 2 * hstep;
    const unsigned ldsw = (unsigned)wid * 1024u;
    const int aoff = lds_byte(wr * 64 + fr, fq * 8), boff = lds_byte(wc * 32 + fr, fq * 8);
#define PG8_SA(b, h) (((b) * 2 + (h)) * HTB)
#define PG8_SB(b, h) ((4 + (b) * 2 + (h)) * HTB)
#define PG8_STAGE(bufoff, gbase, voff) do { _Pragma("unroll") for (int _i = 0; _i < 2; ++_i) \
        __builtin_amdgcn_global_load_lds((const unsigned*)((const char*)(gbase) + (voff)[_i]), (PG8_LAS unsigned*)(lds + (bufoff) + ldsw + _i * 8192), 16, 0, 0); } while (0)
#define PG8_LDA(dst, b, h) do { _Pragma("unroll") for (int m = 0; m < 4; ++m) _Pragma("unroll") for (int k = 0; k < 2; ++k) dst[m][k] = *(const PG8_LAS bf16x8*)(lds + PG8_SA(b, h) + aoff + m * 2048 + k * 1024); } while (0)
#define PG8_LDB(dst, b, h) do { _Pragma("unroll") for (int n = 0; n < 2; ++n) _Pragma("unroll") for (int k = 0; k < 2; ++k) dst[n][k] = *(const PG8_LAS bf16x8*)(lds + PG8_SB(b, h) + boff + n * 2048 + k * 1024); } while (0)
#define PG8_MMA(ai, bj, At, Bt) do { __builtin_amdgcn_s_setprio(1); _Pragma("unroll") for (int m = 0; m < 4; ++m) _Pragma("unroll") for (int n = 0; n < 2; ++n) _Pragma("unroll") for (int k = 0; k < 2; ++k) \
        acc[ai][bj][m][n] = __builtin_amdgcn_mfma_f32_16x16x32_bf16(Bt[n][k], At[m][k], acc[ai][bj][m][n], 0, 0, 0); __builtin_amdgcn_s_setprio(0); } while (0)
#define PG8_WAIT_V(n) asm volatile("s_waitcnt vmcnt(" #n ")" ::: "memory")
#define PG8_WAIT_L(n) asm volatile("s_waitcnt lgkmcnt(" #n ")" ::: "memory")
#define PG8_BAR __builtin_amdgcn_s_barrier()
#define PG8_SCHED __builtin_amdgcn_sched_barrier(0)
    Unit cur, nxt; int ui = 0;
    if (!S.next(0, cur)) return;
    f32x4 acc[2][2][4][2];
#pragma unroll
    for (int a = 0; a < 2; ++a)
#pragma unroll
        for (int b = 0; b < 2; ++b)
#pragma unroll
            for (int m = 0; m < 4; ++m)
#pragma unroll
                for (int n = 0; n < 2; ++n) acc[a][b][m][n] = (f32x4){0.f, 0.f, 0.f, 0.f};
    bf16x8 At[4][2], B0[2][2], B1[2][2];
    const char* cA = (const char*)g.A + (size_t)cur.pm * tstep; const char* cB = (const char*)g.Bt + (size_t)cur.pn * tstep;
    S.a_ready(cur);
    if constexpr (SP2) {
        PG8_STAGE(PG8_SB(0, 0), cB, voffB); PG8_STAGE(PG8_SB(0, 1), cB + hstep, voffB); PG8_STAGE(PG8_SA(0, 0), cA, voffA); PG8_STAGE(PG8_SA(0, 1), cA + hstep, voffA);
        if (wr == 1) PG8_BAR;
        PG8_WAIT_V(2); PG8_BAR;
        PG8_STAGE(PG8_SB(1, 0), cB + kstep, voffB); PG8_STAGE(PG8_SA(1, 0), cA + kstep, voffA); PG8_STAGE(PG8_SB(1, 1), cB + hstep + kstep, voffB);
        PG8_WAIT_V(6); PG8_BAR;
    } else {
        PG8_STAGE(PG8_SB(0, 0), cB, voffB); PG8_STAGE(PG8_SA(0, 0), cA, voffA); PG8_STAGE(PG8_SB(0, 1), cB + hstep, voffB); PG8_STAGE(PG8_SA(0, 1), cA + hstep, voffA);
        if (wr == 1) PG8_BAR;
        PG8_WAIT_V(4); PG8_BAR;
        PG8_STAGE(PG8_SB(1, 0), cB + kstep, voffB); PG8_STAGE(PG8_SA(1, 0), cA + kstep, voffA); PG8_STAGE(PG8_SB(1, 1), cB + hstep + kstep, voffB);
        PG8_WAIT_V(6); PG8_BAR;
    }
    for (;;) {
        const bool has_next = S.next(ui + 1, nxt);
        const char* nA = has_next ? (const char*)g.A + (size_t)nxt.pm * tstep : cA; const char* nB = has_next ? (const char*)g.Bt + (size_t)nxt.pn * tstep : cB;
        for (int t = 0; t < nt; t += 2) {
            const bool last = (t == nt - 2);
            const char* a1 = cA + (size_t)(t + 1) * kstep;
            const char* a2 = last ? nA : cA + (size_t)(t + 2) * kstep; const char* b2 = last ? nB : cB + (size_t)(t + 2) * kstep;
            const char* a3 = a2 + kstep; const char* b3 = b2 + kstep;
            if (last && has_next) S.a_ready(nxt);
            if constexpr (SP2) {
            PG8_LDB(B0, 0, 0); PG8_LDB(B1, 0, 1); PG8_SCHED; PG8_LDA(At, 0, 0); PG8_STAGE(PG8_SA(1, 1), a1 + hstep, voffA);
            PG8_WAIT_V(8); PG8_WAIT_L(0); PG8_BAR; PG8_MMA(0, 0, At, B0); PG8_MMA(0, 1, At, B1); PG8_BAR; PG8_SCHED;
            PG8_LDA(At, 0, 1); PG8_STAGE(PG8_SB(0, 0), b2, voffB); PG8_STAGE(PG8_SB(0, 1), b2 + hstep, voffB); PG8_STAGE(PG8_SA(0, 0), a2, voffA);
            PG8_WAIT_V(8); PG8_WAIT_L(0); PG8_BAR; PG8_MMA(1, 0, At, B0); PG8_MMA(1, 1, At, B1); PG8_BAR; PG8_SCHED;
            PG8_LDB(B0, 1, 0); PG8_LDB(B1, 1, 1); PG8_SCHED; PG8_LDA(At, 1, 0); PG8_STAGE(PG8_SA(0, 1), a2 + hstep, voffA);
            PG8_WAIT_V(8); PG8_WAIT_L(0); PG8_BAR; PG8_MMA(0, 0, At, B0); PG8_MMA(0, 1, At, B1); PG8_BAR; PG8_SCHED;
            PG8_LDA(At, 1, 1); PG8_STAGE(PG8_SB(1, 0), b3, voffB); PG8_STAGE(PG8_SB(1, 1), b3 + hstep, voffB); PG8_STAGE(PG8_SA(1, 0), a3, voffA);
            PG8_WAIT_V(8); PG8_WAIT_L(0); PG8_BAR; PG8_MMA(1, 0, At, B0); PG8_MMA(1, 1, At, B1); PG8_BAR; PG8_SCHED;
            } else {
            PG8_LDB(B0, 0, 0); PG8_SCHED; PG8_LDA(At, 0, 0); PG8_STAGE(PG8_SA(1, 1), a1 + hstep, voffA);
            PG8_WAIT_L(8); PG8_BAR; PG8_WAIT_L(0); PG8_MMA(0, 0, At, B0); PG8_BAR; PG8_SCHED;
            PG8_LDB(B1, 0, 1); PG8_STAGE(PG8_SB(0, 0), b2, voffB);
            PG8_BAR; PG8_WAIT_L(0); PG8_MMA(0, 1, At, B1); PG8_BAR;
            PG8_LDA(At, 0, 1); PG8_STAGE(PG8_SA(0, 0), a2, voffA);
            PG8_BAR; PG8_WAIT_L(0); PG8_MMA(1, 0, At, B0); PG8_BAR; PG8_SCHED;
            PG8_STAGE(PG8_SB(0, 1), b2 + hstep, voffB);
            PG8_WAIT_V(6); PG8_BAR; PG8_MMA(1, 1, At, B1); PG8_BAR;
            PG8_LDB(B0, 1, 0); PG8_SCHED; PG8_LDA(At, 1, 0); PG8_STAGE(PG8_SA(0, 1), a2 + hstep, voffA);
            PG8_WAIT_L(8); PG8_BAR; PG8_WAIT_L(0); PG8_MMA(0, 0, At, B0); PG8_BAR; PG8_SCHED;
            PG8_LDB(B1, 1, 1); PG8_STAGE(PG8_SB(1, 0), b3, voffB);
            PG8_BAR; PG8_WAIT_L(0); PG8_MMA(0, 1, At, B1); PG8_BAR;
            PG8_LDA(At, 1, 1); PG8_STAGE(PG8_SA(1, 0), a3, voffA);
            PG8_BAR; PG8_WAIT_L(0); PG8_MMA(1, 0, At, B0); PG8_BAR; PG8_SCHED;
            PG8_STAGE(PG8_SB(1, 1), b3 + hstep, voffB);
            PG8_WAIT_V(6); PG8_BAR; PG8_MMA(1, 1, At, B1); PG8_BAR;
            }
        }
        if constexpr (ALIGN_EPI) { if (wr == 0) PG8_BAR; }
        if constexpr (!Epi::AFTER_DRAIN) { E(acc, cur, wr, wc, fr, fq); S.done(cur); }
        if (!has_next) break;
#pragma unroll
        for (int a = 0; a < 2; ++a)
#pragma unroll
            for (int b = 0; b < 2; ++b)
#pragma unroll
                for (int m = 0; m < 4; ++m)
#pragma unroll
                    for (int n = 0; n < 2; ++n) acc[a][b][m][n] = (f32x4){0.f, 0.f, 0.f, 0.f};
        cur = nxt; cA = nA; cB = nB; ++ui;
        if constexpr (ALIGN_EPI) { if (wr == 1) PG8_BAR; }
    }
    PG8_WAIT_V(0);
    if constexpr (!ALIGN_EPI) { if (wr == 0) PG8_BAR; }
    PG8_BAR;
    if constexpr (Epi::AFTER_DRAIN) { E.fused(acc, cur, wr, wc, fr, fq, lds, wid, lane); S.done(cur); }
#undef PG8_SA
#undef PG8_SB
#undef PG8_STAGE
#undef PG8_LDA
#undef PG8_LDB
#undef PG8_MMA
#undef PG8_WAIT_V
#undef PG8_WAIT_L
#undef PG8_BAR
#undef PG8_SCHED
}
}

#define GAS __attribute__((address_space(1)))
#define LAS __attribute__((address_space(3)))
typedef unsigned short bf16;
typedef unsigned v4u __attribute__((ext_vector_type(4)));
typedef float f32x4 __attribute__((ext_vector_type(4)));
typedef short bf16x8 __attribute__((ext_vector_type(8)));
typedef GAS unsigned gu32;
typedef GAS unsigned long long gu64;
#define RLX_AGENT __ATOMIC_RELAXED, __HIP_MEMORY_SCOPE_AGENT
#define LDS_WAIT() asm volatile("s_waitcnt lgkmcnt(0)" ::: "memory")
#define VM_WAIT() asm volatile("s_waitcnt vmcnt(0)" ::: "memory")
__device__ __forceinline__ unsigned long long rt() { return __builtin_amdgcn_s_memrealtime(); }
__device__ __forceinline__ unsigned f2bf(float f) { unsigned u = __builtin_bit_cast(unsigned, f); return (u + 0x7fffu + ((u >> 16) & 1u)) >> 16; }
__device__ __forceinline__ unsigned pk2(float lo, float hi) { return f2bf(lo) | (f2bf(hi) << 16); }

#define XB_TMO      128
#define XB_XCNT(j)  (256  + 64 * (j))
#define XB_XSUB(j)  (1280 + 64 * (j))
#define XB_XGEN(j)  (2304 + 64 * (j))
#define XB_TOP      3328
#define XB_TOPGEN   3392
#define XCD_BAR_WORDS 3456
#define XB_SPIN_CAP (1u << 18)

__device__ __forceinline__ unsigned xb_ld(unsigned* p)              { return __hip_atomic_load(p, __ATOMIC_RELAXED, __HIP_MEMORY_SCOPE_AGENT); }
__device__ __forceinline__ unsigned xb_add(unsigned* p, unsigned v) { return __hip_atomic_fetch_add(p, v, __ATOMIC_RELAXED, __HIP_MEMORY_SCOPE_AGENT); }
__device__ __forceinline__ unsigned xb_xcc_id() { return (unsigned)__builtin_amdgcn_s_getreg((3 << 11) | 20) & 0xFu; }
#define XB_SPIN(cond, bar) do { unsigned _sp = 0; while (cond) { __builtin_amdgcn_s_sleep(1); \
    if ((++_sp & 255u) == 0u) { if (xb_ld(&(bar)[XB_TMO])) break; if (_sp > XB_SPIN_CAP) { atomicAdd(&(bar)[XB_TMO], 1u); break; } } } } while (0)

struct XcdBarrier {
    unsigned* bar; unsigned x;
    volatile LAS unsigned* st;
};

__device__ __forceinline__ XcdBarrier xcd_barrier_post(unsigned* bar, volatile LAS unsigned* st) {
    XcdBarrier b; b.bar = bar; b.x = xb_xcc_id(); b.st = st;
    if (threadIdx.x == 0) (void)xb_add(&bar[XB_XCNT(b.x)], 1u);
    return b;
}
__device__ __forceinline__ void xcd_barrier_complete(unsigned* bar, unsigned x, unsigned& nloc, unsigned& nx) {
    const unsigned G = gridDim.x * gridDim.y * gridDim.z;
    unsigned sum, cnt, mine, sp = 0u;
    for (;;) {
        sum = 0u; cnt = 0u; mine = 0u;
#pragma unroll
        for (unsigned j = 0; j < 16; ++j) { const unsigned c = xb_ld(&bar[XB_XCNT(j)]); sum += c; cnt += (c > 0u) ? 1u : 0u; mine = (j == x) ? c : mine; }
        if (sum == G) break;
        __builtin_amdgcn_s_sleep(1);
        if ((++sp & 255u) == 0u) { if (xb_ld(&bar[XB_TMO])) break; if (sp > XB_SPIN_CAP) { atomicAdd(&bar[XB_TMO], 1u); break; } }
    }
    nloc = mine > 0u ? mine : 1u; nx = cnt > 0u ? cnt : 1u;
}

__device__ __forceinline__ void xcd_barrier(const XcdBarrier& b, const bool leader  ) {
    asm volatile("s_waitcnt vmcnt(0)" ::: "memory");
    __syncthreads();
    if (leader) {
        unsigned* bar = b.bar;
        __builtin_amdgcn_s_waitcnt(0);
        unsigned nloc = b.st[0], nx = b.st[1];
        if (nloc == 0u) { xcd_barrier_complete(bar, b.x, nloc, nx); b.st[0] = nloc; b.st[1] = nx; }
        const unsigned old = xb_add(&bar[XB_XSUB(b.x)], 1u);
        const unsigned gen = old / nloc;
        if (old + 1u == (gen + 1u) * nloc) {
            __builtin_amdgcn_fence(__ATOMIC_RELEASE, "agent");
            asm volatile("s_waitcnt vmcnt(0)" ::: "memory");
            const unsigned og = xb_add(&bar[XB_TOP], 1u);
            const unsigned tg = og / nx;
            if (og + 1u == (tg + 1u) * nx) xb_add(&bar[XB_TOPGEN], 1u);
            else XB_SPIN(xb_ld(&bar[XB_TOPGEN]) == tg, bar);
            __builtin_amdgcn_fence(__ATOMIC_ACQUIRE, "agent");
            xb_add(&bar[XB_XGEN(b.x)], 1u);
            asm volatile("s_waitcnt vmcnt(0)" ::: "memory");
        } else {
            XB_SPIN(xb_ld(&bar[XB_XGEN(b.x)]) == gen, bar);
            __builtin_amdgcn_fence(__ATOMIC_ACQUIRE, "agent");
            asm volatile("s_waitcnt vmcnt(0)" ::: "memory");
        }
    }
    __syncthreads();
}
#ifndef REP_P0
#define REP_P0 1
#endif
#ifndef REP_P1
#define REP_P1 1
#endif
#ifndef REP_P2
#define REP_P2 1
#endif
#ifndef REP_P2A
#define REP_P2A 1
#endif
#ifndef REP_SEQ
#define REP_SEQ 1
#endif
#ifndef REP_DSW
#define REP_DSW 1
#endif
#ifndef REP_P3
#define REP_P3 1
#endif
#ifndef REP_P4
#define REP_P4 1
#endif
#ifndef REP_P5
#define REP_P5 1
#endif
#ifndef REP_P6
#define REP_P6 1
#endif
#ifndef REP_P7
#define REP_P7 1
#endif
constexpr int NWAVES = 8;
constexpr int T = 32768, D = 1024, SEQ = 4096;
constexpr int INC = 3328, INCP = 3328, INC_OLD = 3088;
constexpr int OFF_QA = 0, OFF_KA = 256, OFF_VA = 512, OFF_RA = 1024, OFF_LA = 1536, OFF_QB = 1792, OFF_KB = 2304, OFF_VB = 2816;
constexpr float EPS = 1e-6f;
constexpr size_t MiB = 1u << 20;
constexpr size_t WS_CTL = 0, CTL_ZERO_BYTES = 1 * MiB;
constexpr size_t WS_BT_IN = 2 * MiB, WS_BT_OUT = 10 * MiB, WS_BT_PQ = 12 * MiB, WS_BT_PG = 16 * MiB, WS_BT_PP = 18 * MiB;
constexpr size_t WS_ROPE = 20 * MiB, WS_SSQ1 = 22 * MiB, WS_RSTD2 = 24 * MiB, WS_KEYSB = 26 * MiB, WS_GDEC = 27 * MiB;
constexpr size_t WS_H1 = 32 * MiB;
constexpr size_t WS_PROJ = 96 * MiB;
constexpr size_t WS_QR = 96 * MiB, WS_SEL = 224 * MiB;
constexpr size_t WS_MIX = 304 * MiB;
constexpr size_t WS_PB = 368 * MiB;
constexpr size_t WS_PPROJ = 384 * MiB;
constexpr size_t WS_X2B = 304 * MiB;
constexpr size_t WS_UB = 448 * MiB, WS_VB = 464 * MiB;
constexpr size_t WS_GOG = 32 * MiB;
constexpr size_t WS_GQD = 368 * MiB;
constexpr size_t WS_GKV = 480 * MiB;
constexpr size_t WS_END = 512 * MiB;
constexpr int CW_BAR = 4096;
constexpr int CW_DSW = 16384;
constexpr int RING_OFF = 0, RING_BYTES = 131072;
constexpr int LDSCTL_OFF = 159 * 1024, MISC_OFF = LDSCTL_OFF + 320;
constexpr int LDS_BYTES = 163840;

__device__ __forceinline__ float bf2f(bf16 v) { return __uint_as_float(((unsigned)v) << 16); }
__device__ __forceinline__ float wave_sum(float v) {
    v += __int_as_float(__builtin_amdgcn_update_dpp(0, __float_as_int(v), 0xB1, 0xF, 0xF, true));
    v += __int_as_float(__builtin_amdgcn_update_dpp(0, __float_as_int(v), 0x4E, 0xF, 0xF, true));
    v += __int_as_float(__builtin_amdgcn_update_dpp(0, __float_as_int(v), 0x141, 0xF, 0xF, true));
    v += __int_as_float(__builtin_amdgcn_update_dpp(0, __float_as_int(v), 0x140, 0xF, 0xF, true));
    v += __int_as_float(__builtin_amdgcn_update_dpp(0, __float_as_int(v), 0x142, 0xA, 0xF, false));
    v += __int_as_float(__builtin_amdgcn_update_dpp(0, __float_as_int(v), 0x143, 0xC, 0xF, false));
    return __int_as_float(__builtin_amdgcn_readlane(__float_as_int(v), 63));
}
__device__ __forceinline__ float xshfl(float v, int srclane) { return __int_as_float(__builtin_amdgcn_ds_bpermute(srclane << 2, __float_as_int(v))); }
__device__ __forceinline__ int xshfl_i(int v, int srclane) { return __builtin_amdgcn_ds_bpermute(srclane << 2, v); }


typedef __bf16 bf16x2_t __attribute__((ext_vector_type(2)));
typedef int i32x2 __attribute__((ext_vector_type(2)));
typedef short s16x4 __attribute__((ext_vector_type(4)));
typedef float f32x2 __attribute__((ext_vector_type(2)));
typedef float f32x32 __attribute__((ext_vector_type(32)));
typedef float f32x16 __attribute__((ext_vector_type(16)));
typedef __bf16 bf16x32 __attribute__((ext_vector_type(32)));
typedef unsigned u32x6 __attribute__((ext_vector_type(6)));
typedef unsigned u32x16 __attribute__((ext_vector_type(16)));
__device__ __forceinline__ unsigned enc6(float y) { const float q = fabsf(y) * 8.f; float c;
    if (q < 16.f) c = rintf(q); else if (q < 32.f) c = 16.f + rintf((q - 16.f) * 0.5f); else c = 24.f + rintf((q - 32.f) * 0.25f);
    c = fminf(c, 31.f); return (unsigned)c | ((__float_as_uint(y) >> 31) << 5); }
__device__ __forceinline__ unsigned enc4(float y) { const float a = fabsf(y);
    const unsigned c = (a > 0.25f) + (a > 0.75f) + (a > 1.25f) + (a > 1.75f) + (a > 2.5f) + (a > 3.5f) + (a > 5.0f); return c | ((__float_as_uint(y) >> 31) << 3); }
__device__ __forceinline__ unsigned cvtpk(float a, float b) { const f32x2 v = {a, b}; return __builtin_bit_cast(unsigned, __builtin_convertvector(v, bf16x2_t)); }
template <int CTRL> __device__ __forceinline__ float dpp_mov(float v) { return __int_as_float(__builtin_amdgcn_update_dpp(0, __float_as_int(v), CTRL, 0xF, 0xF, true)); }
__device__ __forceinline__ float row_sum16(float v) { v += dpp_mov<0xB1>(v); v += dpp_mov<0x4E>(v); v += dpp_mov<0x141>(v); v += dpp_mov<0x140>(v); return v; }
__device__ __forceinline__ float dot2bf(unsigned a, unsigned b, float c) { return __builtin_amdgcn_fdot2_f32_bf16(__builtin_bit_cast(bf16x2_t, a), __builtin_bit_cast(bf16x2_t, b), c, false); }
__device__ __forceinline__ float bflo(unsigned w) { return __uint_as_float(w << 16); }
__device__ __forceinline__ float bfhi(unsigned w) { return __uint_as_float(w & 0xffff0000u); }


__device__ __forceinline__ int f2key(float f) { const int b = __float_as_int(f); return b ^ ((b >> 31) & 0x7fffffff); }
__device__ __forceinline__ float key2f(int k) { return __int_as_float(k ^ ((k >> 31) & 0x7fffffff)); }
#define CE_DESC(a, b) { const int _hi = max((a), (b)), _lo = min((a), (b)); (a) = _hi; (b) = _lo; }
template <int N> __device__ __forceinline__ void bitonic_sort_desc(int (&v)[N]) {
#pragma unroll
    for (int k = 2; k <= N; k <<= 1)
#pragma unroll
        for (int j = k >> 1; j > 0; j >>= 1)
#pragma unroll
            for (int i = 0; i < N; ++i) { const int l = i ^ j; if (l > i) { if ((i & k) == 0) CE_DESC(v[i], v[l]) else CE_DESC(v[l], v[i]) } }
}
template <int N> __device__ __forceinline__ void bitonic_merge_desc(int (&v)[N]) {
#pragma unroll
    for (int j = N >> 1; j > 0; j >>= 1)
#pragma unroll
        for (int i = 0; i < N; ++i) { const int l = i ^ j; if (l > i) CE_DESC(v[i], v[l]) }
}
__device__ __forceinline__ void merge_top16(int (&a)[16], int srclane) {
    int b[16];
#pragma unroll
    for (int i = 0; i < 16; ++i) b[i] = __builtin_amdgcn_ds_bpermute(srclane << 2, a[i]);
#pragma unroll
    for (int i = 0; i < 16; ++i) a[i] = max(a[i], b[15 - i]);
    bitonic_merge_desc<16>(a);
}
struct CandTab { int i[64], j[64]; int n;
    constexpr CandTab() : i{}, j{}, n(0) { for (int a = 0; a < 16; ++a) for (int b = 0; b < 16; ++b) if ((a + 1) * (b + 1) <= 16) { i[n] = a; j[n] = b; ++n; } for (int q = n; q < 64; ++q) { i[q] = -1; j[q] = -1; } } };
constexpr CandTab kCand{};
static_assert(kCand.n == 50, "50 product-key candidates can reach the top 16");

__device__ __forceinline__ float max_x16(float x) { const auto r = __builtin_amdgcn_permlane16_swap(__float_as_uint(x), __float_as_uint(x), false, false); return fmaxf(__uint_as_float(r[0]), __uint_as_float(r[1])); }
__device__ __forceinline__ float max_x32(float x) { const auto r = __builtin_amdgcn_permlane32_swap(__float_as_uint(x), __float_as_uint(x), false, false); return fmaxf(__uint_as_float(r[0]), __uint_as_float(r[1])); }
__device__ __forceinline__ float add_x16(float x) { const auto r = __builtin_amdgcn_permlane16_swap(__float_as_uint(x), __float_as_uint(x), false, false); return __uint_as_float(r[0]) + __uint_as_float(r[1]); }
__device__ __forceinline__ float add_x32(float x) { const auto r = __builtin_amdgcn_permlane32_swap(__float_as_uint(x), __float_as_uint(x), false, false); return __uint_as_float(r[0]) + __uint_as_float(r[1]); }

__device__ __forceinline__ void p0_transpose_item(const float* W, int K, int ldw, int src0, int ncols, const float* gain, bf16* WT, int dst0, int nblk, LAS float* scr, int item, int lane) {
    const int kb = item / nblk, nb = item % nblk, k0 = 64 * kb, n0 = 32 * nb;
    const int n = n0 + (lane & 31);
#pragma unroll 8
    for (int i = 0; i < 32; ++i) { const int kk = 2 * i + (lane >> 5); float v = 0.f; if (n < ncols) { v = W[(size_t)(k0 + kk) * ldw + src0 + n]; if (gain) v *= gain[k0 + kk]; } scr[kk * 33 + (lane & 31)] = v; }
    LDS_WAIT(); asm volatile("" ::: "memory");
    const int c = lane & 7;
#pragma unroll
    for (int j = 0; j < 4; ++j) { const int nn = (lane >> 3) + 8 * j; const LAS float* s = scr + (8 * c) * 33 + nn;
        v4u o; o.x = pk2(s[0 * 33], s[1 * 33]); o.y = pk2(s[2 * 33], s[3 * 33]); o.z = pk2(s[4 * 33], s[5 * 33]); o.w = pk2(s[6 * 33], s[7 * 33]);
        *(GAS v4u*)(WT + (size_t)(dst0 + n0 + nn) * K + k0 + 8 * c) = o; }
    LDS_WAIT(); asm volatile("" ::: "memory");
}

struct Args { const float* in[18]; float* outp; unsigned char* ws; };

#define xin      (args.in[0])
#define p_in     (args.in[1])
#define positions ((const int*)args.in[2])
#define g_mix    (args.in[3])
#define w_in     (args.in[4])
#define w_up     (args.in[5])
#define b_gate   (args.in[6])
#define g_gla    (args.in[7])
#define w_out    (args.in[8])
#define g_peer   (args.in[9])
#define w_pq     (args.in[10])
#define skeys    (args.in[11])
#define pu       (args.in[12])
#define pv       (args.in[13])
#define g_ple    (args.in[14])
#define w_pg     (args.in[15])
#define w_pp     (args.in[16])
#define g_final  (args.in[17])
#define out      (args.outp)
#define Bt_in    ((bf16*)(args.ws + WS_BT_IN))
#define Bt_out   ((bf16*)(args.ws + WS_BT_OUT))
#define Bt_pq    ((bf16*)(args.ws + WS_BT_PQ))
#define Bt_pg    ((bf16*)(args.ws + WS_BT_PG))
#define Bt_pp    ((bf16*)(args.ws + WS_BT_PP))
#define rope     ((float*)(args.ws + WS_ROPE))
#define ssq1     ((float*)(args.ws + WS_SSQ1))
#define rstd2    ((float*)(args.ws + WS_RSTD2))
#define h1       ((bf16*)(args.ws + WS_H1))
#define x1b      ((bf16*)(args.ws + WS_H1))
#define proj     ((bf16*)(args.ws + WS_PROJ))
#define qr       ((bf16*)(args.ws + WS_QR))
#define sel2     ((i32x2*)(args.ws + WS_SEL))
#define Ub       ((unsigned char*)(args.ws + WS_UB))
#define Vb       ((unsigned char*)(args.ws + WS_VB))
#define keysb    ((bf16*)(args.ws + WS_KEYSB))
#define mix      ((bf16*)(args.ws + WS_MIX))
#define pb       ((bf16*)(args.ws + WS_PB))
#define pproj    ((bf16*)(args.ws + WS_PPROJ))
#define x2b      ((bf16*)(args.ws + WS_X2B))


__global__ void __launch_bounds__(NWAVES * 64, 2) mk_fwd(Args args) {
    extern __shared__ __attribute__((aligned(16))) unsigned char lds[];
    LAS unsigned char* const L = (LAS unsigned char*)lds;
    volatile LAS unsigned* const MISC = (volatile LAS unsigned*)(L + MISC_OFF);
    const int wave = __builtin_amdgcn_readfirstlane((int)threadIdx.x >> 6);
#define LANE_DECL int lane; asm volatile("v_mbcnt_lo_u32_b32 %0, -1, 0\n\tv_mbcnt_hi_u32_b32 %0, -1, %0" : "=v"(lane))
    const int G = gridDim.x; const int bx = blockIdx.x;
    const int vcu = (G % 8 == 0) ? (bx % 8) * (G / 8) + bx / 8 : bx;
    const int gw = vcu * NWAVES + wave, NGW = G * NWAVES;
    gu32* const ctl = (gu32*)(args.ws + WS_CTL);
    for (int u = threadIdx.x; u < (LDS_BYTES - LDSCTL_OFF) / 4; u += NWAVES * 64) ((LAS unsigned*)(L + LDSCTL_OFF))[u] = 0u;
    __syncthreads();
    XcdBarrier bar = xcd_barrier_post((unsigned*)(ctl + CW_BAR), MISC + 8);

    for (int rep_ = 0; rep_ < REP_P0; ++rep_) {
        LANE_DECL;
        LAS float* scr = (LAS float*)(L + RING_OFF + wave * 16384);
        constexpr int I_INA = 16 * 48, I_INB = 16 * 48, I_PP = 4 * 32;
        constexpr int NITEMS = I_INA + I_INB + I_PP;
        for (int it = gw; it < NITEMS; it += NGW) {
            int r = it;
            if (r < I_INA) { p0_transpose_item(w_in, 1024, INC_OLD, 0, 1536, nullptr, Bt_in, 0, 48, scr, r, lane); continue; } r -= I_INA;
            if (r < I_INB) { p0_transpose_item(w_in, 1024, INC_OLD, 1552, 1536, nullptr, Bt_in, 1792, 48, scr, r, lane); continue; } r -= I_INB;
            p0_transpose_item(w_pp, 256, 1024, 0, 1024, nullptr, Bt_pp, 0, 32, scr, r, lane);
        }
        for (int i = gw * 64 + lane; i < 256 * 128; i += NGW * 64) {
            const int n = i >> 7, k0 = (i & 127) * 8;
            float wu[16];
#pragma unroll
            for (int r = 0; r < 16; ++r) wu[r] = w_up[r * 256 + n];
            float o8[8];
#pragma unroll
            for (int kk = 0; kk < 8; ++kk) { const GAS f32x4* wr4 = (const GAS f32x4*)(w_in + (size_t)(k0 + kk) * INC_OLD + 1536); float a = 0.f;
#pragma unroll
                for (int q = 0; q < 4; ++q) { const f32x4 w4 = wr4[q]; a += w4.x * wu[4 * q] + w4.y * wu[4 * q + 1] + w4.z * wu[4 * q + 2] + w4.w * wu[4 * q + 3]; }
                o8[kk] = a; }
            v4u o; o.x = pk2(o8[0], o8[1]); o.y = pk2(o8[2], o8[3]); o.z = pk2(o8[4], o8[5]); o.w = pk2(o8[6], o8[7]);
            *(GAS v4u*)(Bt_in + (size_t)(1536 + n) * 1024 + k0) = o;
        }
        for (int row = gw; row < T; row += NGW) {
            const GAS f32x4* xr = (const GAS f32x4*)(xin + (size_t)row * D) + lane;
            f32x4 v[4]; float s = 0.f;
#pragma unroll
            for (int j = 0; j < 4; ++j) { v[j] = xr[64 * j]; s += (v[j].x * v[j].x + v[j].y * v[j].y) + (v[j].z * v[j].z + v[j].w * v[j].w); }
            const float rstd = rsqrtf(wave_sum(s) * (1.f / D) + EPS);
            GAS unsigned long long* o8 = (GAS unsigned long long*)(h1 + (size_t)row * D) + lane;
#pragma unroll
            for (int j = 0; j < 4; ++j) { const f32x4 gg = ((const GAS f32x4*)g_mix)[64 * j + lane];
                o8[64 * j] = (unsigned long long)pk2(v[j].x * rstd * gg.x, v[j].y * rstd * gg.y) | ((unsigned long long)pk2(v[j].z * rstd * gg.z, v[j].w * rstd * gg.w) << 32); }
        }
        for (size_t i = (size_t)gw * 64 + lane; i < (size_t)T * 256 / 4; i += (size_t)NGW * 64) {
            const f32x4 v = ((const GAS f32x4*)p_in)[i];
            ((GAS unsigned long long*)pb)[i] = (unsigned long long)pk2(v.x, v.y) | ((unsigned long long)pk2(v.z, v.w) << 32);
        }
        for (int i = gw * 64 + lane; i < T * 8; i += NGW * 64) {
            const int t = i >> 3, j = i & 7;
            const float inv_freq = powf(500000.0f, -(float)j / 8.0f);
            const float ang = (float)positions[t] * inv_freq;
            rope[2 * i] = cosf(ang); rope[2 * i + 1] = sinf(ang);
        }
    }
    { LANE_DECL; xcd_barrier(bar, wave == 0 && lane == 0); }

    for (int rep_ = 0; rep_ < REP_P1; ++rep_) {
        pg8::Gemm g{h1, Bt_in, T, INCP, D}; pg8::StaticOrder S; S.init(T, INCP, G, bx);
        pg8::EpiInProj E{proj, rope, b_gate};
        pg8::gemm_phase<pg8::EpiInProj, pg8::StaticOrder, true, true>(L + RING_OFF, g, S, E, wave);
        pg8::Gemm g2{pb, Bt_pp, T, D, 256}; pg8::StaticOrder S2;
        { const int nfull = (T / 256) * (INCP / 256) - ((T / 256) * (INCP / 256) / G) * G;
          if (nfull > 0 && nfull < G && ((G - nfull) % 8) == 0 && (nfull % 8) == 0) S2.init(T, D, G - nfull, bx >= nfull ? bx - nfull : (1 << 28)); else S2.init(T, D, G, bx); }
        pg8::EpiBf16<0> E2{pproj, D, nullptr, 0, 0, 1.f};
        pg8::gemm_phase<pg8::EpiBf16<0>, pg8::StaticOrder, true, true>(L + RING_OFF, g2, S2, E2, wave);
    }
    { LANE_DECL; xcd_barrier(bar, wave == 0 && lane == 0); }

    {
        LANE_DECL;
        const int fr = lane & 15, g = lane >> 4;
        constexpr int RS = 144;
        LAS unsigned char* const qd = L + RING_OFF;
        LAS unsigned char* const kd = qd + 64 * RS;
        LAS unsigned char* const keT = kd + 64 * RS;
        LAS unsigned char* const vT = keT + 64 * RS;
        LAS unsigned char* const Am = vT + 128 * RS;
        LAS float* const dec = (LAS float*)(Am + 64 * RS);
        for (int i = wave * 64 + lane; i < 64 * RS / 4; i += NWAVES * 64) ((LAS unsigned*)Am)[i] = 0u;
        __syncthreads();
        for (int rep4_ = 0; rep4_ < REP_P2A; ++rep4_) {
        int u = bx;
        const bf16* prow = proj + (size_t)((u >> 6) * 64 + lane) * INC + 0;
        v4u lav, qv, kv, vv0, vv1;
        {
            const int hh = (u >> 6) & 3, t0 = (u >> 8) * SEQ + (u & 63) * 64;
            prow = proj + (size_t)(t0 + lane) * INC;
            lav = *(const GAS v4u*)(prow + OFF_LA + hh * 64 + 8 * wave); qv = *(const GAS v4u*)(prow + OFF_QA + hh * 64 + 8 * wave); kv = *(const GAS v4u*)(prow + OFF_KA + hh * 64 + 8 * wave);
            vv0 = *(const GAS v4u*)(prow + OFF_VA + hh * 128 + 16 * wave); vv1 = *(const GAS v4u*)(prow + OFF_VA + hh * 128 + 16 * wave + 8);
        }
        for (; u < 2048; u += G) {
            const int h = (u >> 6) & 3, t0 = (u >> 8) * SEQ + (u & 63) * 64;
            float laf[8];
            laf[0] = bflo(lav.x); laf[1] = bfhi(lav.x); laf[2] = bflo(lav.y); laf[3] = bfhi(lav.y); laf[4] = bflo(lav.z); laf[5] = bfhi(lav.z); laf[6] = bflo(lav.w); laf[7] = bfhi(lav.w);
            float qf[8], kf[8];
            qf[0] = bflo(qv.x); qf[1] = bfhi(qv.x); qf[2] = bflo(qv.y); qf[3] = bfhi(qv.y); qf[4] = bflo(qv.z); qf[5] = bfhi(qv.z); qf[6] = bflo(qv.w); qf[7] = bfhi(qv.w);
            kf[0] = bflo(kv.x); kf[1] = bfhi(kv.x); kf[2] = bflo(kv.y); kf[3] = bfhi(kv.y); kf[4] = bflo(kv.z); kf[5] = bfhi(kv.z); kf[6] = bflo(kv.w); kf[7] = bfhi(kv.w);
            float qdv[8], kdv[8], kev[8];
#pragma unroll
            for (int c = 0; c < 8; ++c) {
                float bsum = laf[c];
                bsum += __int_as_float(__builtin_amdgcn_update_dpp(0, __float_as_int(bsum), 0x111, 0xF, 0xF, false));
                bsum += __int_as_float(__builtin_amdgcn_update_dpp(0, __float_as_int(bsum), 0x112, 0xF, 0xF, false));
                bsum += __int_as_float(__builtin_amdgcn_update_dpp(0, __float_as_int(bsum), 0x114, 0xF, 0xF, false));
                bsum += __int_as_float(__builtin_amdgcn_update_dpp(0, __float_as_int(bsum), 0x118, 0xF, 0xF, false));
                bsum += __int_as_float(__builtin_amdgcn_update_dpp(0, __float_as_int(bsum), 0x142, 0xA, 0xF, false));
                bsum += __int_as_float(__builtin_amdgcn_update_dpp(0, __float_as_int(bsum), 0x143, 0xC, 0xF, false));
                const float blast = __int_as_float(__builtin_amdgcn_readlane(__float_as_int(bsum), 63));
                qdv[c] = qf[c] * 0.125f * __expf(bsum);
                kdv[c] = kf[c] * __expf(-bsum);
                kev[c] = kf[c] * __expf(blast - bsum);
                if (lane == 0) dec[8 * wave + c] = __expf(blast);
            }
#pragma unroll
            for (int c = 0; c < 8; c += 2) { const unsigned w2 = cvtpk(kev[c], kev[c + 1]);
                *(LAS bf16*)(keT + (8 * wave + c) * RS + lane * 2) = (bf16)(w2 & 0xffffu); *(LAS bf16*)(keT + (8 * wave + c + 1) * RS + lane * 2) = (bf16)(w2 >> 16); }
            { v4u o; o.x = cvtpk(qdv[0], qdv[1]); o.y = cvtpk(qdv[2], qdv[3]); o.z = cvtpk(qdv[4], qdv[5]); o.w = cvtpk(qdv[6], qdv[7]); *(LAS v4u*)(qd + lane * RS + 16 * wave) = o;
              v4u o2; o2.x = cvtpk(kdv[0], kdv[1]); o2.y = cvtpk(kdv[2], kdv[3]); o2.z = cvtpk(kdv[4], kdv[5]); o2.w = cvtpk(kdv[6], kdv[7]); *(LAS v4u*)(kd + lane * RS + 16 * wave) = o2; }
            {
                const unsigned vw[8] = {vv0.x, vv0.y, vv0.z, vv0.w, vv1.x, vv1.y, vv1.z, vv1.w};
#pragma unroll
                for (int e = 0; e < 8; ++e) { *(LAS bf16*)(vT + (16 * wave + 2 * e) * RS + lane * 2) = (bf16)(vw[e] & 0xffffu); *(LAS bf16*)(vT + (16 * wave + 2 * e + 1) * RS + lane * 2) = (bf16)(vw[e] >> 16); }
            }
            if (u + G < 2048) {
                const int un = u + G, hn = (un >> 6) & 3, tn = (un >> 8) * SEQ + (un & 63) * 64;
                const bf16* pn = proj + (size_t)(tn + lane) * INC;
                lav = *(const GAS v4u*)(pn + OFF_LA + hn * 64 + 8 * wave); qv = *(const GAS v4u*)(pn + OFF_QA + hn * 64 + 8 * wave); kv = *(const GAS v4u*)(pn + OFF_KA + hn * 64 + 8 * wave);
                vv0 = *(const GAS v4u*)(pn + OFF_VA + hn * 128 + 16 * wave); vv1 = *(const GAS v4u*)(pn + OFF_VA + hn * 128 + 16 * wave + 8);
            }
            unsigned long long rav[4];
#pragma unroll
            for (int tt = 0; tt < 4; ++tt) rav[tt] = *(const GAS unsigned long long*)(proj + (size_t)(t0 + 16 * tt + fr) * INC + OFF_RA + h * 128 + 16 * wave + 4 * g);
            const f32x4 ggl = *(const GAS f32x4*)(g_gla + h * 128 + 16 * wave + 4 * g);
            LDS_WAIT(); __syncthreads();
#pragma unroll
            for (int rep = 0; rep < 2; ++rep) {
                const int ti = wave + 8 * rep;
                if (ti < 10) {
                    const int tt = (ti >= 6) ? 3 : ((ti >= 3) ? 2 : ((ti >= 1) ? 1 : 0));
                    const int tk = ti - ((tt * (tt + 1)) >> 1);
                    f32x4 acc = {0.f, 0.f, 0.f, 0.f};
#pragma unroll
                    for (int ks = 0; ks < 2; ++ks) { const bf16x8 a = *(const LAS bf16x8*)(qd + (16 * tt + fr) * RS + (32 * ks + 8 * g) * 2), bb = *(const LAS bf16x8*)(kd + (16 * tk + fr) * RS + (32 * ks + 8 * g) * 2);
                        acc = __builtin_amdgcn_mfma_f32_16x16x32_bf16(a, bb, acc, 0, 0, 0); }
#pragma unroll
                    for (int r = 0; r < 4; ++r) { const int tq = 16 * tt + 4 * g + r, tc = 16 * tk + fr; *(LAS bf16*)(Am + tq * RS + tc * 2) = (bf16)f2bf(tq >= tc ? acc[r] : 0.f); }
                }
            }
            {
                const int tt = wave >> 1, ks = wave & 1;
                const unsigned long long lo = *(const LAS unsigned long long*)(qd + (16 * tt + fr) * RS + (32 * ks + 4 * g) * 2), hi = *(const LAS unsigned long long*)(qd + (16 * tt + fr) * RS + (32 * ks + 16 + 4 * g) * 2);
                v4u w; w.x = (unsigned)lo; w.y = (unsigned)(lo >> 32); w.z = (unsigned)hi; w.w = (unsigned)(hi >> 32);
                ((GAS v4u*)(args.ws + WS_GQD))[((size_t)u * 8 + wave) * 64 + lane] = w;
                if (wave == 0) ((GAS float*)(args.ws + WS_GDEC))[(size_t)u * 64 + lane] = dec[lane];
            }
            LDS_WAIT(); __syncthreads();
            bf16x8 vb[2];
#pragma unroll
            for (int ks = 0; ks < 2; ++ks) vb[ks] = *(const LAS bf16x8*)(vT + (16 * wave + fr) * RS + (32 * ks + 8 * g) * 2);
#pragma unroll
            for (int tt = 0; tt < 4; ++tt) {
                f32x4 acc = {0.f, 0.f, 0.f, 0.f};
#pragma unroll
                for (int ks = 0; ks < 2; ++ks) { const bf16x8 a = *(const LAS bf16x8*)(Am + (16 * tt + fr) * RS + (32 * ks + 8 * g) * 2); acc = __builtin_amdgcn_mfma_f32_16x16x32_bf16(vb[ks], a, acc, 0, 0, 0); }
                const unsigned rlo = (unsigned)rav[tt], rhi = (unsigned)(rav[tt] >> 32);
                const float rr[4] = {bflo(rlo), bfhi(rlo), bflo(rhi), bfhi(rhi)};
                v4u w;
#pragma unroll
                for (int r = 0; r < 4; ++r) { const float gate = ggl[r] * rr[r] * __builtin_amdgcn_rcpf(1.f + __expf(-rr[r])); w[r] = cvtpk(acc[r], gate); }
                ((GAS v4u*)(args.ws + WS_GOG))[(((size_t)u * 8 + wave) * 4 + tt) * 64 + lane] = w;
            }
#pragma unroll
            for (int dt = 0; dt < 4; ++dt) {
                f32x4 acc = {0.f, 0.f, 0.f, 0.f};
#pragma unroll
                for (int ks = 0; ks < 2; ++ks) { const bf16x8 a = *(const LAS bf16x8*)(keT + (16 * dt + fr) * RS + (32 * ks + 8 * g) * 2); acc = __builtin_amdgcn_mfma_f32_16x16x32_bf16(a, vb[ks], acc, 0, 0, 0); }
                const unsigned long long w = (unsigned long long)cvtpk(acc[0], acc[1]) | ((unsigned long long)cvtpk(acc[2], acc[3]) << 32);
                ((GAS unsigned long long*)(args.ws + WS_GKV))[(((size_t)u * 8 + wave) * 4 + dt) * 64 + lane] = w;
            }
            LDS_WAIT(); __syncthreads();
        }
        }
    }
    { LANE_DECL; xcd_barrier(bar, wave == 0 && lane == 0); }

    for (int rep_ = 0; rep_ < REP_P2; ++rep_) {
    for (int rep3_ = 0; rep3_ < REP_SEQ; ++rep3_)
    if (bx < 32) {
        LANE_DECL;
        const int fr = lane & 15, g = lane >> 4;
        const int b = bx >> 2, h = bx & 3;
        LAS float* const ssqb = (LAS float*)(L + RING_OFF);
        LAS float* const rstdl = ssqb + 1024 + wave * 64;
        f32x4 S[4];
#pragma unroll
        for (int dt = 0; dt < 4; ++dt) S[dt] = (f32x4){0.f, 0.f, 0.f, 0.f};
        const GAS v4u* const gog = (const GAS v4u*)(args.ws + WS_GOG);
        const GAS unsigned long long* const gkv = (const GAS unsigned long long*)(args.ws + WS_GKV);
        const GAS v4u* const gqd = (const GAS v4u*)(args.ws + WS_GQD);
        const GAS f32x4* const gdec = (const GAS f32x4*)(args.ws + WS_GDEC);
        const int u0 = bx * 64;
        v4u ogA[4], ogB[4]; unsigned long long kvA[4], kvB[4]; v4u qdA[8], qdB[8]; f32x4 dcA[4], dcB[4];
#define GLA_LOAD(og_, kv_, qd_, dc_, uu) do { const size_t u_ = (size_t)(uu); \
        _Pragma("unroll") for (int q = 0; q < 4; ++q) { og_[q] = gog[((u_ * 8 + wave) * 4 + q) * 64 + lane]; kv_[q] = gkv[((u_ * 8 + wave) * 4 + q) * 64 + lane]; dc_[q] = gdec[u_ * 16 + 4 * q + g]; } \
        _Pragma("unroll") for (int q = 0; q < 8; ++q) qd_[q] = gqd[(u_ * 8 + q) * 64 + lane]; } while (0)
#define GLA_STEP(og_, kv_, qd_, dc_, n_) do { \
            const int t0 = b * SEQ + (n_) * 64; \
            bf16x8 sa[2];                                                   \
            _Pragma("unroll") for (int ks = 0; ks < 2; ++ks) { v4u w; w.x = cvtpk(S[2 * ks][0], S[2 * ks][1]); w.y = cvtpk(S[2 * ks][2], S[2 * ks][3]); w.z = cvtpk(S[2 * ks + 1][0], S[2 * ks + 1][1]); w.w = cvtpk(S[2 * ks + 1][2], S[2 * ks + 1][3]); sa[ks] = __builtin_bit_cast(bf16x8, w); } \
            f32x4 o[4]; f32x4 gt[4];                                        \
            _Pragma("unroll") for (int tt = 0; tt < 4; ++tt) { \
                f32x4 acc; \
                _Pragma("unroll") for (int r = 0; r < 4; ++r) { acc[r] = bflo(og_[tt][r]); gt[tt][r] = bfhi(og_[tt][r]); } \
                _Pragma("unroll") for (int ks = 0; ks < 2; ++ks) acc = __builtin_amdgcn_mfma_f32_16x16x32_bf16(sa[ks], __builtin_bit_cast(bf16x8, qd_[2 * tt + ks]), acc, 0, 0, 0); \
                o[tt] = acc; } \
            _Pragma("unroll") for (int dt = 0; dt < 4; ++dt) { const unsigned lo = (unsigned)kv_[dt], hi = (unsigned)(kv_[dt] >> 32); \
                S[dt][0] = S[dt][0] * dc_[dt][0] + bflo(lo); S[dt][1] = S[dt][1] * dc_[dt][1] + bfhi(lo); S[dt][2] = S[dt][2] * dc_[dt][2] + bflo(hi); S[dt][3] = S[dt][3] * dc_[dt][3] + bfhi(hi); } \
            LAS float* const sq = ssqb + ((n_) & 1) * 512; \
            _Pragma("unroll") for (int tt = 0; tt < 4; ++tt) { float s2 = (o[tt][0] * o[tt][0] + o[tt][1] * o[tt][1]) + (o[tt][2] * o[tt][2] + o[tt][3] * o[tt][3]); s2 = add_x32(add_x16(s2)); if (g == 0) sq[wave * 64 + 16 * tt + fr] = s2; } \
            LDS_WAIT(); __syncthreads(); \
            { float tot = 0.f; \
              _Pragma("unroll") for (int w2 = 0; w2 < 8; ++w2) tot += sq[w2 * 64 + lane]; \
              rstdl[lane] = __builtin_amdgcn_rsqf(tot * (1.f / 128.f) + EPS); } \
            LDS_WAIT(); asm volatile("" ::: "memory"); \
            _Pragma("unroll") for (int tt = 0; tt < 4; ++tt) { \
                const float rs = rstdl[16 * tt + fr]; \
                const unsigned long long w = (unsigned long long)cvtpk(o[tt][0] * rs * gt[tt][0], o[tt][1] * rs * gt[tt][1]) | ((unsigned long long)cvtpk(o[tt][2] * rs * gt[tt][2], o[tt][3] * rs * gt[tt][3]) << 32); \
                *(GAS unsigned long long*)(mix + (size_t)(t0 + 16 * tt + fr) * D + h * 128 + 16 * wave + 4 * g) = w; } \
            LDS_WAIT(); asm volatile("" ::: "memory"); } while (0)
        GLA_LOAD(ogA, kvA, qdA, dcA, u0);
        for (int n = 0; n < 64; n += 2) {
            GLA_LOAD(ogB, kvB, qdB, dcB, u0 + n + 1);
            GLA_STEP(ogA, kvA, qdA, dcA, n);
            if (n + 2 < 64) GLA_LOAD(ogA, kvA, qdA, dcA, u0 + n + 2);
            GLA_STEP(ogB, kvB, qdB, dcB, n + 1);
        }
#undef GLA_LOAD
#undef GLA_STEP
        __syncthreads();
    }
    if (bx >= 32) {
        LANE_DECL;
        LAS float* scr = (LAS float*)(L + RING_OFF + wave * 16384);
        const int gwl = (bx - 32) * NWAVES + wave, NGWL = (G - 32) * NWAVES;
        constexpr int I_OUT = 16 * 32, I_PQ = 16 * 64, I_PG = 16 * 32;
        for (int it = gwl; it < I_OUT + I_PQ + I_PG; it += NGWL) {
            int r = it;
            if (r < I_OUT) { p0_transpose_item(w_out, 1024, 1024, 0, 1024, nullptr, Bt_out, 0, 32, scr, r, lane); continue; } r -= I_OUT;
            if (r < I_PQ) { p0_transpose_item(w_pq, 1024, 2048, 0, 2048, g_peer, Bt_pq, 0, 64, scr, r, lane); continue; } r -= I_PQ;
            p0_transpose_item(w_pg, 1024, 1024, 0, 1024, g_ple, Bt_pg, 0, 32, scr, r, lane);
        }
        for (int i = gwl * 64 + lane; i < 16384 * 16 * 2; i += NGWL * 64) {
            const int tab = i >> 18, row = (i >> 4) & 16383, li = i & 15;
            const float* src = (tab ? pv : pu) + (size_t)row * D;
            const float scl = tab ? 4.f : 64.f;
            unsigned dw[12];
#pragma unroll
            for (int q = 0; q < 12; ++q) dw[q] = 0u;
#pragma unroll
            for (int j = 0; j < 4; ++j)
#pragma unroll
                for (int e4 = 0; e4 < 4; ++e4) {
                    f32x4 v = ((const GAS f32x4*)(src + 256 * j + 16 * li))[e4];
                    if (!tab) v = v * ((const GAS f32x4*)(g_peer + 256 * j + 16 * li))[e4];
                    v = v * scl;
#pragma unroll
                    for (int e = 0; e < 4; ++e) {
                        const int k = (j & 1) * 16 + e4 * 4 + e, grp = j >> 1;
                        if (!tab) { const int bit = 6 * k, w = bit >> 5, sh = bit & 31; const unsigned c = enc6(v[e]); dw[grp * 6 + w] |= c << sh; if (sh > 26) dw[grp * 6 + w + 1] |= c >> (32 - sh); }
                        else dw[grp * 4 + (k >> 3)] |= enc4(v[e]) << (4 * (k & 7));
                    }
                }
            if (!tab) { GAS v4u* dst = (GAS v4u*)(Ub + (size_t)row * 768) + li;
                v4u o0, o1, o2; o0.x = dw[0]; o0.y = dw[1]; o0.z = dw[2]; o0.w = dw[3]; o1.x = dw[4]; o1.y = dw[5]; o1.z = dw[6]; o1.w = dw[7]; o2.x = dw[8]; o2.y = dw[9]; o2.z = dw[10]; o2.w = dw[11];
                dst[0] = o0; dst[16] = o1; dst[32] = o2; }
            else { GAS v4u* dst = (GAS v4u*)(Vb + (size_t)row * 512) + li;
                v4u o0, o1; o0.x = dw[0]; o0.y = dw[1]; o0.z = dw[2]; o0.w = dw[3]; o1.x = dw[4]; o1.y = dw[5]; o1.z = dw[6]; o1.w = dw[7];
                dst[0] = o0; dst[16] = o1; }
        }
        for (int i = gwl * 64 + lane; i < 16 * 128 * 128 / 4; i += NGWL * 64) {
            const f32x4 v = ((const GAS f32x4*)skeys)[i];
            ((GAS unsigned long long*)keysb)[i] = (unsigned long long)pk2(v.x, v.y) | ((unsigned long long)pk2(v.z, v.w) << 32);
        }
        __syncthreads();
    }
    for (int rep2_ = 0; rep2_ < REP_DSW; ++rep2_)
    {
        LANE_DECL;
        const int qc = lane & 31, hh = lane >> 5;
        constexpr int OROW = 136;
        LAS unsigned char* const Ob = L + RING_OFF;
        constexpr int KROW = 144;
        LAS unsigned char* const Kst = L + RING_OFF + 512 * OROW + wave * (2 * 32 * KROW);
        LAS unsigned char* const Vst = Kst + 32 * KROW;
        volatile LAS int* const ubox = (volatile LAS int*)(L + MISC_OFF + 64);
        const float C2 = 0.125f * 1.4426950408889634f;
        for (;;) {
            if (wave == 0 && lane == 0) ubox[0] = (int)__hip_atomic_fetch_add(ctl + CW_DSW + 64 * (rep_ * 4 + rep2_), 1u, __ATOMIC_RELAXED, __HIP_MEMORY_SCOPE_AGENT);
            __syncthreads();
            const int unit = __builtin_amdgcn_readfirstlane(ubox[0]);
            if (unit >= 512) break;
            const int sp = unit & 7, h = (unit >> 3) & 7, b = unit >> 6;
            const int s0 = sp * 512;
            const bf16* const base = proj + (size_t)b * SEQ * INC;
#pragma unroll 1
            for (int pt = 0; pt < 3; ++pt) {
                const int dl = (pt == 0) ? 0 : ((pt == 1) ? 2 : 4), d = 1 << dl;
#pragma unroll 1
                for (int rep = 0; rep < 2; ++rep) {
                    const int qt = wave + 8 * rep;
                    const int rr = qt & (d - 1), jj = qt >> dl;
                    const int tq0 = s0 + rr + ((32 * jj) << dl);
                    const int tkb = tq0 - (128 << dl);
                    int kkmin = 0;
                    if (tkb < 0) kkmin = (-tkb + d - 1) >> dl;
                    bf16x8 qf[4];
#pragma unroll
                    for (int ks = 0; ks < 4; ++ks) qf[ks] = *(const GAS bf16x8*)(base + (size_t)(tq0 + (qc << dl)) * INC + OFF_QB + h * 64 + 16 * ks + 8 * hh);
                    f32x16 O0, O1;
#pragma unroll
                    for (int r = 0; r < 16; ++r) { O0[r] = 0.f; O1[r] = 0.f; }
                    float m = -INFINITY, l = 0.f;
                    const int cmin = kkmin >> 5;
                    v4u kA[4], vA[4], kB[4], vB[4];
#define DSW_LOAD(kr_, vr_, c_) do { const int k0_ = 32 * (c_); \
                        _Pragma("unroll") for (int it = 0; it < 4; ++it) { const int pc = lane + 64 * it, key = pc >> 3, ch = pc & 7; int tk = tkb + ((k0_ + key) << dl); tk = tk < 0 ? 0 : (tk > SEQ - 1 ? SEQ - 1 : tk); \
                            const bf16* rp = base + (size_t)tk * INC + h * 64 + 8 * ch; kr_[it] = *(const GAS v4u*)(rp + OFF_KB); vr_[it] = *(const GAS v4u*)(rp + OFF_VB); } } while (0)
#define DSW_STEP(kr_, vr_, c_) do { const int k0 = 32 * (c_); \
                        _Pragma("unroll") for (int it = 0; it < 4; ++it) { const int pc = lane + 64 * it, key = pc >> 3, ch = pc & 7; *(LAS v4u*)(Kst + key * KROW + ch * 16) = kr_[it]; *(LAS v4u*)(Vst + key * KROW + ch * 16) = vr_[it]; } \
                        LDS_WAIT(); asm volatile("" ::: "memory"); \
                        f32x16 sc; \
                        _Pragma("unroll") for (int r = 0; r < 16; ++r) sc[r] = 0.f; \
                        _Pragma("unroll") for (int ks = 0; ks < 4; ++ks) { const bf16x8 ka = *(const LAS bf16x8*)(Kst + qc * KROW + (16 * ks + 8 * hh) * 2);     \
                            sc = __builtin_amdgcn_mfma_f32_32x32x16_bf16(ka, qf[ks], sc, 0, 0, 0); } \
                        const bool edge = ((c_) == 0) | ((c_) == 4) | (k0 < kkmin);     \
                        float cmax = -INFINITY; \
                        _Pragma("unroll") for (int r = 0; r < 16; ++r) { float v = sc[r] * C2; \
                            if (edge) { const int kk = k0 + (r & 3) + 8 * (r >> 2) + 4 * hh; const bool ok = (kk >= qc) & (kk <= qc + 128) & (kk >= kkmin); v = ok ? v : -INFINITY; } \
                            sc[r] = v; cmax = fmaxf(cmax, v); } \
                        cmax = max_x32(cmax); \
                        const float mn = fmaxf(m, cmax);                    \
                        const float alpha = __builtin_amdgcn_exp2f(m - mn); \
                        float ps = 0.f; \
                        _Pragma("unroll") for (int r = 0; r < 16; ++r) { sc[r] = __builtin_amdgcn_exp2f(sc[r] - mn); ps += sc[r]; } \
                        l = l * alpha + ps; m = mn; \
                        bf16x8 pf[2];                                       \
                        _Pragma("unroll") for (int sx = 0; sx < 2; ++sx) { v4u w; w.x = cvtpk(sc[8 * sx], sc[8 * sx + 1]); w.y = cvtpk(sc[8 * sx + 2], sc[8 * sx + 3]); w.z = cvtpk(sc[8 * sx + 4], sc[8 * sx + 5]); w.w = cvtpk(sc[8 * sx + 6], sc[8 * sx + 7]); pf[sx] = __builtin_bit_cast(bf16x8, w); } \
                        _Pragma("unroll") for (int r = 0; r < 16; ++r) { O0[r] *= alpha; O1[r] *= alpha; } \
                        _Pragma("unroll") for (int sx = 0; sx < 2; ++sx) { \
                            const int vrow = 16 * sx + 4 * hh + ((lane & 15) >> 2), vcol = 16 * ((lane >> 4) & 1) + 4 * (lane & 3); \
                            const s16x4 a0 = __builtin_amdgcn_ds_read_tr16_b64_v4i16((LAS s16x4*)(Vst + vrow * KROW + vcol * 2)); \
                            const s16x4 a1 = __builtin_amdgcn_ds_read_tr16_b64_v4i16((LAS s16x4*)(Vst + (vrow + 8) * KROW + vcol * 2)); \
                            const s16x4 c0 = __builtin_amdgcn_ds_read_tr16_b64_v4i16((LAS s16x4*)(Vst + vrow * KROW + (32 + vcol) * 2)); \
                            const s16x4 c1 = __builtin_amdgcn_ds_read_tr16_b64_v4i16((LAS s16x4*)(Vst + (vrow + 8) * KROW + (32 + vcol) * 2)); \
                            bf16x8 va, vc; va[0] = a0[0]; va[1] = a0[1]; va[2] = a0[2]; va[3] = a0[3]; va[4] = a1[0]; va[5] = a1[1]; va[6] = a1[2]; va[7] = a1[3]; \
                            vc[0] = c0[0]; vc[1] = c0[1]; vc[2] = c0[2]; vc[3] = c0[3]; vc[4] = c1[0]; vc[5] = c1[1]; vc[6] = c1[2]; vc[7] = c1[3]; \
                            O0 = __builtin_amdgcn_mfma_f32_32x32x16_bf16(va, pf[sx], O0, 0, 0, 0); \
                            O1 = __builtin_amdgcn_mfma_f32_32x32x16_bf16(vc, pf[sx], O1, 0, 0, 0); } \
                        LDS_WAIT(); asm volatile("" ::: "memory");         \
                    } while (0)
                    DSW_LOAD(kA, vA, 4);
                    if (3 >= cmin) DSW_LOAD(kB, vB, 3);
                    DSW_STEP(kA, vA, 4);
                    if (3 >= cmin) {
                        if (2 >= cmin) DSW_LOAD(kA, vA, 2);
                        DSW_STEP(kB, vB, 3);
                        if (2 >= cmin) {
                            if (1 >= cmin) DSW_LOAD(kB, vB, 1);
                            DSW_STEP(kA, vA, 2);
                            if (1 >= cmin) {
                                if (0 >= cmin) DSW_LOAD(kA, vA, 0);
                                DSW_STEP(kB, vB, 1);
                                if (0 >= cmin) DSW_STEP(kA, vA, 0);
                            }
                        }
                    }
#undef DSW_LOAD
#undef DSW_STEP
                    l = add_x32(l);
                    const int row = (tq0 - s0) + (qc << dl);
                    LAS unsigned char* orow = Ob + row * OROW;
                    if (pt > 0) {
                        const float m1 = *(const LAS float*)(orow + 128), l1 = *(const LAS float*)(orow + 132);
                        const float mn = fmaxf(m, m1), a0 = __builtin_amdgcn_exp2f(m - mn), a1 = __builtin_amdgcn_exp2f(m1 - mn);
#pragma unroll
                        for (int rq = 0; rq < 4; ++rq) {
                            const unsigned long long w0 = *(const LAS unsigned long long*)(orow + (8 * rq + 4 * hh) * 2), w1 = *(const LAS unsigned long long*)(orow + (32 + 8 * rq + 4 * hh) * 2);
                            O0[4 * rq] = O0[4 * rq] * a0 + bflo((unsigned)w0) * a1; O0[4 * rq + 1] = O0[4 * rq + 1] * a0 + bfhi((unsigned)w0) * a1;
                            O0[4 * rq + 2] = O0[4 * rq + 2] * a0 + bflo((unsigned)(w0 >> 32)) * a1; O0[4 * rq + 3] = O0[4 * rq + 3] * a0 + bfhi((unsigned)(w0 >> 32)) * a1;
                            O1[4 * rq] = O1[4 * rq] * a0 + bflo((unsigned)w1) * a1; O1[4 * rq + 1] = O1[4 * rq + 1] * a0 + bfhi((unsigned)w1) * a1;
                            O1[4 * rq + 2] = O1[4 * rq + 2] * a0 + bflo((unsigned)(w1 >> 32)) * a1; O1[4 * rq + 3] = O1[4 * rq + 3] * a0 + bfhi((unsigned)(w1 >> 32)) * a1;
                        }
                        l = l * a0 + l1 * a1; m = mn;
                    }
                    if (pt < 2) {
#pragma unroll
                        for (int rq = 0; rq < 4; ++rq) {
                            *(LAS unsigned long long*)(orow + (8 * rq + 4 * hh) * 2) = (unsigned long long)cvtpk(O0[4 * rq], O0[4 * rq + 1]) | ((unsigned long long)cvtpk(O0[4 * rq + 2], O0[4 * rq + 3]) << 32);
                            *(LAS unsigned long long*)(orow + (32 + 8 * rq + 4 * hh) * 2) = (unsigned long long)cvtpk(O1[4 * rq], O1[4 * rq + 1]) | ((unsigned long long)cvtpk(O1[4 * rq + 2], O1[4 * rq + 3]) << 32);
                        }
                        if (hh == 0) { *(LAS float*)(orow + 128) = m; *(LAS float*)(orow + 132) = l; }
                    } else {
                        const float rl = 1.f / l;
                        bf16* op = mix + (size_t)(b * SEQ + s0 + row) * D + 512 + h * 64;
#pragma unroll
                        for (int rq = 0; rq < 4; ++rq) {
                            *(GAS unsigned long long*)(op + 8 * rq + 4 * hh) = (unsigned long long)cvtpk(O0[4 * rq] * rl, O0[4 * rq + 1] * rl) | ((unsigned long long)cvtpk(O0[4 * rq + 2] * rl, O0[4 * rq + 3] * rl) << 32);
                            *(GAS unsigned long long*)(op + 32 + 8 * rq + 4 * hh) = (unsigned long long)cvtpk(O1[4 * rq] * rl, O1[4 * rq + 1] * rl) | ((unsigned long long)cvtpk(O1[4 * rq + 2] * rl, O1[4 * rq + 3] * rl) << 32);
                        }
                    }
                }
                LDS_WAIT(); __syncthreads();
            }
        }
    }
    }
    { LANE_DECL; xcd_barrier(bar, wave == 0 && lane == 0); }

    for (int rep_ = 0; rep_ < REP_P3; ++rep_) {
        pg8::Gemm g{mix, Bt_out, T, D, D}; pg8::StaticOrder S; S.init(T, D, G, bx);
        pg8::EpiOutProj E{xin, x1b, ssq1};
        pg8::gemm_phase<pg8::EpiOutProj, pg8::StaticOrder, true, true>(L + RING_OFF, g, S, E, wave);
    }
    { LANE_DECL; xcd_barrier(bar, wave == 0 && lane == 0); }

    for (int rep_ = 0; rep_ < REP_P4; ++rep_) {
        pg8::Gemm g{x1b, Bt_pq, T, 2048, D}; pg8::StaticOrder S; S.init(T, 2048, G, bx);
        pg8::EpiPeerQ E{qr, ssq1};
        pg8::gemm_phase<pg8::EpiPeerQ, pg8::StaticOrder, true, true>(L + RING_OFF, g, S, E, wave);
    }
    { LANE_DECL; xcd_barrier(bar, wave == 0 && lane == 0); }

    for (int rep_ = 0; rep_ < REP_P5; ++rep_) {
        LANE_DECL;
        const int fr = lane & 15, g = lane >> 4;
        constexpr int KROW = 272;
        const int h = bx & 7, nbh = G >> 3;
        {
            const GAS v4u* src = (const GAS v4u*)(keysb + (size_t)h * 2 * 128 * 128);
            for (int pc = wave * 64 + lane; pc < 4096; pc += NWAVES * 64) { const int R = pc >> 4, ch = pc & 15; *(LAS v4u*)(L + RING_OFF + R * KROW + ch * 16) = src[pc]; }
        }
        LAS int* const scr = (LAS int*)(L + RING_OFF + 256 * KROW + wave * (16 * 33 * 4));
        __syncthreads();
        for (int tg = (bx >> 3) * NWAVES + wave; tg < T / 16; tg += nbh * NWAVES) {
            const int tok0 = tg * 16;
            int top[2][16];
#pragma unroll
            for (int c = 0; c < 2; ++c) {
                bf16x8 bq[4];
#pragma unroll
                for (int ks = 0; ks < 4; ++ks) bq[ks] = *(const GAS bf16x8*)(qr + (size_t)(tok0 + fr) * 2048 + h * 256 + c * 128 + 32 * ks + 8 * g);
                int v[32];
#pragma unroll
                for (int tl = 0; tl < 8; ++tl) {
                    f32x4 acc = {0.f, 0.f, 0.f, 0.f};
#pragma unroll
                    for (int ks = 0; ks < 4; ++ks) { const bf16x8 a = *(const LAS bf16x8*)(L + RING_OFF + (c * 128 + 16 * tl + fr) * KROW + (32 * ks + 8 * g) * 2);
                        acc = __builtin_amdgcn_mfma_f32_16x16x32_bf16(a, bq[ks], acc, 0, 0, 0); }
#pragma unroll
                    for (int r = 0; r < 4; ++r) v[4 * tl + r] = (f2key(acc[r]) & ~0x7f) | (16 * tl + 4 * g + r);
                }
                bitonic_sort_desc<32>(v);
#pragma unroll
                for (int i = 0; i < 16; ++i) top[c][i] = v[i];
                merge_top16(top[c], lane ^ 16);
                merge_top16(top[c], lane ^ 32);
            }
            float fa[16], fb[16];
#pragma unroll
            for (int i = 0; i < 16; ++i) { fa[i] = key2f(top[0][i]); fb[i] = key2f(top[1][i]); }
            int cand[16];
#pragma unroll
            for (int sl = 0; sl < 16; ++sl) {
                int cv[4];
#pragma unroll
                for (int gg = 0; gg < 4; ++gg) { constexpr int NEG = (int)0x80000000;
                    const int n = 16 * gg + sl;
                    if (kCand.i[n] >= 0) cv[gg] = (f2key(fa[kCand.i[n] < 0 ? 0 : kCand.i[n]] + fb[kCand.j[n] < 0 ? 0 : kCand.j[n]]) & ~0xff) | (kCand.i[n] * 16 + kCand.j[n]); else cv[gg] = NEG; }
                cand[sl] = (g == 0) ? cv[0] : ((g == 1) ? cv[1] : ((g == 2) ? cv[2] : cv[3]));
            }
            bitonic_sort_desc<16>(cand);
            merge_top16(cand, lane ^ 16);
            merge_top16(cand, lane ^ 32);
#pragma unroll
            for (int i = 0; i < 16; ++i) { if (g == (i >> 3)) scr[fr * 33 + i] = top[0][i] & 0x7f; if (g == 2 + (i >> 3)) scr[fr * 33 + 16 + i] = top[1][i] & 0x7f; }
            float ex[16]; float den = 0.f; const float m0 = key2f(cand[0]);
#pragma unroll
            for (int r = 0; r < 16; ++r) { ex[r] = __expf(key2f(cand[r]) - m0); den += ex[r]; }
            const float rden = 1.f / den;
            LDS_WAIT(); asm volatile("" ::: "memory");
            int oi[4]; float og[4];
#pragma unroll
            for (int q = 0; q < 4; ++q) {
                const int kq = (g == 0) ? cand[q] : ((g == 1) ? cand[4 + q] : ((g == 2) ? cand[8 + q] : cand[12 + q]));
                const float eq = (g == 0) ? ex[q] : ((g == 1) ? ex[4 + q] : ((g == 2) ? ex[8 + q] : ex[12 + q]));
                const int code = kq & 0xff;
                oi[q] = scr[fr * 33 + (code >> 4)] * 128 + scr[fr * 33 + 16 + (code & 15)]; og[q] = eq * rden;
            }
            GAS v4u* op = (GAS v4u*)(sel2 + (size_t)(tok0 + fr) * 128 + h * 16 + 4 * g);
            v4u o0, o1; o0.x = (unsigned)oi[0]; o0.y = __float_as_uint(og[0]); o0.z = (unsigned)oi[1]; o0.w = __float_as_uint(og[1]);
            o1.x = (unsigned)oi[2]; o1.y = __float_as_uint(og[2]); o1.z = (unsigned)oi[3]; o1.w = __float_as_uint(og[3]);
            op[0] = o0; op[1] = o1;
            LDS_WAIT(); asm volatile("" ::: "memory");
        }
        __syncthreads();
    }
    { LANE_DECL; xcd_barrier(bar, wave == 0 && lane == 0); }

    for (int rep_ = 0; rep_ < REP_P6; ++rep_) {
        LANE_DECL;
        const int g4 = lane >> 4, li = lane & 15;
        LAS i32x2* const selw = (LAS i32x2*)(L + RING_OFF + wave * 1024);
        for (int tok = gw; tok < T; tok += NGW) {
            const float s1 = (lane < 16) ? ssq1[(size_t)lane * T + tok] : 0.f;
            const float rstd1 = rsqrtf(wave_sum(s1) * (1.f / D) + EPS);
            v4u xw[8];
#pragma unroll
            for (int j = 0; j < 4; ++j) { xw[2 * j] = ((const GAS v4u*)(x1b + (size_t)tok * D))[32 * j + 2 * li]; xw[2 * j + 1] = ((const GAS v4u*)(x1b + (size_t)tok * D))[32 * j + 2 * li + 1]; }
            float acc[64];
#pragma unroll
            for (int k = 0; k < 64; ++k) acc[k] = 0.f;
            {
                const GAS i32x2* selg = (const GAS i32x2*)sel2 + (size_t)tok * 128;
                const i32x2 p0 = selg[lane], p1 = selg[lane + 64];
                const int b0 = p0.x >> 11, b1 = p1.x >> 11;
                const unsigned long long lt = (1ull << lane) - 1ull;
                int base = 0, r0 = 0, r1 = 0;
#pragma unroll
                for (int bk = 0; bk < 8; ++bk) {
                    const unsigned long long m0 = __ballot(b0 == bk), m1 = __ballot(b1 == bk);
                    const int c0 = __popcll(m0), c1 = __popcll(m1);
                    if (b0 == bk) r0 = base + __popcll(m0 & lt);
                    if (b1 == bk) r1 = base + c0 + __popcll(m1 & lt);
                    base += c0 + c1;
                }
                selw[r0] = p0; selw[r1] = p1;
                LDS_WAIT(); asm volatile("" ::: "memory");
            }
            const float ascale = rstd1 * (1.f / 64.f);
            i32x2 cur = selw[g4];
            for (int it = 0; it < 32; ++it) {
                const i32x2 nxt = selw[((it < 31) ? 4 * (it + 1) : 0) + g4];
                const GAS v4u* up = (const GAS v4u*)(Ub + (size_t)cur.x * 768) + li;
                const GAS v4u* vp = (const GAS v4u*)(Vb + (size_t)cur.x * 512) + li;
                const v4u u0 = up[0], u1 = up[16], u2 = up[32], v0 = vp[0], v1 = vp[16];
                float s = 0.f;
                { const u32x6 ga = {u0.x, u0.y, u0.z, u0.w, u1.x, u1.y};
                  const u32x16 d = __builtin_bit_cast(u32x16, __builtin_amdgcn_cvt_scalef32_pk32_bf16_fp6(ga, 1.0f));
#pragma unroll
                  for (int k = 0; k < 16; ++k) s = dot2bf(xw[k >> 2][k & 3], d[k], s); }
                { const u32x6 gb = {u1.z, u1.w, u2.x, u2.y, u2.z, u2.w};
                  const u32x16 d = __builtin_bit_cast(u32x16, __builtin_amdgcn_cvt_scalef32_pk32_bf16_fp6(gb, 1.0f));
#pragma unroll
                  for (int k = 0; k < 16; ++k) s = dot2bf(xw[4 + (k >> 2)][k & 3], d[k], s); }
                s = row_sum16(s);
                const float a = s * ascale;
                const float act = 0.5f * a * (1.f + erff(a * 0.70710678118654752f)) * __int_as_float(cur.y) * 0.25f;
#define PG_V4(bsel) { const f32x2 fa = __builtin_amdgcn_cvt_scalef32_pk_f32_fp4(v0[w], 1.0f, bsel), fb = __builtin_amdgcn_cvt_scalef32_pk_f32_fp4(v1[w], 1.0f, bsel); \
                        acc[8 * w + 2 * bsel] += act * fa.x; acc[8 * w + 2 * bsel + 1] += act * fa.y; acc[32 + 8 * w + 2 * bsel] += act * fb.x; acc[32 + 8 * w + 2 * bsel + 1] += act * fb.y; }
#pragma unroll
                for (int w = 0; w < 4; ++w) { PG_V4(0) PG_V4(1) PG_V4(2) PG_V4(3) }
#undef PG_V4
                cur = nxt;
            }
            float s2 = 0.f;
#pragma unroll
            for (int j = 0; j < 4; ++j) {
                float r[16];
#pragma unroll
                for (int e = 0; e < 16; ++e) { float v = acc[16 * j + e]; v += xshfl(v, lane ^ 16); v += xshfl(v, lane ^ 32);
                    const unsigned xwd = xw[2 * j + (e >> 3)][(e >> 1) & 3]; r[e] = v + ((e & 1) ? bfhi(xwd) : bflo(xwd)); s2 += r[e] * r[e]; }
                if (g4 == j) { v4u o0, o1; o0.x = pk2(r[0], r[1]); o0.y = pk2(r[2], r[3]); o0.z = pk2(r[4], r[5]); o0.w = pk2(r[6], r[7]); o1.x = pk2(r[8], r[9]); o1.y = pk2(r[10], r[11]); o1.z = pk2(r[12], r[13]); o1.w = pk2(r[14], r[15]);
                    ((GAS v4u*)(x2b + (size_t)tok * D))[32 * j + 2 * li] = o0; ((GAS v4u*)(x2b + (size_t)tok * D))[32 * j + 2 * li + 1] = o1; }
            }
            s2 = row_sum16(s2);
            if (lane == 0) rstd2[tok] = rsqrtf(s2 * (1.f / D) + EPS);
            LDS_WAIT(); asm volatile("" ::: "memory");
        }
    }
    { LANE_DECL; xcd_barrier(bar, wave == 0 && lane == 0); }

    for (int rep_ = 0; rep_ < REP_P7; ++rep_) {
        pg8::Gemm g{x2b, Bt_pg, T, D, D}; pg8::StaticOrder S; S.init(T, D, G, bx);
        pg8::EpiPle E{x2b, pproj, rstd2, x1b};
        pg8::gemm_phase<pg8::EpiPle, pg8::StaticOrder, true, true>(L + RING_OFF, g, S, E, wave);
    }
    { LANE_DECL; xcd_barrier(bar, wave == 0 && lane == 0); }

    {
    LANE_DECL;
    for (int row = gw; row < T; row += NGW) {
        const GAS v4u* xr = (const GAS v4u*)(x1b + (size_t)row * D);
        const v4u a = xr[lane], c = xr[64 + lane];
        float v[16];
        v[0] = bflo(a.x); v[1] = bfhi(a.x); v[2] = bflo(a.y); v[3] = bfhi(a.y); v[4] = bflo(a.z); v[5] = bfhi(a.z); v[6] = bflo(a.w); v[7] = bfhi(a.w);
        v[8] = bflo(c.x); v[9] = bfhi(c.x); v[10] = bflo(c.y); v[11] = bfhi(c.y); v[12] = bflo(c.z); v[13] = bfhi(c.z); v[14] = bflo(c.w); v[15] = bfhi(c.w);
        float s = 0.f;
#pragma unroll
        for (int k = 0; k < 16; ++k) s += v[k] * v[k];
        const float rstd = rsqrtf(wave_sum(s) * (1.f / D) + EPS);
        GAS f32x4* orow = (GAS f32x4*)(out + (size_t)row * D);
#pragma unroll
        for (int q = 0; q < 4; ++q) {
            const int e0 = (q < 2) ? (8 * lane + 4 * q) : (512 + 8 * lane + 4 * (q - 2));
            const f32x4 gg = *(const GAS f32x4*)(g_final + e0);
            f32x4 o; o.x = v[4 * q] * rstd * gg.x; o.y = v[4 * q + 1] * rstd * gg.y; o.z = v[4 * q + 2] * rstd * gg.z; o.w = v[4 * q + 3] * rstd * gg.w;
            orow[e0 >> 2] = o;
        }
    }
    }
}

#undef xin
#undef p_in
#undef positions
#undef g_mix
#undef w_in
#undef w_up
#undef b_gate
#undef g_gla
#undef w_out
#undef g_peer
#undef w_pq
#undef skeys
#undef pu
#undef pv
#undef g_ple
#undef w_pg
#undef w_pp
#undef g_final
#undef out
#undef Bt_in
#undef Bt_out
#undef Bt_pq
#undef Bt_pg
#undef Bt_pp
#undef rope
#undef ssq1
#undef rstd2
#undef h1
#undef x1b
#undef proj
#undef qr
#undef sel2
#undef Ub
#undef Vb
#undef keysb
#undef mix
#undef pb
#undef pproj
#undef x2b
extern "C" void kernel_launch(void* const* d_in, const int* in_sizes, int n_in, void* d_out, int out_size, void* d_ws, size_t ws_size, hipStream_t stream) {
    static int grid = 0;
    if (grid == 0) {
        if (n_in != 18 || out_size != T * D || ws_size < WS_END) { fprintf(stderr, "kernel_launch: unexpected shapes n_in %d out %d ws %zu\n", n_in, out_size, ws_size); grid = -1; return; }
        int dev = 0, cus = 0, per_cu = 0;
        if (hipGetDevice(&dev) != hipSuccess || hipDeviceGetAttribute(&cus, hipDeviceAttributeMultiprocessorCount, dev) != hipSuccess) { grid = -1; return; }
        if (hipFuncSetAttribute((const void*)mk_fwd, hipFuncAttributeMaxDynamicSharedMemorySize, LDS_BYTES) != hipSuccess) { fprintf(stderr, "kernel_launch: hipFuncSetAttribute failed\n"); grid = -1; return; }
        if (hipOccupancyMaxActiveBlocksPerMultiprocessor(&per_cu, (const void*)mk_fwd, NWAVES * 64, LDS_BYTES) != hipSuccess || per_cu < 1) fprintf(stderr, "kernel_launch: occupancy query reports %d\n", per_cu);
        (void)hipGetLastError();
        grid = cus;
    }
    if (grid < 0) return;
    if (hipMemsetAsync((char*)d_ws + WS_CTL, 0, CTL_ZERO_BYTES, stream) != hipSuccess) return;
    Args a{};
    for (int i = 0; i < 18; ++i) a.in[i] = (const float*)d_in[i];
    a.outp = (float*)d_out; a.ws = (unsigned char*)d_ws;
    hipLaunchKernelGGL(mk_fwd, dim3(grid), dim3(NWAVES * 64), LDS_BYTES, stream, a);
}
```

```cpp
#include <hip/hip_runtime.h>
#include <cstdio>
#include <cstdint>
namespace pg8 {
#define PG8_LAS __attribute__((address_space(3)))
typedef unsigned short bf16_t;
typedef short bf16x8 __attribute__((ext_vector_type(8)));
typedef float f32x4 __attribute__((ext_vector_type(4)));
typedef unsigned u32x4 __attribute__((ext_vector_type(4)));
constexpr int BM = 256, BK = 64, HALF = 128, HTB = HALF * BK * 2  , STAGE_BYTES = 8 * HTB, NXCD = 8, WGM = 8;

__host__ __device__ __forceinline__ int lds_byte(int r, int c) { const int st = (r >> 4) * 2 + (c >> 5), rr = r & 15, cc = c & 31, ob = rr * 64 + cc * 2; return st * 1024 + (ob ^ (((ob >> 9) & 1) << 5)); }
__host__ __device__ __forceinline__ void stage_rc(int b, int& R, int& C) { const int st = b / 1024, sb = b % 1024, swz = sb ^ (((sb >> 9) & 1) << 5); R = (st >> 1) * 16 + swz / 64; C = (st & 1) * 32 + (swz % 64) / 2; }
__host__ __device__ __forceinline__ int perm32(int rho) { const int n = rho >> 4, i = rho & 15; return 8 * (i >> 2) + 4 * n + (i & 3); }

struct Unit { int pm, pn; };
struct Gemm { const bf16_t* A; const bf16_t* Bt; int M, N, K; };

struct StaticOrder {
    int nM, nN, nwg, G, c;
    __host__ __device__ void init(int M, int N, int G_, int c_) { nM = M / BM; nN = N / BM; nwg = nM * nN; G = G_; c = c_; }
    __host__ __device__ bool next(int i, Unit& u) const {
        const long L = (long)i * G + c; if (L >= nwg) return false;
        int wgid = (int)L; { const int q = nwg / NXCD, r = nwg % NXCD, xcd = wgid % NXCD, off = wgid / NXCD; wgid = (xcd < r ? xcd * (q + 1) : r * (q + 1) + (xcd - r) * q) + off; }
        const int nig = WGM * nN, gid = wgid / nig, fm = gid * WGM, gsz = (nM - fm) < WGM ? (nM - fm) : WGM;
        u.pm = fm + ((wgid % nig) % gsz); u.pn = (wgid % nig) / gsz; return true;
    }
    __device__ __forceinline__ void a_ready(const Unit&) const {}
    __device__ __forceinline__ void done(const Unit&) const {}
};

__device__ __forceinline__ unsigned cvt_pk_bf16(float lo, float hi) { unsigned r; asm volatile("v_cvt_pk_bf16_f32 %0, %1, %2" : "=v"(r) : "v"(lo), "v"(hi)); return r; }
typedef float f32x2 __attribute__((ext_vector_type(2)));
__device__ __forceinline__ f32x2 gelu_pk(f32x2 v) {
    const f32x2 av = __builtin_elementwise_abs(v), d = av * 0.2316418882f + 1.0f;
    f32x2 t; t.x = __builtin_amdgcn_rcpf(d.x); t.y = __builtin_amdgcn_rcpf(d.y);
    f32x2 q = t * 0.5307027145f + (-0.7265760135f); q = q * t + 0.7107068705f; q = q * t + (-0.142248368f); q = q * t + 0.127414796f; q = q * t;
    const f32x2 s = (v * v) * (-0.72134752044f);
    f32x2 e; e.x = __builtin_amdgcn_exp2f(s.x); e.y = __builtin_amdgcn_exp2f(s.y);
    const f32x2 m = v * (q * e), r = v - m;
    f32x2 o; o.x = v.x < 0.f ? m.x : r.x; o.y = v.y < 0.f ? m.y : r.y; return o;
}

template <int ACT  > struct EpiBf16 {
    static constexpr bool PERM = true, AFTER_DRAIN = false; static_assert(ACT == 0 || ACT == 1, "EpiBf16: ACT is 0 (none) or 1 (gelu_pk)");
    bf16_t* O; int ldc; const float* bias; int split_cols; size_t split_stride; float scale0;
    __device__ __forceinline__ void operator()(const f32x4 (&acc)[2][2][4][2], const Unit& u, int wr, int wc, int fr, int fq) const {
        const int row0 = u.pm * BM + wr * 64 + fr; int colt = u.pn * BM; bf16_t* base = O;
        float sc = 1.f; if (split_cols) { const int t = colt / split_cols; base += (size_t)t * split_stride; colt -= t * split_cols; if (t == 0) sc = scale0; }
        const int col0 = colt + wc * 32 + 8 * fq, bcol0 = u.pn * BM + wc * 32 + 8 * fq;
        f32x4 bv[2][2];
#pragma unroll
        for (int bj = 0; bj < 2; ++bj)
#pragma unroll
            for (int n = 0; n < 2; ++n) bv[bj][n] = bias ? *(const f32x4*)(bias + bcol0 + bj * HALF + 4 * n) : (f32x4){0.f, 0.f, 0.f, 0.f};
#pragma unroll
        for (int ai = 0; ai < 2; ++ai)
#pragma unroll
            for (int m = 0; m < 4; ++m) { bf16_t* rowp = base + (size_t)(row0 + ai * HALF + m * 16) * ldc + col0;
#pragma unroll
                for (int bj = 0; bj < 2; ++bj) { f32x4 v0 = acc[ai][bj][m][0] + bv[bj][0], v1 = acc[ai][bj][m][1] + bv[bj][1];
                    if (ACT == 1) { f32x2 a = gelu_pk((f32x2){v0[0], v0[1]}), b = gelu_pk((f32x2){v0[2], v0[3]}), c = gelu_pk((f32x2){v1[0], v1[1]}), d = gelu_pk((f32x2){v1[2], v1[3]});
                        v0 = (f32x4){a.x, a.y, b.x, b.y}; v1 = (f32x4){c.x, c.y, d.x, d.y}; }
                    v0 = v0 * sc; v1 = v1 * sc; u32x4 w; w.x = cvt_pk_bf16(v0[0], v0[1]); w.y = cvt_pk_bf16(v0[2], v0[3]); w.z = cvt_pk_bf16(v1[0], v1[1]); w.w = cvt_pk_bf16(v1[2], v1[3]);
                    *(u32x4*)(rowp + bj * HALF) = w; } }
    }
};

__device__ __forceinline__ float xshfl(float v, int srclane) { return __int_as_float(__builtin_amdgcn_ds_bpermute(srclane << 2, __float_as_int(v))); }
constexpr int P_INC = 3328;
struct EpiInProj {
    static constexpr bool PERM = true, AFTER_DRAIN = false;
    bf16_t* O; const float* rope; const float* bgate;
    __device__ __forceinline__ void operator()(const f32x4 (&acc)[2][2][4][2], const Unit& u, int wr, int wc, int fr, int fq) const {
        const int row0 = u.pm * BM + wr * 64 + fr;
#pragma unroll
        for (int bj = 0; bj < 2; ++bj) {
            const int cb = u.pn * BM + bj * HALF + wc * 32;
            const int c0 = cb + 8 * fq;
            const bool ropechunk = (cb >= 1792) && (cb < 2816) && ((cb & 63) == 0);
            const bool lachunk = (cb >= 1536) && (cb < 1792);
            f32x4 bg0 = {0.f, 0.f, 0.f, 0.f}, bg1 = {0.f, 0.f, 0.f, 0.f};
            if (lachunk) { bg0 = *(const f32x4*)(bgate + c0 - 1536); bg1 = *(const f32x4*)(bgate + c0 - 1536 + 4); }
#pragma unroll
            for (int ai = 0; ai < 2; ++ai)
#pragma unroll
                for (int m = 0; m < 4; ++m) {
                    const int row = row0 + ai * HALF + m * 16;
                    f32x4 v0 = acc[ai][bj][m][0], v1 = acc[ai][bj][m][1];
                    if (lachunk) {
#pragma unroll
                        for (int e = 0; e < 4; ++e) { const float z0 = v0[e] + bg0[e], z1 = v1[e] + bg1[e];
                            v0[e] = (fminf(z0, 0.f) - __logf(1.f + __expf(-fabsf(z0)))) * (1.f / 16.f); v1[e] = (fminf(z1, 0.f) - __logf(1.f + __expf(-fabsf(z1)))) * (1.f / 16.f); }
                    }
                    if (ropechunk) {
                        f32x4 p0, p1;
#pragma unroll
                        for (int e = 0; e < 4; ++e) { p0[e] = xshfl(v0[e], (fq * 16 + fr) ^ 16); p1[e] = xshfl(v1[e], (fq * 16 + fr) ^ 16); }
                        if (fq < 2) {
                            const f32x4* cs = (const f32x4*)(rope + (size_t)row * 16);
                            const f32x4 t0 = cs[0], t1 = cs[1], t2 = cs[2], t3 = cs[3];
                            const float sg = (fq == 0) ? -1.f : 1.f;
                            v0[0] = v0[0] * t0[0] + sg * p0[0] * t0[1]; v0[1] = v0[1] * t0[2] + sg * p0[1] * t0[3];
                            v0[2] = v0[2] * t1[0] + sg * p0[2] * t1[1]; v0[3] = v0[3] * t1[2] + sg * p0[3] * t1[3];
                            v1[0] = v1[0] * t2[0] + sg * p1[0] * t2[1]; v1[1] = v1[1] * t2[2] + sg * p1[1] * t2[3];
                            v1[2] = v1[2] * t3[0] + sg * p1[2] * t3[1]; v1[3] = v1[3] * t3[2] + sg * p1[3] * t3[3];
                        }
                    }
                    { u32x4 w; w.x = cvt_pk_bf16(v0[0], v0[1]); w.y = cvt_pk_bf16(v0[2], v0[3]); w.z = cvt_pk_bf16(v1[0], v1[1]); w.w = cvt_pk_bf16(v1[2], v1[3]);
                        *(u32x4*)(O + (size_t)row * P_INC + c0) = w; }
                }
        }
    }
};
struct EpiOutProj {
    static constexpr bool PERM = true, AFTER_DRAIN = false;
    const float* X; bf16_t* O; float* ssq;
    __device__ __forceinline__ void operator()(const f32x4 (&acc)[2][2][4][2], const Unit& u, int wr, int wc, int fr, int fq) const {
        const int row0 = u.pm * BM + wr * 64 + fr, col0 = u.pn * BM + wc * 32 + 8 * fq;
#pragma unroll
        for (int ai = 0; ai < 2; ++ai)
#pragma unroll
            for (int m = 0; m < 4; ++m) {
                const int row = row0 + ai * HALF + m * 16; float s = 0.f;
#pragma unroll
                for (int bj = 0; bj < 2; ++bj) {
                    const float* xp = X + (size_t)row * 1024 + col0 + bj * HALF;
                    const f32x4 x0 = *(const f32x4*)xp, x1 = *(const f32x4*)(xp + 4);
                    const f32x4 v0 = acc[ai][bj][m][0] + x0, v1 = acc[ai][bj][m][1] + x1;
                    s += (v0[0] * v0[0] + v0[1] * v0[1]) + (v0[2] * v0[2] + v0[3] * v0[3]) + (v1[0] * v1[0] + v1[1] * v1[1]) + (v1[2] * v1[2] + v1[3] * v1[3]);
                    u32x4 w; w.x = cvt_pk_bf16(v0[0], v0[1]); w.y = cvt_pk_bf16(v0[2], v0[3]); w.z = cvt_pk_bf16(v1[0], v1[1]); w.w = cvt_pk_bf16(v1[2], v1[3]);
                    *(u32x4*)(O + (size_t)row * 1024 + col0 + bj * HALF) = w;
                }
                s += xshfl(s, (fq * 16 + fr) ^ 16); s += xshfl(s, (fq * 16 + fr) ^ 32);
                if (fq == 0) ssq[(size_t)(u.pn * 4 + wc) * 32768 + row] = s;
            }
    }
};
struct EpiPeerQ {
    static constexpr bool PERM = true, AFTER_DRAIN = false;
    bf16_t* O; const float* ssq;
    __device__ __forceinline__ void operator()(const f32x4 (&acc)[2][2][4][2], const Unit& u, int wr, int wc, int fr, int fq) const {
        const int row0 = u.pm * BM + wr * 64 + fr, col0 = u.pn * BM + wc * 32 + 8 * fq;
#pragma unroll
        for (int ai = 0; ai < 2; ++ai)
#pragma unroll
            for (int m = 0; m < 4; ++m) {
                const int row = row0 + ai * HALF + m * 16;
                float s = 0.f;
#pragma unroll
                for (int q = 0; q < 4; ++q) s += ssq[(size_t)(4 * fq + q) * 32768 + row];
                s += xshfl(s, (fq * 16 + fr) ^ 16); s += xshfl(s, (fq * 16 + fr) ^ 32);
                const float rstd = rsqrtf(s * (1.f / 1024.f) + 1e-6f);
#pragma unroll
                for (int bj = 0; bj < 2; ++bj) {
                    const f32x4 v0 = acc[ai][bj][m][0] * rstd, v1 = acc[ai][bj][m][1] * rstd;
                    u32x4 w; w.x = cvt_pk_bf16(v0[0], v0[1]); w.y = cvt_pk_bf16(v0[2], v0[3]); w.z = cvt_pk_bf16(v1[0], v1[1]); w.w = cvt_pk_bf16(v1[2], v1[3]);
                    *(u32x4*)(O + (size_t)row * 2048 + col0 + bj * HALF) = w;
                }
            }
    }
};
struct EpiPle {
    static constexpr bool PERM = true, AFTER_DRAIN = false;
    const bf16_t* X2; const bf16_t* PP; const float* rstd2; bf16_t* O;
    __device__ __forceinline__ void operator()(const f32x4 (&acc)[2][2][4][2], const Unit& u, int wr, int wc, int fr, int fq) const {
        const int row0 = u.pm * BM + wr * 64 + fr, col0 = u.pn * BM + wc * 32 + 8 * fq;
#pragma unroll
        for (int ai = 0; ai < 2; ++ai)
#pragma unroll
            for (int m = 0; m < 4; ++m) {
                const int row = row0 + ai * HALF + m * 16;
                const float rstd = rstd2[row];
#pragma unroll
                for (int bj = 0; bj < 2; ++bj) {
                    const size_t off = (size_t)row * 1024 + col0 + bj * HALF;
                    const u32x4 xw = *(const u32x4*)(X2 + off), pw = *(const u32x4*)(PP + off);
                    f32x4 o0, o1;
#pragma unroll
                    for (int e = 0; e < 4; ++e) {
                        const unsigned xe = (e < 2) ? ((e == 0) ? xw.x : xw.y) : ((e == 2) ? xw.z : xw.w);
                        const unsigned pe = (e < 2) ? ((e == 0) ? pw.x : pw.y) : ((e == 2) ? pw.z : pw.w);
                        const float xlo = __uint_as_float(xe << 16), xhi = __uint_as_float(xe & 0xffff0000u);
                        const float plo = __uint_as_float(pe << 16), phi = __uint_as_float(pe & 0xffff0000u);
                        const float a0 = (e < 2) ? acc[ai][bj][m][0][2 * e] : acc[ai][bj][m][1][2 * e - 4];
                        const float a1 = (e < 2) ? acc[ai][bj][m][0][2 * e + 1] : acc[ai][bj][m][1][2 * e - 3];
                        const float g0 = 1.f / (1.f + __expf(-a0 * rstd)), g1 = 1.f / (1.f + __expf(-a1 * rstd));
                        const float r0 = xlo + plo * g0, r1 = xhi + phi * g1;
                        if (e < 2) { o0[2 * e] = r0; o0[2 * e + 1] = r1; } else { o1[2 * e - 4] = r0; o1[2 * e - 3] = r1; }
                    }
                    { u32x4 w; w.x = cvt_pk_bf16(o0[0], o0[1]); w.y = cvt_pk_bf16(o0[2], o0[3]); w.z = cvt_pk_bf16(o1[0], o1[1]); w.w = cvt_pk_bf16(o1[2], o1[3]); *(u32x4*)(O + off) = w; }
                }
            }
    }
};
template <class Epi, class Sched, bool ALIGN_EPI = false, bool SP2 = false>
__device__ __forceinline__ void gemm_phase(PG8_LAS unsigned char* lds, const Gemm g, const Sched& S, const Epi& E, const int wave_id  ) {
    int lane_; asm volatile("v_mbcnt_lo_u32_b32 %0, -1, 0\n\tv_mbcnt_hi_u32_b32 %0, -1, %0" : "=v"(lane_)); int tid_ = wave_id * 64 + lane_;
    const int tid = tid_, wid = wave_id, lane = tid & 63, wr = wid >> 2, wc = wid & 3, fr = lane & 15, fq = lane >> 4;
    const int K = g.K, nt = K / BK;
    unsigned voffA[2], voffB[2];
#pragma unroll
    for (int i = 0; i < 2; ++i) { int R, C; stage_rc(tid * 16 + i * 8192, R, C); const int Rb = Epi::PERM ? ((R & ~31) + perm32(R & 31)) : R;
        voffA[i] = (unsigned)(R * K + C) * 2u; voffB[i] = (unsigned)(Rb * K + C) * 2u; }
    const size_t kstep = (size_t)(BK * 2);
    const size_t hstep = (size_t)HALF * K * 2;
    const size_t tstep = 2 * hstep;
    const unsigned ldsw = (unsigned)wid * 1024u;
    const int aoff = lds_byte(wr * 64 + fr, fq * 8), boff = lds_byte(wc * 32 + fr, fq * 8);
#define PG8_SA(b, h) (((b) * 2 + (h)) * HTB)
#define PG8_SB(b, h) ((4 + (b) * 2 + (h)) * HTB)
#define PG8_STAGE(bufoff, gbase, voff) do { _Pragma("unroll") for (int _i = 0; _i < 2; ++_i) \
        __builtin_amdgcn_global_load_lds((const unsigned*)((const char*)(gbase) + (voff)[_i]), (PG8_LAS unsigned*)(lds + (bufoff) + ldsw + _i * 8192), 16, 0, 0); } while (0)
#define PG8_LDA(dst, b, h) do { _Pragma("unroll") for (int m = 0; m < 4; ++m) _Pragma("unroll") for (int k = 0; k < 2; ++k) dst[m][k] = *(const PG8_LAS bf16x8*)(lds + PG8_SA(b, h) + aoff + m * 2048 + k * 1024); } while (0)
#define PG8_LDB(dst, b, h) do { _Pragma("unroll") for (int n = 0; n < 2; ++n) _Pragma("unroll") for (int k = 0; k < 2; ++k) dst[n][k] = *(const PG8_LAS bf16x8*)(lds + PG8_SB(b, h) + boff + n * 2048 + k * 1024); } while (0)
#define PG8_MMA(ai, bj, At, Bt) do { __builtin_amdgcn_s_setprio(1); _Pragma("unroll") for (int m = 0; m < 4; ++m) _Pragma("unroll") for (int n = 0; n < 2; ++n) _Pragma("unroll") for (int k = 0; k < 2; ++k) \
        acc[ai][bj][m][n] = __builtin_amdgcn_mfma_f32_16x16x32_bf16(Bt[n][k], At[m][k], acc[ai][bj][m][n], 0, 0, 0); __builtin_amdgcn_s_setprio(0); } while (0)
#define PG8_WAIT_V(n) asm volatile("s_waitcnt vmcnt(" #n ")" ::: "memory")
#define PG8_WAIT_L(n) asm volatile("s_waitcnt lgkmcnt(" #n ")" ::: "memory")
#define PG8_BAR __builtin_amdgcn_s_barrier()
#define PG8_SCHED __builtin_amdgcn_sched_barrier(0)
    Unit cur, nxt; int ui = 0;
    if (!S.next(0, cur)) return;
    f32x4 acc[2][2][4][2];
#pragma unroll
    for (int a = 0; a < 2; ++a)
#pragma unroll
        for (int b = 0; b < 2; ++b)
#pragma unroll
            for (int m = 0; m < 4; ++m)
#pragma unroll
                for (int n = 0; n < 2; ++n) acc[a][b][m][n] = (f32x4){0.f, 0.f, 0.f, 0.f};
    bf16x8 At[4][2], B0[2][2], B1[2][2];
    const char* cA = (const char*)g.A + (size_t)cur.pm * tstep; const char* cB = (const char*)g.Bt + (size_t)cur.pn * tstep;
    S.a_ready(cur);
    if constexpr (SP2) {
        PG8_STAGE(PG8_SB(0, 0), cB, voffB); PG8_STAGE(PG8_SB(0, 1), cB + hstep, voffB); PG8_STAGE(PG8_SA(0, 0), cA, voffA); PG8_STAGE(PG8_SA(0, 1), cA + hstep, voffA);
        if (wr == 1) PG8_BAR;
        PG8_WAIT_V(2); PG8_BAR;
        PG8_STAGE(PG8_SB(1, 0), cB + kstep, voffB); PG8_STAGE(PG8_SA(1, 0), cA + kstep, voffA); PG8_STAGE(PG8_SB(1, 1), cB + hstep + kstep, voffB);
        PG8_WAIT_V(6); PG8_BAR;
    } else {
        PG8_STAGE(PG8_SB(0, 0), cB, voffB); PG8_STAGE(PG8_SA(0, 0), cA, voffA); PG8_STAGE(PG8_SB(0, 1), cB + hstep, voffB); PG8_STAGE(PG8_SA(0, 1), cA + hstep, voffA);
        if (wr == 1) PG8_BAR;
        PG8_WAIT_V(4); PG8_BAR;
        PG8_STAGE(PG8_SB(1, 0), cB + kstep, voffB); PG8_STAGE(PG8_SA(1, 0), cA + kstep, voffA); PG8_STAGE(PG8_SB(1, 1), cB + hstep + kstep, voffB);
        PG8_WAIT_V(6); PG8_BAR;
    }
    for (;;) {
        const bool has_next = S.next(ui + 1, nxt);
        const char* nA = has_next ? (const char*)g.A + (size_t)nxt.pm * tstep : cA; const char* nB = has_next ? (const char*)g.Bt + (size_t)nxt.pn * tstep : cB;
        for (int t = 0; t < nt; t += 2) {
            const bool last = (t == nt - 2);
            const char* a1 = cA + (size_t)(t + 1) * kstep;
            const char* a2 = last ? nA : cA + (size_t)(t + 2) * kstep; const char* b2 = last ? nB : cB + (size_t)(t + 2) * kstep;
            const char* a3 = a2 + kstep; const char* b3 = b2 + kstep;
            if (last && has_next) S.a_ready(nxt);
            if constexpr (SP2) {
            PG8_LDB(B0, 0, 0); PG8_LDB(B1, 0, 1); PG8_SCHED; PG8_LDA(At, 0, 0); PG8_STAGE(PG8_SA(1, 1), a1 + hstep, voffA);
            PG8_WAIT_V(8); PG8_WAIT_L(0); PG8_BAR; PG8_MMA(0, 0, At, B0); PG8_MMA(0, 1, At, B1); PG8_BAR; PG8_SCHED;
            PG8_LDA(At, 0, 1); PG8_STAGE(PG8_SB(0, 0), b2, voffB); PG8_STAGE(PG8_SB(0, 1), b2 + hstep, voffB); PG8_STAGE(PG8_SA(0, 0), a2, voffA);
            PG8_WAIT_V(8); PG8_WAIT_L(0); PG8_BAR; PG8_MMA(1, 0, At, B0); PG8_MMA(1, 1, At, B1); PG8_BAR; PG8_SCHED;
            PG8_LDB(B0, 1, 0); PG8_LDB(B1, 1, 1); PG8_SCHED; PG8_LDA(At, 1, 0); PG8_STAGE(PG8_SA(0, 1), a2 + hstep, voffA);
            PG8_WAIT_V(8); PG8_WAIT_L(0); PG8_BAR; PG8_MMA(0, 0, At, B0); PG8_MMA(0, 1, At, B1); PG8_BAR; PG8_SCHED;
            PG8_LDA(At, 1, 1); PG8_STAGE(PG8_SB(1, 0), b3, voffB); PG8_STAGE(PG8_SB(1, 1), b3 + hstep, voffB); PG8_STAGE(PG8_SA(1, 0), a3, voffA);
            PG8_WAIT_V(8); PG8_WAIT_L(0); PG8_BAR; PG8_MMA(1, 0, At, B0); PG8_MMA(1, 1, At, B1); PG8_BAR; PG8_SCHED;
            } else {
            PG8_LDB(B0, 0, 0); PG8_SCHED; PG8_LDA(At, 0, 0); PG8_STAGE(PG8_SA(1, 1), a1 + hstep, voffA);
            PG8_WAIT_L(8); PG8_BAR; PG8_WAIT_L(0); PG8_MMA(0, 0, At, B0); PG8_BAR; PG8_SCHED;
            PG8_LDB(B1, 0, 1); PG8_STAGE(PG8_SB(0, 0), b2, voffB);
            PG8_BAR; PG8_WAIT_L(0); PG8_MMA(0, 1, At, B1); PG8_BAR;
            PG8_LDA(At, 0, 1); PG8_STAGE(PG8_SA(0, 0), a2, voffA);
            PG8_BAR; PG8_WAIT_L(0); PG8_MMA(1, 0, At, B0); PG8_BAR; PG8_SCHED;
            PG8_STAGE(PG8_SB(0, 1), b2 + hstep, voffB);
            PG8_WAIT_V(6); PG8_BAR; PG8_MMA(1, 1, At, B1); PG8_BAR;
            PG8_LDB(B0, 1, 0); PG8_SCHED; PG8_LDA(At, 1, 0); PG8_STAGE(PG8_SA(0, 1), a2 + hstep, voffA);
            PG8_WAIT_L(8); PG8_BAR; PG8_WAIT_L(0); PG8_MMA(0, 0, At, B0); PG8_BAR; PG8_SCHED;
            PG8_LDB(B1, 1, 1); PG8_STAGE(PG8_SB(1, 0), b3, voffB);
            PG8_BAR; PG8_WAIT_L(0); PG8_MMA(0, 1, At, B1); PG8_BAR;
            PG8_LDA(At, 1, 1); PG8_STAGE(PG8_SA(1, 0), a3, voffA);
            PG8_BAR; PG8_WAIT_L(0); PG8_MMA(1, 0, At, B0); PG8_BAR; PG8_SCHED;
            PG8_STAGE(PG8_SB(1, 1), b3 + hstep, voffB);
            PG8_WAIT_V(6); PG8_BAR; PG8_MMA(1, 1, At, B1); PG8_BAR;
            }
        }
        if constexpr (ALIGN_EPI) { if (wr == 0) PG8_BAR; }
        if constexpr (!Epi::AFTER_DRAIN) { E(acc, cur, wr, wc, fr, fq); S.done(cur); }
        if (!has_next) break;
#pragma unroll
        for (int a = 0; a < 2; ++a)
#pragma unroll
            for (int b = 0; b < 2; ++b)
#pragma unroll
                for (int m = 0; m < 4; ++m)
#pragma unroll
                    for (int n = 0; n < 2; ++n) acc[a][b][m][n] = (f32x4){0.f, 0.f, 0.f, 0.f};
        cur = nxt; cA = nA; cB = nB; ++ui;
        if constexpr (ALIGN_EPI) { if (wr == 1) PG8_BAR; }
    }
    PG8_WAIT_V(0);
    if constexpr (!ALIGN_EPI) { if (wr == 0) PG8_BAR; }
    PG8_BAR;
    if constexpr (Epi::AFTER_DRAIN) { E.fused(acc, cur, wr, wc, fr, fq, lds, wid, lane); S.done(cur); }
#undef PG8_SA
#undef PG8_SB
#undef PG8_STAGE
#undef PG8_LDA
#undef PG8_LDB
#undef PG8_MMA
#undef PG8_WAIT_V
#undef PG8_WAIT_L
#undef PG8_BAR
#undef PG8_SCHED
}
}

#define GAS __attribute__((address_space(1)))
#define LAS __attribute__((address_space(3)))
typedef unsigned short bf16;
typedef unsigned v4u __attribute__((ext_vector_type(4)));
typedef float f32x4 __attribute__((ext_vector_type(4)));
typedef short bf16x8 __attribute__((ext_vector_type(8)));
typedef GAS unsigned gu32;
typedef GAS unsigned long long gu64;
#define RLX_AGENT __ATOMIC_RELAXED, __HIP_MEMORY_SCOPE_AGENT
#define LDS_WAIT() asm volatile("s_waitcnt lgkmcnt(0)" ::: "memory")
#define VM_WAIT() asm volatile("s_waitcnt vmcnt(0)" ::: "memory")
__device__ __forceinline__ unsigned long long rt() { return __builtin_amdgcn_s_memrealtime(); }
__device__ __forceinline__ unsigned f2bf(float f) { unsigned u = __builtin_bit_cast(unsigned, f); return (u + 0x7fffu + ((u >> 16) & 1u)) >> 16; }
__device__ __forceinline__ unsigned pk2(float lo, float hi) { return f2bf(lo) | (f2bf(hi) << 16); }

#define XB_TMO      128
#define XB_XCNT(j)  (256  + 64 * (j))
#define XB_XSUB(j)  (1280 + 64 * (j))
#define XB_XGEN(j)  (2304 + 64 * (j))
#define XB_TOP      3328
#define XB_TOPGEN   3392
#define XCD_BAR_WORDS 3456
#define XB_SPIN_CAP (1u << 18)

__device__ __forceinline__ unsigned xb_ld(unsigned* p)              { return __hip_atomic_load(p, __ATOMIC_RELAXED, __HIP_MEMORY_SCOPE_AGENT); }
__device__ __forceinline__ unsigned xb_add(unsigned* p, unsigned v) { return __hip_atomic_fetch_add(p, v, __ATOMIC_RELAXED, __HIP_MEMORY_SCOPE_AGENT); }
__device__ __forceinline__ unsigned xb_xcc_id() { return (unsigned)__builtin_amdgcn_s_getreg((3 << 11) | 20) & 0xFu; }
#define XB_SPIN(cond, bar) do { unsigned _sp = 0; while (cond) { __builtin_amdgcn_s_sleep(1); \
    if ((++_sp & 255u) == 0u) { if (xb_ld(&(bar)[XB_TMO])) break; if (_sp > XB_SPIN_CAP) { atomicAdd(&(bar)[XB_TMO], 1u); break; } } } } while (0)

struct XcdBarrier {
    unsigned* bar; unsigned x;
    volatile LAS unsigned* st;
};

__device__ __forceinline__ XcdBarrier xcd_barrier_post(unsigned* bar, volatile LAS unsigned* st) {
    XcdBarrier b; b.bar = bar; b.x = xb_xcc_id(); b.st = st;
    if (threadIdx.x == 0) (void)xb_add(&bar[XB_XCNT(b.x)], 1u);
    return b;
}
__device__ __forceinline__ void xcd_barrier_complete(unsigned* bar, unsigned x, unsigned& nloc, unsigned& nx) {
    const unsigned G = gridDim.x * gridDim.y * gridDim.z;
    unsigned sum, cnt, mine, sp = 0u;
    for (;;) {
        sum = 0u; cnt = 0u; mine = 0u;
#pragma unroll
        for (unsigned j = 0; j < 16; ++j) { const unsigned c = xb_ld(&bar[XB_XCNT(j)]); sum += c; cnt += (c > 0u) ? 1u : 0u; mine = (j == x) ? c : mine; }
        if (sum == G) break;
        __builtin_amdgcn_s_sleep(1);
        if ((++sp & 255u) == 0u) { if (xb_ld(&bar[XB_TMO])) break; if (sp > XB_SPIN_CAP) { atomicAdd(&bar[XB_TMO], 1u); break; } }
    }
    nloc = mine > 0u ? mine : 1u; nx = cnt > 0u ? cnt : 1u;
}

__device__ __forceinline__ void xcd_barrier(const XcdBarrier& b, const bool leader  ) {
    asm volatile("s_waitcnt vmcnt(0)" ::: "memory");
    __syncthreads();
    if (leader) {
        unsigned* bar = b.bar;
        __builtin_amdgcn_s_waitcnt(0);
        unsigned nloc = b.st[0], nx = b.st[1];
        if (nloc == 0u) { xcd_barrier_complete(bar, b.x, nloc, nx); b.st[0] = nloc; b.st[1] = nx; }
        const unsigned old = xb_add(&bar[XB_XSUB(b.x)], 1u);
        const unsigned gen = old / nloc;
        if (old + 1u == (gen + 1u) * nloc) {
            __builtin_amdgcn_fence(__ATOMIC_RELEASE, "agent");
            asm volatile("s_waitcnt vmcnt(0)" ::: "memory");
            const unsigned og = xb_add(&bar[XB_TOP], 1u);
            const unsigned tg = og / nx;
            if (og + 1u == (tg + 1u) * nx) xb_add(&bar[XB_TOPGEN], 1u);
            else XB_SPIN(xb_ld(&bar[XB_TOPGEN]) == tg, bar);
            __builtin_amdgcn_fence(__ATOMIC_ACQUIRE, "agent");
            xb_add(&bar[XB_XGEN(b.x)], 1u);
            asm volatile("s_waitcnt vmcnt(0)" ::: "memory");
        } else {
            XB_SPIN(xb_ld(&bar[XB_XGEN(b.x)]) == gen, bar);
            __builtin_amdgcn_fence(__ATOMIC_ACQUIRE, "agent");
            asm volatile("s_waitcnt vmcnt(0)" ::: "memory");
        }
    }
    __syncthreads();
}
#ifndef REP_P0
#define REP_P0 1
#endif
#ifndef REP_P1
#define REP_P1 1
#endif
#ifndef REP_P2
#define REP_P2 1
#endif
#ifndef REP_P2A
#define REP_P2A 1
#endif
#ifndef REP_SEQ
#define REP_SEQ 1
#endif
#ifndef REP_DSW
#define REP_DSW 1
#endif
#ifndef REP_P3
#define REP_P3 1
#endif
#ifndef REP_P4
#define REP_P4 1
#endif
#ifndef REP_P5
#define REP_P5 1
#endif
#ifndef REP_P6
#define REP_P6 1
#endif
#ifndef REP_P7
#define REP_P7 1
#endif
constexpr int NWAVES = 8;
constexpr int T = 32768, D = 1024, SEQ = 4096;
constexpr int INC = 3328, INCP = 3328, INC_OLD = 3088;
constexpr int OFF_QA = 0, OFF_KA = 256, OFF_VA = 512, OFF_RA = 1024, OFF_LA = 1536, OFF_QB = 1792, OFF_KB = 2304, OFF_VB = 2816;
constexpr float EPS = 1e-6f;
constexpr size_t MiB = 1u << 20;
constexpr size_t WS_CTL = 0, CTL_ZERO_BYTES = 1 * MiB;
constexpr size_t WS_BT_IN = 2 * MiB, WS_BT_OUT = 10 * MiB, WS_BT_PQ = 12 * MiB, WS_BT_PG = 16 * MiB, WS_BT_PP = 18 * MiB;
constexpr size_t WS_ROPE = 20 * MiB, WS_SSQ1 = 22 * MiB, WS_RSTD2 = 24 * MiB, WS_KEYSB = 26 * MiB, WS_GDEC = 27 * MiB;
constexpr size_t WS_H1 = 32 * MiB;
constexpr size_t WS_PROJ = 96 * MiB;
constexpr size_t WS_QR = 96 * MiB, WS_SEL = 224 * MiB;
constexpr size_t WS_MIX = 304 * MiB;
constexpr size_t WS_PB = 368 * MiB;
constexpr size_t WS_PPROJ = 384 * MiB;
constexpr size_t WS_X2B = 304 * MiB;
constexpr size_t WS_UB = 448 * MiB, WS_VB = 464 * MiB;
constexpr size_t WS_GOG = 32 * MiB;
constexpr size_t WS_GQD = 368 * MiB;
constexpr size_t WS_GKV = 480 * MiB;
constexpr size_t WS_END = 512 * MiB;
constexpr int CW_BAR = 4096;
constexpr int CW_DSW = 16384;
constexpr int RING_OFF = 0, RING_BYTES = 131072;
constexpr int LDSCTL_OFF = 159 * 1024, MISC_OFF = LDSCTL_OFF + 320;
constexpr int LDS_BYTES = 163840;

__device__ __forceinline__ float bf2f(bf16 v) { return __uint_as_float(((unsigned)v) << 16); }
__device__ __forceinline__ float wave_sum(float v) {
    v += __int_as_float(__builtin_amdgcn_update_dpp(0, __float_as_int(v), 0xB1, 0xF, 0xF, true));
    v += __int_as_float(__builtin_amdgcn_update_dpp(0, __float_as_int(v), 0x4E, 0xF, 0xF, true));
    v += __int_as_float(__builtin_amdgcn_update_dpp(0, __float_as_int(v), 0x141, 0xF, 0xF, true));
    v += __int_as_float(__builtin_amdgcn_update_dpp(0, __float_as_int(v), 0x140, 0xF, 0xF, true));
    v += __int_as_float(__builtin_amdgcn_update_dpp(0, __float_as_int(v), 0x142, 0xA, 0xF, false));
    v += __int_as_float(__builtin_amdgcn_update_dpp(0, __float_as_int(v), 0x143, 0xC, 0xF, false));
    return __int_as_float(__builtin_amdgcn_readlane(__float_as_int(v), 63));
}
__device__ __forceinline__ float xshfl(float v, int srclane) { return __int_as_float(__builtin_amdgcn_ds_bpermute(srclane << 2, __float_as_int(v))); }
__device__ __forceinline__ int xshfl_i(int v, int srclane) { return __builtin_amdgcn_ds_bpermute(srclane << 2, v); }


typedef __bf16 bf16x2_t __attribute__((ext_vector_type(2)));
typedef int i32x2 __attribute__((ext_vector_type(2)));
typedef short s16x4 __attribute__((ext_vector_type(4)));
typedef float f32x2 __attribute__((ext_vector_type(2)));
typedef float f32x32 __attribute__((ext_vector_type(32)));
typedef float f32x16 __attribute__((ext_vector_type(16)));
typedef __bf16 bf16x32 __attribute__((ext_vector_type(32)));
typedef unsigned u32x6 __attribute__((ext_vector_type(6)));
typedef unsigned u32x16 __attribute__((ext_vector_type(16)));
__device__ __forceinline__ unsigned enc6(float y) { const float q = fabsf(y) * 8.f; float c;
    if (q < 16.f) c = rintf(q); else if (q < 32.f) c = 16.f + rintf((q - 16.f) * 0.5f); else c = 24.f + rintf((q - 32.f) * 0.25f);
    c = fminf(c, 31.f); return (unsigned)c | ((__float_as_uint(y) >> 31) << 5); }
__device__ __forceinline__ unsigned enc4(float y) { const float a = fabsf(y);
    const unsigned c = (a > 0.25f) + (a > 0.75f) + (a > 1.25f) + (a > 1.75f) + (a > 2.5f) + (a > 3.5f) + (a > 5.0f); return c | ((__float_as_uint(y) >> 31) << 3); }
__device__ __forceinline__ unsigned cvtpk(float a, float b) { const f32x2 v = {a, b}; return __builtin_bit_cast(unsigned, __builtin_convertvector(v, bf16x2_t)); }
template <int CTRL> __device__ __forceinline__ float dpp_mov(float v) { return __int_as_float(__builtin_amdgcn_update_dpp(0, __float_as_int(v), CTRL, 0xF, 0xF, true)); }
__device__ __forceinline__ float row_sum16(float v) { v += dpp_mov<0xB1>(v); v += dpp_mov<0x4E>(v); v += dpp_mov<0x141>(v); v += dpp_mov<0x140>(v); return v; }
__device__ __forceinline__ float dot2bf(unsigned a, unsigned b, float c) { return __builtin_amdgcn_fdot2_f32_bf16(__builtin_bit_cast(bf16x2_t, a), __builtin_bit_cast(bf16x2_t, b), c, false); }
__device__ __forceinline__ float bflo(unsigned w) { return __uint_as_float(w << 16); }
__device__ __forceinline__ float bfhi(unsigned w) { return __uint_as_float(w & 0xffff0000u); }


__device__ __forceinline__ int f2key(float f) { const int b = __float_as_int(f); return b ^ ((b >> 31) & 0x7fffffff); }
__device__ __forceinline__ float key2f(int k) { return __int_as_float(k ^ ((k >> 31) & 0x7fffffff)); }
#define CE_DESC(a, b) { const int _hi = max((a), (b)), _lo = min((a), (b)); (a) = _hi; (b) = _lo; }
template <int N> __device__ __forceinline__ void bitonic_sort_desc(int (&v)[N]) {
#pragma unroll
    for (int k = 2; k <= N; k <<= 1)
#pragma unroll
        for (int j = k >> 1; j > 0; j >>= 1)
#pragma unroll
            for (int i = 0; i < N; ++i) { const int l = i ^ j; if (l > i) { if ((i & k) == 0) CE_DESC(v[i], v[l]) else CE_DESC(v[l], v[i]) } }
}
template <int N> __device__ __forceinline__ void bitonic_merge_desc(int (&v)[N]) {
#pragma unroll
    for (int j = N >> 1; j > 0; j >>= 1)
#pragma unroll
        for (int i = 0; i < N; ++i) { const int l = i ^ j; if (l > i) CE_DESC(v[i], v[l]) }
}
__device__ __forceinline__ void merge_top16(int (&a)[16], int srclane) {
    int b[16];
#pragma unroll
    for (int i = 0; i < 16; ++i) b[i] = __builtin_amdgcn_ds_bpermute(srclane << 2, a[i]);
#pragma unroll
    for (int i = 0; i < 16; ++i) a[i] = max(a[i], b[15 - i]);
    bitonic_merge_desc<16>(a);
}
struct CandTab { int i[64], j[64]; int n;
    constexpr CandTab() : i{}, j{}, n(0) { for (int a = 0; a < 16; ++a) for (int b = 0; b < 16; ++b) if ((a + 1) * (b + 1) <= 16) { i[n] = a; j[n] = b; ++n; } for (int q = n; q < 64; ++q) { i[q] = -1; j[q] = -1; } } };
constexpr CandTab kCand{};
static_assert(kCand.n == 50, "50 product-key candidates can reach the top 16");

__device__ __forceinline__ float max_x16(float x) { const auto r = __builtin_amdgcn_permlane16_swap(__float_as_uint(x), __float_as_uint(x), false, false); return fmaxf(__uint_as_float(r[0]), __uint_as_float(r[1])); }
__device__ __forceinline__ float max_x32(float x) { const auto r = __builtin_amdgcn_permlane32_swap(__float_as_uint(x), __float_as_uint(x), false, false); return fmaxf(__uint_as_float(r[0]), __uint_as_float(r[1])); }
__device__ __forceinline__ float add_x16(float x) { const auto r = __builtin_amdgcn_permlane16_swap(__float_as_uint(x), __float_as_uint(x), false, false); return __uint_as_float(r[0]) + __uint_as_float(r[1]); }
__device__ __forceinline__ float add_x32(float x) { const auto r = __builtin_amdgcn_permlane32_swap(__float_as_uint(x), __float_as_uint(x), false, false); return __uint_as_float(r[0]) + __uint_as_float(r[1]); }

__device__ __forceinline__ void p0_transpose_item(const float* W, int K, int ldw, int src0, int ncols, const float* gain, bf16* WT, int dst0, int nblk, LAS float* scr, int item, int lane) {
    const int kb = item / nblk, nb = item % nblk, k0 = 64 * kb, n0 = 32 * nb;
    const int n = n0 + (lane & 31);
#pragma unroll 8
    for (int i = 0; i < 32; ++i) { const int kk = 2 * i + (lane >> 5); float v = 0.f; if (n < ncols) { v = W[(size_t)(k0 + kk) * ldw + src0 + n]; if (gain) v *= gain[k0 + kk]; } scr[kk * 33 + (lane & 31)] = v; }
    LDS_WAIT(); asm volatile("" ::: "memory");
    const int c = lane & 7;
#pragma unroll
    for (int j = 0; j < 4; ++j) { const int nn = (lane >> 3) + 8 * j; const LAS float* s = scr + (8 * c) * 33 + nn;
        v4u o; o.x = pk2(s[0 * 33], s[1 * 33]); o.y = pk2(s[2 * 33], s[3 * 33]); o.z = pk2(s[4 * 33], s[5 * 33]); o.w = pk2(s[6 * 33], s[7 * 33]);
        *(GAS v4u*)(WT + (size_t)(dst0 + n0 + nn) * K + k0 + 8 * c) = o; }
    LDS_WAIT(); asm volatile("" ::: "memory");
}

struct Args { const float* in[18]; float* outp; unsigned char* ws; };

#define xin      (args.in[0])
#define p_in     (args.in[1])
#define positions ((const int*)args.in[2])
#define g_mix    (args.in[3])
#define w_in     (args.in[4])
#define w_up     (args.in[5])
#define b_gate   (args.in[6])
#define g_gla    (args.in[7])
#define w_out    (args.in[8])
#define g_peer   (args.in[9])
#define w_pq     (args.in[10])
#define skeys    (args.in[11])
#define pu       (args.in[12])
#define pv       (args.in[13])
#define g_ple    (args.in[14])
#define w_pg     (args.in[15])
#define w_pp     (args.in[16])
#define g_final  (args.in[17])
#define out      (args.outp)
#define Bt_in    ((bf16*)(args.ws + WS_BT_IN))
#define Bt_out   ((bf16*)(args.ws + WS_BT_OUT))
#define Bt_pq    ((bf16*)(args.ws + WS_BT_PQ))
#define Bt_pg    ((bf16*)(args.ws + WS_BT_PG))
#define Bt_pp    ((bf16*)(args.ws + WS_BT_PP))
#define rope     ((float*)(args.ws + WS_ROPE))
#define ssq1     ((float*)(args.ws + WS_SSQ1))
#define rstd2    ((float*)(args.ws + WS_RSTD2))
#define h1       ((bf16*)(args.ws + WS_H1))
#define x1b      ((bf16*)(args.ws + WS_H1))
#define proj     ((bf16*)(args.ws + WS_PROJ))
#define qr       ((bf16*)(args.ws + WS_QR))
#define sel2     ((i32x2*)(args.ws + WS_SEL))
#define Ub       ((unsigned char*)(args.ws + WS_UB))
#define Vb       ((unsigned char*)(args.ws + WS_VB))
#define keysb    ((bf16*)(args.ws + WS_KEYSB))
#define mix      ((bf16*)(args.ws + WS_MIX))
#define pb       ((bf16*)(args.ws + WS_PB))
#define pproj    ((bf16*)(args.ws + WS_PPROJ))
#define x2b      ((bf16*)(args.ws + WS_X2B))


__global__ void __launch_bounds__(NWAVES * 64, 2) mk_fwd(Args args) {
    extern __shared__ __attribute__((aligned(16))) unsigned char lds[];
    LAS unsigned char* const L = (LAS unsigned char*)lds;
    volatile LAS unsigned* const MISC = (volatile LAS unsigned*)(L + MISC_OFF);
    const int wave = __builtin_amdgcn_readfirstlane((int)threadIdx.x >> 6);
#define LANE_DECL int lane; asm volatile("v_mbcnt_lo_u32_b32 %0, -1, 0\n\tv_mbcnt_hi_u32_b32 %0, -1, %0" : "=v"(lane))
    const int G = gridDim.x; const int bx = blockIdx.x;
    const int vcu = (G % 8 == 0) ? (bx % 8) * (G / 8) + bx / 8 : bx;
    const int gw = vcu * NWAVES + wave, NGW = G * NWAVES;
    gu32* const ctl = (gu32*)(args.ws + WS_CTL);
    for (int u = threadIdx.x; u < (LDS_BYTES - LDSCTL_OFF) / 4; u += NWAVES * 64) ((LAS unsigned*)(L + LDSCTL_OFF))[u] = 0u;
    __syncthreads();
    XcdBarrier bar = xcd_barrier_post((unsigned*)(ctl + CW_BAR), MISC + 8);

    for (int rep_ = 0; rep_ < REP_P0; ++rep_) {
        LANE_DECL;
        LAS float* scr = (LAS float*)(L + RING_OFF + wave * 16384);
        constexpr int I_INA = 16 * 48, I_INB = 16 * 48, I_PP = 4 * 32;
        constexpr int NITEMS = I_INA + I_INB + I_PP;
        for (int it = gw; it < NITEMS; it += NGW) {
            int r = it;
            if (r < I_INA) { p0_transpose_item(w_in, 1024, INC_OLD, 0, 1536, nullptr, Bt_in, 0, 48, scr, r, lane); continue; } r -= I_INA;
            if (r < I_INB) { p0_transpose_item(w_in, 1024, INC_OLD, 1552, 1536, nullptr, Bt_in, 1792, 48, scr, r, lane); continue; } r -= I_INB;
            p0_transpose_item(w_pp, 256, 1024, 0, 1024, nullptr, Bt_pp, 0, 32, scr, r, lane);
        }
        for (int i = gw * 64 + lane; i < 256 * 128; i += NGW * 64) {
            const int n = i >> 7, k0 = (i & 127) * 8;
            float wu[16];
#pragma unroll
            for (int r = 0; r < 16; ++r) wu[r] = w_up[r * 256 + n];
            float o8[8];
#pragma unroll
            for (int kk = 0; kk < 8; ++kk) { const GAS f32x4* wr4 = (const GAS f32x4*)(w_in + (size_t)(k0 + kk) * INC_OLD + 1536); float a = 0.f;
#pragma unroll
                for (int q = 0; q < 4; ++q) { const f32x4 w4 = wr4[q]; a += w4.x * wu[4 * q] + w4.y * wu[4 * q + 1] + w4.z * wu[4 * q + 2] + w4.w * wu[4 * q + 3]; }
                o8[kk] = a; }
            v4u o; o.x = pk2(o8[0], o8[1]); o.y = pk2(o8[2], o8[3]); o.z = pk2(o8[4], o8[5]); o.w = pk2(o8[6], o8[7]);
            *(GAS v4u*)(Bt_in + (size_t)(1536 + n) * 1024 + k0) = o;
        }
        for (int row = gw; row < T; row += NGW) {
            const GAS f32x4* xr = (const GAS f32x4*)(xin + (size_t)row * D) + lane;
            f32x4 v[4]; float s = 0.f;
#pragma unroll
            for (int j = 0; j < 4; ++j) { v[j] = xr[64 * j]; s += (v[j].x * v[j].x + v[j].y * v[j].y) + (v[j].z * v[j].z + v[j].w * v[j].w); }
            const float rstd = rsqrtf(wave_sum(s) * (1.f / D) + EPS);
            GAS unsigned long long* o8 = (GAS unsigned long long*)(h1 + (size_t)row * D) + lane;
#pragma unroll
            for (int j = 0; j < 4; ++j) { const f32x4 gg = ((const GAS f32x4*)g_mix)[64 * j + lane];
                o8[64 * j] = (unsigned long long)pk2(v[j].x * rstd * gg.x, v[j].y * rstd * gg.y) | ((unsigned long long)pk2(v[j].z * rstd * gg.z, v[j].w * rstd * gg.w) << 32); }
        }
        for (size_t i = (size_t)gw * 64 + lane; i < (size_t)T * 256 / 4; i += (size_t)NGW * 64) {
            const f32x4 v = ((const GAS f32x4*)p_in)[i];
            ((GAS unsigned long long*)pb)[i] = (unsigned long long)pk2(v.x, v.y) | ((unsigned long long)pk2(v.z, v.w) << 32);
        }
        for (int i = gw * 64 + lane; i < T * 8; i += NGW * 64) {
            const int t = i >> 3, j = i & 7;
            const float inv_freq = powf(500000.0f, -(float)j / 8.0f);
            const float ang = (float)positions[t] * inv_freq;
            rope[2 * i] = cosf(ang); rope[2 * i + 1] = sinf(ang);
        }
    }
    { LANE_DECL; xcd_barrier(bar, wave == 0 && lane == 0); }

    for (int rep_ = 0; rep_ < REP_P1; ++rep_) {
        pg8::Gemm g{h1, Bt_in, T, INCP, D}; pg8::StaticOrder S; S.init(T, INCP, G, bx);
        pg8::EpiInProj E{proj, rope, b_gate};
        pg8::gemm_phase<pg8::EpiInProj, pg8::StaticOrder, true, true>(L + RING_OFF, g, S, E, wave);
        pg8::Gemm g2{pb, Bt_pp, T, D, 256}; pg8::StaticOrder S2;
        { const int nfull = (T / 256) * (INCP / 256) - ((T / 256) * (INCP / 256) / G) * G;
          if (nfull > 0 && nfull < G && ((G - nfull) % 8) == 0 && (nfull % 8) == 0) S2.init(T, D, G - nfull, bx >= nfull ? bx - nfull : (1 << 28)); else S2.init(T, D, G, bx); }
        pg8::EpiBf16<0> E2{pproj, D, nullptr, 0, 0, 1.f};
        pg8::gemm_phase<pg8::EpiBf16<0>, pg8::StaticOrder, true, true>(L + RING_OFF, g2, S2, E2, wave);
    }
    { LANE_DECL; xcd_barrier(bar, wave == 0 && lane == 0); }

    {
        LANE_DECL;
        const int fr = lane & 15, g = lane >> 4;
        constexpr int RS = 144;
        LAS unsigned char* const qd = L + RING_OFF;
        LAS unsigned char* const kd = qd + 64 * RS;
        LAS unsigned char* const keT = kd + 64 * RS;
        LAS unsigned char* const vT = keT + 64 * RS;
        LAS unsigned char* const Am = vT + 128 * RS;
        LAS float* const dec = (LAS float*)(Am + 64 * RS);
        for (int i = wave * 64 + lane; i < 64 * RS / 4; i += NWAVES * 64) ((LAS unsigned*)Am)[i] = 0u;
        __syncthreads();
        for (int rep4_ = 0; rep4_ < REP_P2A; ++rep4_) {
        int u = bx;
        const bf16* prow = proj + (size_t)((u >> 6) * 64 + lane) * INC + 0;
        v4u lav, qv, kv, vv0, vv1;
        {
            const int hh = (u >> 6) & 3, t0 = (u >> 8) * SEQ + (u & 63) * 64;
            prow = proj + (size_t)(t0 + lane) * INC;
            lav = *(const GAS v4u*)(prow + OFF_LA + hh * 64 + 8 * wave); qv = *(const GAS v4u*)(prow + OFF_QA + hh * 64 + 8 * wave); kv = *(const GAS v4u*)(prow + OFF_KA + hh * 64 + 8 * wave);
            vv0 = *(const GAS v4u*)(prow + OFF_VA + hh * 128 + 16 * wave); vv1 = *(const GAS v4u*)(prow + OFF_VA + hh * 128 + 16 * wave + 8);
        }
        for (; u < 2048; u += G) {
            const int h = (u >> 6) & 3, t0 = (u >> 8) * SEQ + (u & 63) * 64;
            float laf[8];
            laf[0] = bflo(lav.x); laf[1] = bfhi(lav.x); laf[2] = bflo(lav.y); laf[3] = bfhi(lav.y); laf[4] = bflo(lav.z); laf[5] = bfhi(lav.z); laf[6] = bflo(lav.w); laf[7] = bfhi(lav.w);
            float qf[8], kf[8];
            qf[0] = bflo(qv.x); qf[1] = bfhi(qv.x); qf[2] = bflo(qv.y); qf[3] = bfhi(qv.y); qf[4] = bflo(qv.z); qf[5] = bfhi(qv.z); qf[6] = bflo(qv.w); qf[7] = bfhi(qv.w);
            kf[0] = bflo(kv.x); kf[1] = bfhi(kv.x); kf[2] = bflo(kv.y); kf[3] = bfhi(kv.y); kf[4] = bflo(kv.z); kf[5] = bfhi(kv.z); kf[6] = bflo(kv.w); kf[7] = bfhi(kv.w);
            float qdv[8], kdv[8], kev[8];
#pragma unroll
            for (int c = 0; c < 8; ++c) {
                float bsum = laf[c];
                bsum += __int_as_float(__builtin_amdgcn_update_dpp(0, __float_as_int(bsum), 0x111, 0xF, 0xF, false));
                bsum += __int_as_float(__builtin_amdgcn_update_dpp(0, __float_as_int(bsum), 0x112, 0xF, 0xF, false));
                bsum += __int_as_float(__builtin_amdgcn_update_dpp(0, __float_as_int(bsum), 0x114, 0xF, 0xF, false));
                bsum += __int_as_float(__builtin_amdgcn_update_dpp(0, __float_as_int(bsum), 0x118, 0xF, 0xF, false));
                bsum += __int_as_float(__builtin_amdgcn_update_dpp(0, __float_as_int(bsum), 0x142, 0xA, 0xF, false));
                bsum += __int_as_float(__builtin_amdgcn_update_dpp(0, __float_as_int(bsum), 0x143, 0xC, 0xF, false));
                const float blast = __int_as_float(__builtin_amdgcn_readlane(__float_as_int(bsum), 63));
                qdv[c] = qf[c] * 0.125f * __expf(bsum);
                kdv[c] = kf[c] * __expf(-bsum);
                kev[c] = kf[c] * __expf(blast - bsum);
                if (lane == 0) dec[8 * wave + c] = __expf(blast);
            }
#pragma unroll
            for (int c = 0; c < 8; c += 2) { const unsigned w2 = cvtpk(kev[c], kev[c + 1]);
                *(LAS bf16*)(keT + (8 * wave + c) * RS + lane * 2) = (bf16)(w2 & 0xffffu); *(LAS bf16*)(keT + (8 * wave + c + 1) * RS + lane * 2) = (bf16)(w2 >> 16); }
            { v4u o; o.x = cvtpk(qdv[0], qdv[1]); o.y = cvtpk(qdv[2], qdv[3]); o.z = cvtpk(qdv[4], qdv[5]); o.w = cvtpk(qdv[6], qdv[7]); *(LAS v4u*)(qd + lane * RS + 16 * wave) = o;
              v4u o2; o2.x = cvtpk(kdv[0], kdv[1]); o2.y = cvtpk(kdv[2], kdv[3]); o2.z = cvtpk(kdv[4], kdv[5]); o2.w = cvtpk(kdv[6], kdv[7]); *(LAS v4u*)(kd + lane * RS + 16 * wave) = o2; }
            {
                const unsigned vw[8] = {vv0.x, vv0.y, vv0.z, vv0.w, vv1.x, vv1.y, vv1.z, vv1.w};
#pragma unroll
                for (int e = 0; e < 8; ++e) { *(LAS bf16*)(vT + (16 * wave + 2 * e) * RS + lane * 2) = (bf16)(vw[e] & 0xffffu); *(LAS bf16*)(vT + (16 * wave + 2 * e + 1) * RS + lane * 2) = (bf16)(vw[e] >> 16); }
            }
            if (u + G < 2048) {
                const int un = u + G, hn = (un >> 6) & 3, tn = (un >> 8) * SEQ + (un & 63) * 64;
                const bf16* pn = proj + (size_t)(tn + lane) * INC;
                lav = *(const GAS v4u*)(pn + OFF_LA + hn * 64 + 8 * wave); qv = *(const GAS v4u*)(pn + OFF_QA + hn * 64 + 8 * wave); kv = *(const GAS v4u*)(pn + OFF_KA + hn * 64 + 8 * wave);
                vv0 = *(const GAS v4u*)(pn + OFF_VA + hn * 128 + 16 * wave); vv1 = *(const GAS v4u*)(pn + OFF_VA + hn * 128 + 16 * wave + 8);
            }
            unsigned long long rav[4];
#pragma unroll
            for (int tt = 0; tt < 4; ++tt) rav[tt] = *(const GAS unsigned long long*)(proj + (size_t)(t0 + 16 * tt + fr) * INC + OFF_RA + h * 128 + 16 * wave + 4 * g);
            const f32x4 ggl = *(const GAS f32x4*)(g_gla + h * 128 + 16 * wave + 4 * g);
            LDS_WAIT(); __syncthreads();
#pragma unroll
            for (int rep = 0; rep < 2; ++rep) {
                const int ti = wave + 8 * rep;
                if (ti < 10) {
                    const int tt = (ti >= 6) ? 3 : ((ti >= 3) ? 2 : ((ti >= 1) ? 1 : 0));
                    const int tk = ti - ((tt * (tt + 1)) >> 1);
                    f32x4 acc = {0.f, 0.f, 0.f, 0.f};
#pragma unroll
                    for (int ks = 0; ks < 2; ++ks) { const bf16x8 a = *(const LAS bf16x8*)(qd + (16 * tt + fr) * RS + (32 * ks + 8 * g) * 2), bb = *(const LAS bf16x8*)(kd + (16 * tk + fr) * RS + (32 * ks + 8 * g) * 2);
                        acc = __builtin_amdgcn_mfma_f32_16x16x32_bf16(a, bb, acc, 0, 0, 0); }
#pragma unroll
                    for (int r = 0; r < 4; ++r) { const int tq = 16 * tt + 4 * g + r, tc = 16 * tk + fr; *(LAS bf16*)(Am + tq * RS + tc * 2) = (bf16)f2bf(tq >= tc ? acc[r] : 0.f); }
                }
            }
            {
                const int tt = wave >> 1, ks = wave & 1;
                const unsigned long long lo = *(const LAS unsigned long long*)(qd + (16 * tt + fr) * RS + (32 * ks + 4 * g) * 2), hi = *(const LAS unsigned long long*)(qd + (16 * tt + fr) * RS + (32 * ks + 16 + 4 * g) * 2);
                v4u w; w.x = (unsigned)lo; w.y = (unsigned)(lo >> 32); w.z = (unsigned)hi; w.w = (unsigned)(hi >> 32);
                ((GAS v4u*)(args.ws + WS_GQD))[((size_t)u * 8 + wave) * 64 + lane] = w;
                if (wave == 0) ((GAS float*)(args.ws + WS_GDEC))[(size_t)u * 64 + lane] = dec[lane];
            }
            LDS_WAIT(); __syncthreads();
            bf16x8 vb[2];
#pragma unroll
            for (int ks = 0; ks < 2; ++ks) vb[ks] = *(const LAS bf16x8*)(vT + (16 * wave + fr) * RS + (32 * ks + 8 * g) * 2);
#pragma unroll
            for (int tt = 0; tt < 4; ++tt) {
                f32x4 acc = {0.f, 0.f, 0.f, 0.f};
#pragma unroll
                for (int ks = 0; ks < 2; ++ks) { const bf16x8 a = *(const LAS bf16x8*)(Am + (16 * tt + fr) * RS + (32 * ks + 8 * g) * 2); acc = __builtin_amdgcn_mfma_f32_16x16x32_bf16(vb[ks], a, acc, 0, 0, 0); }
                const unsigned rlo = (unsigned)rav[tt], rhi = (unsigned)(rav[tt] >> 32);
                const float rr[4] = {bflo(rlo), bfhi(rlo), bflo(rhi), bfhi(rhi)};
                v4u w;
#pragma unroll
                for (int r = 0; r < 4; ++r) { const float gate = ggl[r] * rr[r] * __builtin_amdgcn_rcpf(1.f + __expf(-rr[r])); w[r] = cvtpk(acc[r], gate); }
                ((GAS v4u*)(args.ws + WS_GOG))[(((size_t)u * 8 + wave) * 4 + tt) * 64 + lane] = w;
            }
#pragma unroll
            for (int dt = 0; dt < 4; ++dt) {
                f32x4 acc = {0.f, 0.f, 0.f, 0.f};
#pragma unroll
                for (int ks = 0; ks < 2; ++ks) { const bf16x8 a = *(const LAS bf16x8*)(keT + (16 * dt + fr) * RS + (32 * ks + 8 * g) * 2); acc = __builtin_amdgcn_mfma_f32_16x16x32_bf16(a, vb[ks], acc, 0, 0, 0); }
                const unsigned long long w = (unsigned long long)cvtpk(acc[0], acc[1]) | ((unsigned long long)cvtpk(acc[2], acc[3]) << 32);
                ((GAS unsigned long long*)(args.ws + WS_GKV))[(((size_t)u * 8 + wave) * 4 + dt) * 64 + lane] = w;
            }
            LDS_WAIT(); __syncthreads();
        }
        }
    }
    { LANE_DECL; xcd_barrier(bar, wave == 0 && lane == 0); }

    for (int rep_ = 0; rep_ < REP_P2; ++rep_) {
    for (int rep3_ = 0; rep3_ < REP_SEQ; ++rep3_)
    if (bx < 32) {
        LANE_DECL;
        const int fr = lane & 15, g = lane >> 4;
        const int b = bx >> 2, h = bx & 3;
        LAS float* const ssqb = (LAS float*)(L + RING_OFF);
        LAS float* const rstdl = ssqb + 1024 + wave * 64;
        f32x4 S[4];
#pragma unroll
        for (int dt = 0; dt < 4; ++dt) S[dt] = (f32x4){0.f, 0.f, 0.f, 0.f};
        const GAS v4u* const gog = (const GAS v4u*)(args.ws + WS_GOG);
        const GAS unsigned long long* const gkv = (const GAS unsigned long long*)(args.ws + WS_GKV);
        const GAS v4u* const gqd = (const GAS v4u*)(args.ws + WS_GQD);
        const GAS f32x4* const gdec = (const GAS f32x4*)(args.ws + WS_GDEC);
        const int u0 = bx * 64;
        v4u ogA[4], ogB[4]; unsigned long long kvA[4], kvB[4]; v4u qdA[8], qdB[8]; f32x4 dcA[4], dcB[4];
#define GLA_LOAD(og_, kv_, qd_, dc_, uu) do { const size_t u_ = (size_t)(uu); \
        _Pragma("unroll") for (int q = 0; q < 4; ++q) { og_[q] = gog[((u_ * 8 + wave) * 4 + q) * 64 + lane]; kv_[q] = gkv[((u_ * 8 + wave) * 4 + q) * 64 + lane]; dc_[q] = gdec[u_ * 16 + 4 * q + g]; } \
        _Pragma("unroll") for (int q = 0; q < 8; ++q) qd_[q] = gqd[(u_ * 8 + q) * 64 + lane]; } while (0)
#define GLA_STEP(og_, kv_, qd_, dc_, n_) do { \
            const int t0 = b * SEQ + (n_) * 64; \
            bf16x8 sa[2];                                                   \
            _Pragma("unroll") for (int ks = 0; ks < 2; ++ks) { v4u w; w.x = cvtpk(S[2 * ks][0], S[2 * ks][1]); w.y = cvtpk(S[2 * ks][2], S[2 * ks][3]); w.z = cvtpk(S[2 * ks + 1][0], S[2 * ks + 1][1]); w.w = cvtpk(S[2 * ks + 1][2], S[2 * ks + 1][3]); sa[ks] = __builtin_bit_cast(bf16x8, w); } \
            f32x4 o[4]; f32x4 gt[4];                                        \
            _Pragma("unroll") for (int tt = 0; tt < 4; ++tt) { \
                f32x4 acc; \
                _Pragma("unroll") for (int r = 0; r < 4; ++r) { acc[r] = bflo(og_[tt][r]); gt[tt][r] = bfhi(og_[tt][r]); } \
                _Pragma("unroll") for (int ks = 0; ks < 2; ++ks) acc = __builtin_amdgcn_mfma_f32_16x16x32_bf16(sa[ks], __builtin_bit_cast(bf16x8, qd_[2 * tt + ks]), acc, 0, 0, 0); \
                o[tt] = acc; } \
            _Pragma("unroll") for (int dt = 0; dt < 4; ++dt) { const unsigned lo = (unsigned)kv_[dt], hi = (unsigned)(kv_[dt] >> 32); \
                S[dt][0] = S[dt][0] * dc_[dt][0] + bflo(lo); S[dt][1] = S[dt][1] * dc_[dt][1] + bfhi(lo); S[dt][2] = S[dt][2] * dc_[dt][2] + bflo(hi); S[dt][3] = S[dt][3] * dc_[dt][3] + bfhi(hi); } \
            LAS float* const sq = ssqb + ((n_) & 1) * 512; \
            _Pragma("unroll") for (int tt = 0; tt < 4; ++tt) { float s2 = (o[tt][0] * o[tt][0] + o[tt][1] * o[tt][1]) + (o[tt][2] * o[tt][2] + o[tt][3] * o[tt][3]); s2 = add_x32(add_x16(s2)); if (g == 0) sq[wave * 64 + 16 * tt + fr] = s2; } \
            LDS_WAIT(); __syncthreads(); \
            { float tot = 0.f; \
              _Pragma("unroll") for (int w2 = 0; w2 < 8; ++w2) tot += sq[w2 * 64 + lane]; \
              rstdl[lane] = __builtin_amdgcn_rsqf(tot * (1.f / 128.f) + EPS); } \
            LDS_WAIT(); asm volatile("" ::: "memory"); \
            _Pragma("unroll") for (int tt = 0; tt < 4; ++tt) { \
                const float rs = rstdl[16 * tt + fr]; \
                const unsigned long long w = (unsigned long long)cvtpk(o[tt][0] * rs * gt[tt][0], o[tt][1] * rs * gt[tt][1]) | ((unsigned long long)cvtpk(o[tt][2] * rs * gt[tt][2], o[tt][3] * rs * gt[tt][3]) << 32); \
                *(GAS unsigned long long*)(mix + (size_t)(t0 + 16 * tt + fr) * D + h * 128 + 16 * wave + 4 * g) = w; } \
            LDS_WAIT(); asm volatile("" ::: "memory"); } while (0)
        GLA_LOAD(ogA, kvA, qdA, dcA, u0);
        for (int n = 0; n < 64; n += 2) {
            GLA_LOAD(ogB, kvB, qdB, dcB, u0 + n + 1);
            GLA_STEP(ogA, kvA, qdA, dcA, n);
            if (n + 2 < 64) GLA_LOAD(ogA, kvA, qdA, dcA, u0 + n + 2);
            GLA_STEP(ogB, kvB, qdB, dcB, n + 1);
        }
#undef GLA_LOAD
#undef GLA_STEP
        __syncthreads();
    }
    if (bx >= 32) {
        LANE_DECL;
        LAS float* scr = (LAS float*)(L + RING_OFF + wave * 16384);
        const int gwl = (bx - 32) * NWAVES + wave, NGWL = (G - 32) * NWAVES;
        constexpr int I_OUT = 16 * 32, I_PQ = 16 * 64, I_PG = 16 * 32;
        for (int it = gwl; it < I_OUT + I_PQ + I_PG; it += NGWL) {
            int r = it;
            if (r < I_OUT) { p0_transpose_item(w_out, 1024, 1024, 0, 1024, nullptr, Bt_out, 0, 32, scr, r, lane); continue; } r -= I_OUT;
            if (r < I_PQ) { p0_transpose_item(w_pq, 1024, 2048, 0, 2048, g_peer, Bt_pq, 0, 64, scr, r, lane); continue; } r -= I_PQ;
            p0_transpose_item(w_pg, 1024, 1024, 0, 1024, g_ple, Bt_pg, 0, 32, scr, r, lane);
        }
        for (int i = gwl * 64 + lane; i < 16384 * 16 * 2; i += NGWL * 64) {
            const int tab = i >> 18, row = (i >> 4) & 16383, li = i & 15;
            const float* src = (tab ? pv : pu) + (size_t)row * D;
            const float scl = tab ? 4.f : 64.f;
            unsigned dw[12];
#pragma unroll
            for (int q = 0; q < 12; ++q) dw[q] = 0u;
#pragma unroll
            for (int j = 0; j < 4; ++j)
#pragma unroll
                for (int e4 = 0; e4 < 4; ++e4) {
                    f32x4 v = ((const GAS f32x4*)(src + 256 * j + 16 * li))[e4];
                    if (!tab) v = v * ((const GAS f32x4*)(g_peer + 256 * j + 16 * li))[e4];
                    v = v * scl;
#pragma unroll
                    for (int e = 0; e < 4; ++e) {
                        const int k = (j & 1) * 16 + e4 * 4 + e, grp = j >> 1;
                        dw[grp * 4 + (k >> 3)] |= enc4(v[e]) << (4 * (k & 7));
                    }
                }
            { GAS v4u* dst = (GAS v4u*)((tab ? Vb : Ub) + (size_t)row * 512) + li;
                v4u o0, o1; o0.x = dw[0]; o0.y = dw[1]; o0.z = dw[2]; o0.w = dw[3]; o1.x = dw[4]; o1.y = dw[5]; o1.z = dw[6]; o1.w = dw[7];
                dst[0] = o0; dst[16] = o1; }
        }
        for (int i = gwl * 64 + lane; i < 16 * 128 * 128 / 4; i += NGWL * 64) {
            const f32x4 v = ((const GAS f32x4*)skeys)[i];
            ((GAS unsigned long long*)keysb)[i] = (unsigned long long)pk2(v.x, v.y) | ((unsigned long long)pk2(v.z, v.w) << 32);
        }
        __syncthreads();
    }
    for (int rep2_ = 0; rep2_ < REP_DSW; ++rep2_)
    {
        LANE_DECL;
        const int qc = lane & 31, hh = lane >> 5;
        constexpr int OROW = 136;
        LAS unsigned char* const Ob = L + RING_OFF;
        constexpr int KROW = 144;
        LAS unsigned char* const Kst = L + RING_OFF + 512 * OROW + wave * (2 * 32 * KROW);
        LAS unsigned char* const Vst = Kst + 32 * KROW;
        volatile LAS int* const ubox = (volatile LAS int*)(L + MISC_OFF + 64);
        const float C2 = 0.125f * 1.4426950408889634f;
        for (;;) {
            if (wave == 0 && lane == 0) ubox[0] = (int)__hip_atomic_fetch_add(ctl + CW_DSW + 64 * (rep_ * 4 + rep2_), 1u, __ATOMIC_RELAXED, __HIP_MEMORY_SCOPE_AGENT);
            __syncthreads();
            const int unit = __builtin_amdgcn_readfirstlane(ubox[0]);
            if (unit >= 512) break;
            const int sp = unit & 7, h = (unit >> 3) & 7, b = unit >> 6;
            const int s0 = sp * 512;
            const bf16* const base = proj + (size_t)b * SEQ * INC;
#pragma unroll 1
            for (int pt = 0; pt < 3; ++pt) {
                const int dl = (pt == 0) ? 0 : ((pt == 1) ? 2 : 4), d = 1 << dl;
#pragma unroll 1
                for (int rep = 0; rep < 2; ++rep) {
                    const int qt = wave + 8 * rep;
                    const int rr = qt & (d - 1), jj = qt >> dl;
                    const int tq0 = s0 + rr + ((32 * jj) << dl);
                    const int tkb = tq0 - (128 << dl);
                    int kkmin = 0;
                    if (tkb < 0) kkmin = (-tkb + d - 1) >> dl;
                    bf16x8 qf[4];
#pragma unroll
                    for (int ks = 0; ks < 4; ++ks) qf[ks] = *(const GAS bf16x8*)(base + (size_t)(tq0 + (qc << dl)) * INC + OFF_QB + h * 64 + 16 * ks + 8 * hh);
                    f32x16 O0, O1;
#pragma unroll
                    for (int r = 0; r < 16; ++r) { O0[r] = 0.f; O1[r] = 0.f; }
                    float m = -INFINITY, l = 0.f;
                    const int cmin = kkmin >> 5;
                    v4u kA[4], vA[4], kB[4], vB[4];
#define DSW_LOAD(kr_, vr_, c_) do { const int k0_ = 32 * (c_); \
                        _Pragma("unroll") for (int it = 0; it < 4; ++it) { const int pc = lane + 64 * it, key = pc >> 3, ch = pc & 7; int tk = tkb + ((k0_ + key) << dl); tk = tk < 0 ? 0 : (tk > SEQ - 1 ? SEQ - 1 : tk); \
                            const bf16* rp = base + (size_t)tk * INC + h * 64 + 8 * ch; kr_[it] = *(const GAS v4u*)(rp + OFF_KB); vr_[it] = *(const GAS v4u*)(rp + OFF_VB); } } while (0)
#define DSW_STEP(kr_, vr_, c_) do { const int k0 = 32 * (c_); \
                        _Pragma("unroll") for (int it = 0; it < 4; ++it) { const int pc = lane + 64 * it, key = pc >> 3, ch = pc & 7; *(LAS v4u*)(Kst + key * KROW + ch * 16) = kr_[it]; *(LAS v4u*)(Vst + key * KROW + ch * 16) = vr_[it]; } \
                        LDS_WAIT(); asm volatile("" ::: "memory"); \
                        f32x16 sc; \
                        _Pragma("unroll") for (int r = 0; r < 16; ++r) sc[r] = 0.f; \
                        _Pragma("unroll") for (int ks = 0; ks < 4; ++ks) { const bf16x8 ka = *(const LAS bf16x8*)(Kst + qc * KROW + (16 * ks + 8 * hh) * 2);     \
                            sc = __builtin_amdgcn_mfma_f32_32x32x16_bf16(ka, qf[ks], sc, 0, 0, 0); } \
                        const bool edge = ((c_) == 0) | ((c_) == 4) | (k0 < kkmin);     \
                        float cmax = -INFINITY; \
                        _Pragma("unroll") for (int r = 0; r < 16; ++r) { float v = sc[r] * C2; \
                            if (edge) { const int kk = k0 + (r & 3) + 8 * (r >> 2) + 4 * hh; const bool ok = (kk >= qc) & (kk <= qc + 128) & (kk >= kkmin); v = ok ? v : -INFINITY; } \
                            sc[r] = v; cmax = fmaxf(cmax, v); } \
                        cmax = max_x32(cmax); \
                        const float mn = fmaxf(m, cmax);                    \
                        const float alpha = __builtin_amdgcn_exp2f(m - mn); \
                        float ps = 0.f; \
                        _Pragma("unroll") for (int r = 0; r < 16; ++r) { sc[r] = __builtin_amdgcn_exp2f(sc[r] - mn); ps += sc[r]; } \
                        l = l * alpha + ps; m = mn; \
                        bf16x8 pf[2];                                       \
                        _Pragma("unroll") for (int sx = 0; sx < 2; ++sx) { v4u w; w.x = cvtpk(sc[8 * sx], sc[8 * sx + 1]); w.y = cvtpk(sc[8 * sx + 2], sc[8 * sx + 3]); w.z = cvtpk(sc[8 * sx + 4], sc[8 * sx + 5]); w.w = cvtpk(sc[8 * sx + 6], sc[8 * sx + 7]); pf[sx] = __builtin_bit_cast(bf16x8, w); } \
                        _Pragma("unroll") for (int r = 0; r < 16; ++r) { O0[r] *= alpha; O1[r] *= alpha; } \
                        _Pragma("unroll") for (int sx = 0; sx < 2; ++sx) { \
                            const int vrow = 16 * sx + 4 * hh + ((lane & 15) >> 2), vcol = 16 * ((lane >> 4) & 1) + 4 * (lane & 3); \
                            const s16x4 a0 = __builtin_amdgcn_ds_read_tr16_b64_v4i16((LAS s16x4*)(Vst + vrow * KROW + vcol * 2)); \
                            const s16x4 a1 = __builtin_amdgcn_ds_read_tr16_b64_v4i16((LAS s16x4*)(Vst + (vrow + 8) * KROW + vcol * 2)); \
                            const s16x4 c0 = __builtin_amdgcn_ds_read_tr16_b64_v4i16((LAS s16x4*)(Vst + vrow * KROW + (32 + vcol) * 2)); \
                            const s16x4 c1 = __builtin_amdgcn_ds_read_tr16_b64_v4i16((LAS s16x4*)(Vst + (vrow + 8) * KROW + (32 + vcol) * 2)); \
                            bf16x8 va, vc; va[0] = a0[0]; va[1] = a0[1]; va[2] = a0[2]; va[3] = a0[3]; va[4] = a1[0]; va[5] = a1[1]; va[6] = a1[2]; va[7] = a1[3]; \
                            vc[0] = c0[0]; vc[1] = c0[1]; vc[2] = c0[2]; vc[3] = c0[3]; vc[4] = c1[0]; vc[5] = c1[1]; vc[6] = c1[2]; vc[7] = c1[3]; \
                            O0 = __builtin_amdgcn_mfma_f32_32x32x16_bf16(va, pf[sx], O0, 0, 0, 0); \
                            O1 = __builtin_amdgcn_mfma_f32_32x32x16_bf16(vc, pf[sx], O1, 0, 0, 0); } \
                        LDS_WAIT(); asm volatile("" ::: "memory");         \
                    } while (0)
                    DSW_LOAD(kA, vA, 4);
                    if (3 >= cmin) DSW_LOAD(kB, vB, 3);
                    DSW_STEP(kA, vA, 4);
                    if (3 >= cmin) {
                        if (2 >= cmin) DSW_LOAD(kA, vA, 2);
                        DSW_STEP(kB, vB, 3);
                        if (2 >= cmin) {
                            if (1 >= cmin) DSW_LOAD(kB, vB, 1);
                            DSW_STEP(kA, vA, 2);
                            if (1 >= cmin) {
                                if (0 >= cmin) DSW_LOAD(kA, vA, 0);
                                DSW_STEP(kB, vB, 1);
                                if (0 >= cmin) DSW_STEP(kA, vA, 0);
                            }
                        }
                    }
#undef DSW_LOAD
#undef DSW_STEP
                    l = add_x32(l);
                    const int row = (tq0 - s0) + (qc << dl);
                    LAS unsigned char* orow = Ob + row * OROW;
                    if (pt > 0) {
                        const float m1 = *(const LAS float*)(orow + 128), l1 = *(const LAS float*)(orow + 132);
                        const float mn = fmaxf(m, m1), a0 = __builtin_amdgcn_exp2f(m - mn), a1 = __builtin_amdgcn_exp2f(m1 - mn);
#pragma unroll
                        for (int rq = 0; rq < 4; ++rq) {
                            const unsigned long long w0 = *(const LAS unsigned long long*)(orow + (8 * rq + 4 * hh) * 2), w1 = *(const LAS unsigned long long*)(orow + (32 + 8 * rq + 4 * hh) * 2);
                            O0[4 * rq] = O0[4 * rq] * a0 + bflo((unsigned)w0) * a1; O0[4 * rq + 1] = O0[4 * rq + 1] * a0 + bfhi((unsigned)w0) * a1;
                            O0[4 * rq + 2] = O0[4 * rq + 2] * a0 + bflo((unsigned)(w0 >> 32)) * a1; O0[4 * rq + 3] = O0[4 * rq + 3] * a0 + bfhi((unsigned)(w0 >> 32)) * a1;
                            O1[4 * rq] = O1[4 * rq] * a0 + bflo((unsigned)w1) * a1; O1[4 * rq + 1] = O1[4 * rq + 1] * a0 + bfhi((unsigned)w1) * a1;
                            O1[4 * rq + 2] = O1[4 * rq + 2] * a0 + bflo((unsigned)(w1 >> 32)) * a1; O1[4 * rq + 3] = O1[4 * rq + 3] * a0 + bfhi((unsigned)(w1 >> 32)) * a1;
                        }
                        l = l * a0 + l1 * a1; m = mn;
                    }
                    if (pt < 2) {
#pragma unroll
                        for (int rq = 0; rq < 4; ++rq) {
                            *(LAS unsigned long long*)(orow + (8 * rq + 4 * hh) * 2) = (unsigned long long)cvtpk(O0[4 * rq], O0[4 * rq + 1]) | ((unsigned long long)cvtpk(O0[4 * rq + 2], O0[4 * rq + 3]) << 32);
                            *(LAS unsigned long long*)(orow + (32 + 8 * rq + 4 * hh) * 2) = (unsigned long long)cvtpk(O1[4 * rq], O1[4 * rq + 1]) | ((unsigned long long)cvtpk(O1[4 * rq + 2], O1[4 * rq + 3]) << 32);
                        }
                        if (hh == 0) { *(LAS float*)(orow + 128) = m; *(LAS float*)(orow + 132) = l; }
                    } else {
                        const float rl = 1.f / l;
                        bf16* op = mix + (size_t)(b * SEQ + s0 + row) * D + 512 + h * 64;
#pragma unroll
                        for (int rq = 0; rq < 4; ++rq) {
                            *(GAS unsigned long long*)(op + 8 * rq + 4 * hh) = (unsigned long long)cvtpk(O0[4 * rq] * rl, O0[4 * rq + 1] * rl) | ((unsigned long long)cvtpk(O0[4 * rq + 2] * rl, O0[4 * rq + 3] * rl) << 32);
                            *(GAS unsigned long long*)(op + 32 + 8 * rq + 4 * hh) = (unsigned long long)cvtpk(O1[4 * rq] * rl, O1[4 * rq + 1] * rl) | ((unsigned long long)cvtpk(O1[4 * rq + 2] * rl, O1[4 * rq + 3] * rl) << 32);
                        }
                    }
                }
                LDS_WAIT(); __syncthreads();
            }
        }
    }
    }
    { LANE_DECL; xcd_barrier(bar, wave == 0 && lane == 0); }

    for (int rep_ = 0; rep_ < REP_P3; ++rep_) {
        pg8::Gemm g{mix, Bt_out, T, D, D}; pg8::StaticOrder S; S.init(T, D, G, bx);
        pg8::EpiOutProj E{xin, x1b, ssq1};
        pg8::gemm_phase<pg8::EpiOutProj, pg8::StaticOrder, true, true>(L + RING_OFF, g, S, E, wave);
    }
    { LANE_DECL; xcd_barrier(bar, wave == 0 && lane == 0); }

    for (int rep_ = 0; rep_ < REP_P4; ++rep_) {
        pg8::Gemm g{x1b, Bt_pq, T, 2048, D}; pg8::StaticOrder S; S.init(T, 2048, G, bx);
        pg8::EpiPeerQ E{qr, ssq1};
        pg8::gemm_phase<pg8::EpiPeerQ, pg8::StaticOrder, true, true>(L + RING_OFF, g, S, E, wave);
    }
    { LANE_DECL; xcd_barrier(bar, wave == 0 && lane == 0); }

    for (int rep_ = 0; rep_ < REP_P5; ++rep_) {
        LANE_DECL;
        const int fr = lane & 15, g = lane >> 4;
        constexpr int KROW = 272;
        const int h = bx & 7, nbh = G >> 3;
        {
            const GAS v4u* src = (const GAS v4u*)(keysb + (size_t)h * 2 * 128 * 128);
            for (int pc = wave * 64 + lane; pc < 4096; pc += NWAVES * 64) { const int R = pc >> 4, ch = pc & 15; *(LAS v4u*)(L + RING_OFF + R * KROW + ch * 16) = src[pc]; }
        }
        LAS int* const scr = (LAS int*)(L + RING_OFF + 256 * KROW + wave * (16 * 33 * 4));
        __syncthreads();
        for (int tg = (bx >> 3) * NWAVES + wave; tg < T / 16; tg += nbh * NWAVES) {
            const int tok0 = tg * 16;
            int top[2][16];
#pragma unroll
            for (int c = 0; c < 2; ++c) {
                bf16x8 bq[4];
#pragma unroll
                for (int ks = 0; ks < 4; ++ks) bq[ks] = *(const GAS bf16x8*)(qr + (size_t)(tok0 + fr) * 2048 + h * 256 + c * 128 + 32 * ks + 8 * g);
                int v[32];
#pragma unroll
                for (int tl = 0; tl < 8; ++tl) {
                    f32x4 acc = {0.f, 0.f, 0.f, 0.f};
#pragma unroll
                    for (int ks = 0; ks < 4; ++ks) { const bf16x8 a = *(const LAS bf16x8*)(L + RING_OFF + (c * 128 + 16 * tl + fr) * KROW + (32 * ks + 8 * g) * 2);
                        acc = __builtin_amdgcn_mfma_f32_16x16x32_bf16(a, bq[ks], acc, 0, 0, 0); }
#pragma unroll
                    for (int r = 0; r < 4; ++r) v[4 * tl + r] = (f2key(acc[r]) & ~0x7f) | (16 * tl + 4 * g + r);
                }
                bitonic_sort_desc<32>(v);
#pragma unroll
                for (int i = 0; i < 16; ++i) top[c][i] = v[i];
                merge_top16(top[c], lane ^ 16);
                merge_top16(top[c], lane ^ 32);
            }
            float fa[16], fb[16];
#pragma unroll
            for (int i = 0; i < 16; ++i) { fa[i] = key2f(top[0][i]); fb[i] = key2f(top[1][i]); }
            int cand[16];
#pragma unroll
            for (int sl = 0; sl < 16; ++sl) {
                int cv[4];
#pragma unroll
                for (int gg = 0; gg < 4; ++gg) { constexpr int NEG = (int)0x80000000;
                    const int n = 16 * gg + sl;
                    if (kCand.i[n] >= 0) cv[gg] = (f2key(fa[kCand.i[n] < 0 ? 0 : kCand.i[n]] + fb[kCand.j[n] < 0 ? 0 : kCand.j[n]]) & ~0xff) | (kCand.i[n] * 16 + kCand.j[n]); else cv[gg] = NEG; }
                cand[sl] = (g == 0) ? cv[0] : ((g == 1) ? cv[1] : ((g == 2) ? cv[2] : cv[3]));
            }
            bitonic_sort_desc<16>(cand);
            merge_top16(cand, lane ^ 16);
            merge_top16(cand, lane ^ 32);
#pragma unroll
            for (int i = 0; i < 16; ++i) { if (g == (i >> 3)) scr[fr * 33 + i] = top[0][i] & 0x7f; if (g == 2 + (i >> 3)) scr[fr * 33 + 16 + i] = top[1][i] & 0x7f; }
            float ex[16]; float den = 0.f; const float m0 = key2f(cand[0]);
#pragma unroll
            for (int r = 0; r < 16; ++r) { ex[r] = __expf(key2f(cand[r]) - m0); den += ex[r]; }
            const float rden = 1.f / den;
            LDS_WAIT(); asm volatile("" ::: "memory");
            int oi[4]; float og[4];
#pragma unroll
            for (int q = 0; q < 4; ++q) {
                const int kq = (g == 0) ? cand[q] : ((g == 1) ? cand[4 + q] : ((g == 2) ? cand[8 + q] : cand[12 + q]));
                const float eq = (g == 0) ? ex[q] : ((g == 1) ? ex[4 + q] : ((g == 2) ? ex[8 + q] : ex[12 + q]));
                const int code = kq & 0xff;
                oi[q] = scr[fr * 33 + (code >> 4)] * 128 + scr[fr * 33 + 16 + (code & 15)]; og[q] = eq * rden;
            }
            GAS v4u* op = (GAS v4u*)(sel2 + (size_t)(tok0 + fr) * 128 + h * 16 + 4 * g);
            v4u o0, o1; o0.x = (unsigned)oi[0]; o0.y = __float_as_uint(og[0]); o0.z = (unsigned)oi[1]; o0.w = __float_as_uint(og[1]);
            o1.x = (unsigned)oi[2]; o1.y = __float_as_uint(og[2]); o1.z = (unsigned)oi[3]; o1.w = __float_as_uint(og[3]);
            op[0] = o0; op[1] = o1;
            LDS_WAIT(); asm volatile("" ::: "memory");
        }
        __syncthreads();
    }
    { LANE_DECL; xcd_barrier(bar, wave == 0 && lane == 0); }

    for (int rep_ = 0; rep_ < REP_P6; ++rep_) {
        LANE_DECL;
        const int g4 = lane >> 4, li = lane & 15;
        LAS i32x2* const selw = (LAS i32x2*)(L + RING_OFF + wave * 1024);
        for (int tok = gw; tok < T; tok += NGW) {
            const float s1 = (lane < 16) ? ssq1[(size_t)lane * T + tok] : 0.f;
            const float rstd1 = rsqrtf(wave_sum(s1) * (1.f / D) + EPS);
            v4u xw[8];
#pragma unroll
            for (int j = 0; j < 4; ++j) { xw[2 * j] = ((const GAS v4u*)(x1b + (size_t)tok * D))[32 * j + 2 * li]; xw[2 * j + 1] = ((const GAS v4u*)(x1b + (size_t)tok * D))[32 * j + 2 * li + 1]; }
            float acc[64];
#pragma unroll
            for (int k = 0; k < 64; ++k) acc[k] = 0.f;
            {
                const GAS i32x2* selg = (const GAS i32x2*)sel2 + (size_t)tok * 128;
                const i32x2 p0 = selg[lane], p1 = selg[lane + 64];
                const int b0 = p0.x >> 11, b1 = p1.x >> 11;
                const unsigned long long lt = (1ull << lane) - 1ull;
                int base = 0, r0 = 0, r1 = 0;
#pragma unroll
                for (int bk = 0; bk < 8; ++bk) {
                    const unsigned long long m0 = __ballot(b0 == bk), m1 = __ballot(b1 == bk);
                    const int c0 = __popcll(m0), c1 = __popcll(m1);
                    if (b0 == bk) r0 = base + __popcll(m0 & lt);
                    if (b1 == bk) r1 = base + c0 + __popcll(m1 & lt);
                    base += c0 + c1;
                }
                selw[r0] = p0; selw[r1] = p1;
                LDS_WAIT(); asm volatile("" ::: "memory");
            }
            const float ascale = rstd1 * (1.f / 64.f);
            i32x2 cur = selw[g4];
            for (int it = 0; it < 32; ++it) {
                const i32x2 nxt = selw[((it < 31) ? 4 * (it + 1) : 0) + g4];
                const GAS v4u* up = (const GAS v4u*)(Ub + (size_t)cur.x * 512) + li;
                const GAS v4u* vp = (const GAS v4u*)(Vb + (size_t)cur.x * 512) + li;
                const v4u u0 = up[0], u1 = up[16], v0 = vp[0], v1 = vp[16];
                float s = 0.f;
#define PG_U4(bsel) { const unsigned da = __builtin_bit_cast(unsigned, __builtin_amdgcn_cvt_scalef32_pk_bf16_fp4(u0[w], 1.0f, bsel)), db = __builtin_bit_cast(unsigned, __builtin_amdgcn_cvt_scalef32_pk_bf16_fp4(u1[w], 1.0f, bsel)); \
                        s = dot2bf(xw[w][bsel], da, s); s = dot2bf(xw[4 + w][bsel], db, s); }
#pragma unroll
                for (int w = 0; w < 4; ++w) { PG_U4(0) PG_U4(1) PG_U4(2) PG_U4(3) }
#undef PG_U4
                s = row_sum16(s);
                const float a = s * ascale;
                const float act = 0.5f * a * (1.f + erff(a * 0.70710678118654752f)) * __int_as_float(cur.y) * 0.25f;
#define PG_V4(bsel) { const f32x2 fa = __builtin_amdgcn_cvt_scalef32_pk_f32_fp4(v0[w], 1.0f, bsel), fb = __builtin_amdgcn_cvt_scalef32_pk_f32_fp4(v1[w], 1.0f, bsel); \
                        acc[8 * w + 2 * bsel] += act * fa.x; acc[8 * w + 2 * bsel + 1] += act * fa.y; acc[32 + 8 * w + 2 * bsel] += act * fb.x; acc[32 + 8 * w + 2 * bsel + 1] += act * fb.y; }
#pragma unroll
                for (int w = 0; w < 4; ++w) { PG_V4(0) PG_V4(1) PG_V4(2) PG_V4(3) }
#undef PG_V4
                cur = nxt;
            }
            float s2 = 0.f;
#pragma unroll
            for (int j = 0; j < 4; ++j) {
                float r[16];
#pragma unroll
                for (int e = 0; e < 16; ++e) { float v = acc[16 * j + e]; v += xshfl(v, lane ^ 16); v += xshfl(v, lane ^ 32);
                    const unsigned xwd = xw[2 * j + (e >> 3)][(e >> 1) & 3]; r[e] = v + ((e & 1) ? bfhi(xwd) : bflo(xwd)); s2 += r[e] * r[e]; }
                if (g4 == j) { v4u o0, o1; o0.x = pk2(r[0], r[1]); o0.y = pk2(r[2], r[3]); o0.z = pk2(r[4], r[5]); o0.w = pk2(r[6], r[7]); o1.x = pk2(r[8], r[9]); o1.y = pk2(r[10], r[11]); o1.z = pk2(r[12], r[13]); o1.w = pk2(r[14], r[15]);
                    ((GAS v4u*)(x2b + (size_t)tok * D))[32 * j + 2 * li] = o0; ((GAS v4u*)(x2b + (size_t)tok * D))[32 * j + 2 * li + 1] = o1; }
            }
            s2 = row_sum16(s2);
            if (lane == 0) rstd2[tok] = rsqrtf(s2 * (1.f / D) + EPS);
            LDS_WAIT(); asm volatile("" ::: "memory");
        }
    }
    { LANE_DECL; xcd_barrier(bar, wave == 0 && lane == 0); }

    for (int rep_ = 0; rep_ < REP_P7; ++rep_) {
        pg8::Gemm g{x2b, Bt_pg, T, D, D}; pg8::StaticOrder S; S.init(T, D, G, bx);
        pg8::EpiPle E{x2b, pproj, rstd2, x1b};
        pg8::gemm_phase<pg8::EpiPle, pg8::StaticOrder, true, true>(L + RING_OFF, g, S, E, wave);
    }
    { LANE_DECL; xcd_barrier(bar, wave == 0 && lane == 0); }

    {
    LANE_DECL;
    for (int row = gw; row < T; row += NGW) {
        const GAS v4u* xr = (const GAS v4u*)(x1b + (size_t)row * D);
        const v4u a = xr[lane], c = xr[64 + lane];
        float v[16];
        v[0] = bflo(a.x); v[1] = bfhi(a.x); v[2] = bflo(a.y); v[3] = bfhi(a.y); v[4] = bflo(a.z); v[5] = bfhi(a.z); v[6] = bflo(a.w); v[7] = bfhi(a.w);
        v[8] = bflo(c.x); v[9] = bfhi(c.x); v[10] = bflo(c.y); v[11] = bfhi(c.y); v[12] = bflo(c.z); v[13] = bfhi(c.z); v[14] = bflo(c.w); v[15] = bfhi(c.w);
        float s = 0.f;
#pragma unroll
        for (int k = 0; k < 16; ++k) s += v[k] * v[k];
        const float rstd = rsqrtf(wave_sum(s) * (1.f / D) + EPS);
        GAS f32x4* orow = (GAS f32x4*)(out + (size_t)row * D);
#pragma unroll
        for (int q = 0; q < 4; ++q) {
            const int e0 = (q < 2) ? (8 * lane + 4 * q) : (512 + 8 * lane + 4 * (q - 2));
            const f32x4 gg = *(const GAS f32x4*)(g_final + e0);
            f32x4 o; o.x = v[4 * q] * rstd * gg.x; o.y = v[4 * q + 1] * rstd * gg.y; o.z = v[4 * q + 2] * rstd * gg.z; o.w = v[4 * q + 3] * rstd * gg.w;
            orow[e0 >> 2] = o;
        }
    }
    }
}

#undef xin
#undef p_in
#undef positions
#undef g_mix
#undef w_in
#undef w_up
#undef b_gate
#undef g_gla
#undef w_out
#undef g_peer
#undef w_pq
#undef skeys
#undef pu
#undef pv
#undef g_ple
#undef w_pg
#undef w_pp
#undef g_final
#undef out
#undef Bt_in
#undef Bt_out
#undef Bt_pq
#undef Bt_pg
#undef Bt_pp
#undef rope
#undef ssq1
#undef rstd2
#undef h1
#undef x1b
#undef proj
#undef qr
#undef sel2
#undef Ub
#undef Vb
#undef keysb
#undef mix
#undef pb
#undef pproj
#undef x2b
extern "C" void kernel_launch(void* const* d_in, const int* in_sizes, int n_in, void* d_out, int out_size, void* d_ws, size_t ws_size, hipStream_t stream) {
    static int grid = 0;
    if (grid == 0) {
        if (n_in != 18 || out_size != T * D || ws_size < WS_END) { fprintf(stderr, "kernel_launch: unexpected shapes n_in %d out %d ws %zu\n", n_in, out_size, ws_size); grid = -1; return; }
        int dev = 0, cus = 0, per_cu = 0;
        if (hipGetDevice(&dev) != hipSuccess || hipDeviceGetAttribute(&cus, hipDeviceAttributeMultiprocessorCount, dev) != hipSuccess) { grid = -1; return; }
        if (hipFuncSetAttribute((const void*)mk_fwd, hipFuncAttributeMaxDynamicSharedMemorySize, LDS_BYTES) != hipSuccess) { fprintf(stderr, "kernel_launch: hipFuncSetAttribute failed\n"); grid = -1; return; }
        if (hipOccupancyMaxActiveBlocksPerMultiprocessor(&per_cu, (const void*)mk_fwd, NWAVES * 64, LDS_BYTES) != hipSuccess || per_cu < 1) fprintf(stderr, "kernel_launch: occupancy query reports %d\n", per_cu);
        (void)hipGetLastError();
        grid = cus;
    }
    if (grid < 0) return;
    if (hipMemsetAsync((char*)d_ws + WS_CTL, 0, CTL_ZERO_BYTES, stream) != hipSuccess) return;
    Args a{};
    for (int i = 0; i < 18; ++i) a.in[i] = (const float*)d_in[i];
    a.outp = (float*)d_out; a.ws = (unsigned char*)d_ws;
    hipLaunchKernelGGL(mk_fwd, dim3(grid), dim3(NWAVES * 64), LDS_BYTES, stream, a);
}
```

```cpp
#include <hip/hip_runtime.h>
#include <cstdio>
#include <cstdint>
namespace pg8 {
#define PG8_LAS __attribute__((address_space(3)))
typedef unsigned short bf16_t;
typedef short bf16x8 __attribute__((ext_vector_type(8)));
typedef float f32x4 __attribute__((ext_vector_type(4)));
typedef unsigned u32x4 __attribute__((ext_vector_type(4)));
constexpr int BM = 256, BK = 64, HALF = 128, HTB = HALF * BK * 2  , STAGE_BYTES = 8 * HTB, NXCD = 8, WGM = 8;

__host__ __device__ __forceinline__ int lds_byte(int r, int c) { const int st = (r >> 4) * 2 + (c >> 5), rr = r & 15, cc = c & 31, ob = rr * 64 + cc * 2; return st * 1024 + (ob ^ (((ob >> 9) & 1) << 5)); }
__host__ __device__ __forceinline__ void stage_rc(int b, int& R, int& C) { const int st = b / 1024, sb = b % 1024, swz = sb ^ (((sb >> 9) & 1) << 5); R = (st >> 1) * 16 + swz / 64; C = (st & 1) * 32 + (swz % 64) / 2; }
__host__ __device__ __forceinline__ int perm32(int rho) { const int n = rho >> 4, i = rho & 15; return 8 * (i >> 2) + 4 * n + (i & 3); }

struct Unit { int pm, pn; };
struct Gemm { const bf16_t* A; const bf16_t* Bt; int M, N, K; };

struct StaticOrder {
    int nM, nN, nwg, G, c;
    __host__ __device__ void init(int M, int N, int G_, int c_) { nM = M / BM; nN = N / BM; nwg = nM * nN; G = G_; c = c_; }
    __host__ __device__ bool next(int i, Unit& u) const {
        const long L = (long)i * G + c; if (L >= nwg) return false;
        int wgid = (int)L; { const int q = nwg / NXCD, r = nwg % NXCD, xcd = wgid % NXCD, off = wgid / NXCD; wgid = (xcd < r ? xcd * (q + 1) : r * (q + 1) + (xcd - r) * q) + off; }
        const int nig = WGM * nN, gid = wgid / nig, fm = gid * WGM, gsz = (nM - fm) < WGM ? (nM - fm) : WGM;
        u.pm = fm + ((wgid % nig) % gsz); u.pn = (wgid % nig) / gsz; return true;
    }
    __device__ __forceinline__ void a_ready(const Unit&) const {}
    __device__ __forceinline__ void done(const Unit&) const {}
};

__device__ __forceinline__ unsigned cvt_pk_bf16(float lo, float hi) { unsigned r; asm volatile("v_cvt_pk_bf16_f32 %0, %1, %2" : "=v"(r) : "v"(lo), "v"(hi)); return r; }
typedef float f32x2 __attribute__((ext_vector_type(2)));
__device__ __forceinline__ f32x2 gelu_pk(f32x2 v) {
    const f32x2 av = __builtin_elementwise_abs(v), d = av * 0.2316418882f + 1.0f;
    f32x2 t; t.x = __builtin_amdgcn_rcpf(d.x); t.y = __builtin_amdgcn_rcpf(d.y);
    f32x2 q = t * 0.5307027145f + (-0.7265760135f); q = q * t + 0.7107068705f; q = q * t + (-0.142248368f); q = q * t + 0.127414796f; q = q * t;
    const f32x2 s = (v * v) * (-0.72134752044f);
    f32x2 e; e.x = __builtin_amdgcn_exp2f(s.x); e.y = __builtin_amdgcn_exp2f(s.y);
    const f32x2 m = v * (q * e), r = v - m;
    f32x2 o; o.x = v.x < 0.f ? m.x : r.x; o.y = v.y < 0.f ? m.y : r.y; return o;
}

template <int ACT  > struct EpiBf16 {
    static constexpr bool PERM = true, AFTER_DRAIN = false; static_assert(ACT == 0 || ACT == 1, "EpiBf16: ACT is 0 (none) or 1 (gelu_pk)");
    bf16_t* O; int ldc; const float* bias; int split_cols; size_t split_stride; float scale0;
    __device__ __forceinline__ void operator()(const f32x4 (&acc)[2][2][4][2], const Unit& u, int wr, int wc, int fr, int fq) const {
        const int row0 = u.pm * BM + wr * 64 + fr; int colt = u.pn * BM; bf16_t* base = O;
        float sc = 1.f; if (split_cols) { const int t = colt / split_cols; base += (size_t)t * split_stride; colt -= t * split_cols; if (t == 0) sc = scale0; }
        const int col0 = colt + wc * 32 + 8 * fq, bcol0 = u.pn * BM + wc * 32 + 8 * fq;
        f32x4 bv[2][2];
#pragma unroll
        for (int bj = 0; bj < 2; ++bj)
#pragma unroll
            for (int n = 0; n < 2; ++n) bv[bj][n] = bias ? *(const f32x4*)(bias + bcol0 + bj * HALF + 4 * n) : (f32x4){0.f, 0.f, 0.f, 0.f};
#pragma unroll
        for (int ai = 0; ai < 2; ++ai)
#pragma unroll
            for (int m = 0; m < 4; ++m) { bf16_t* rowp = base + (size_t)(row0 + ai * HALF + m * 16) * ldc + col0;
#pragma unroll
                for (int bj = 0; bj < 2; ++bj) { f32x4 v0 = acc[ai][bj][m][0] + bv[bj][0], v1 = acc[ai][bj][m][1] + bv[bj][1];
                    if (ACT == 1) { f32x2 a = gelu_pk((f32x2){v0[0], v0[1]}), b = gelu_pk((f32x2){v0[2], v0[3]}), c = gelu_pk((f32x2){v1[0], v1[1]}), d = gelu_pk((f32x2){v1[2], v1[3]});
                        v0 = (f32x4){a.x, a.y, b.x, b.y}; v1 = (f32x4){c.x, c.y, d.x, d.y}; }
                    v0 = v0 * sc; v1 = v1 * sc; u32x4 w; w.x = cvt_pk_bf16(v0[0], v0[1]); w.y = cvt_pk_bf16(v0[2], v0[3]); w.z = cvt_pk_bf16(v1[0], v1[1]); w.w = cvt_pk_bf16(v1[2], v1[3]);
                    *(u32x4*)(rowp + bj * HALF) = w; } }
    }
};

__device__ __forceinline__ float xshfl(float v, int srclane) { return __int_as_float(__builtin_amdgcn_ds_bpermute(srclane << 2, __float_as_int(v))); }
constexpr int P_INC = 3328;
struct EpiInProj {
    static constexpr bool PERM = true, AFTER_DRAIN = false;
    bf16_t* O; const float* rope; const float* bgate;
    __device__ __forceinline__ void operator()(const f32x4 (&acc)[2][2][4][2], const Unit& u, int wr, int wc, int fr, int fq) const {
        const int row0 = u.pm * BM + wr * 64 + fr;
#pragma unroll
        for (int bj = 0; bj < 2; ++bj) {
            const int cb = u.pn * BM + bj * HALF + wc * 32;
            const int c0 = cb + 8 * fq;
            const bool ropechunk = (cb >= 1792) && (cb < 2816) && ((cb & 63) == 0);
            const bool lachunk = (cb >= 1536) && (cb < 1792);
            f32x4 bg0 = {0.f, 0.f, 0.f, 0.f}, bg1 = {0.f, 0.f, 0.f, 0.f};
            if (lachunk) { bg0 = *(const f32x4*)(bgate + c0 - 1536); bg1 = *(const f32x4*)(bgate + c0 - 1536 + 4); }
#pragma unroll
            for (int ai = 0; ai < 2; ++ai)
#pragma unroll
                for (int m = 0; m < 4; ++m) {
                    const int row = row0 + ai * HALF + m * 16;
                    f32x4 v0 = acc[ai][bj][m][0], v1 = acc[ai][bj][m][1];
                    if (lachunk) {
#pragma unroll
                        for (int e = 0; e < 4; ++e) { const float z0 = v0[e] + bg0[e], z1 = v1[e] + bg1[e];
                            v0[e] = (fminf(z0, 0.f) - __logf(1.f + __expf(-fabsf(z0)))) * (1.f / 16.f); v1[e] = (fminf(z1, 0.f) - __logf(1.f + __expf(-fabsf(z1)))) * (1.f / 16.f); }
                    }
                    if (ropechunk) {
                        f32x4 p0, p1;
#pragma unroll
                        for (int e = 0; e < 4; ++e) { p0[e] = xshfl(v0[e], (fq * 16 + fr) ^ 16); p1[e] = xshfl(v1[e], (fq * 16 + fr) ^ 16); }
                        if (fq < 2) {
                            const f32x4* cs = (const f32x4*)(rope + (size_t)row * 16);
                            const f32x4 t0 = cs[0], t1 = cs[1], t2 = cs[2], t3 = cs[3];
                            const float sg = (fq == 0) ? -1.f : 1.f;
                            v0[0] = v0[0] * t0[0] + sg * p0[0] * t0[1]; v0[1] = v0[1] * t0[2] + sg * p0[1] * t0[3];
                            v0[2] = v0[2] * t1[0] + sg * p0[2] * t1[1]; v0[3] = v0[3] * t1[2] + sg * p0[3] * t1[3];
                            v1[0] = v1[0] * t2[0] + sg * p1[0] * t2[1]; v1[1] = v1[1] * t2[2] + sg * p1[1] * t2[3];
                            v1[2] = v1[2] * t3[0] + sg * p1[2] * t3[1]; v1[3] = v1[3] * t3[2] + sg * p1[3] * t3[3];
                        }
                    }
                    { u32x4 w; w.x = cvt_pk_bf16(v0[0], v0[1]); w.y = cvt_pk_bf16(v0[2], v0[3]); w.z = cvt_pk_bf16(v1[0], v1[1]); w.w = cvt_pk_bf16(v1[2], v1[3]);
                        *(u32x4*)(O + (size_t)row * P_INC + c0) = w; }
                }
        }
    }
};
struct EpiOutProj {
    static constexpr bool PERM = true, AFTER_DRAIN = false;
    const float* X; bf16_t* O; float* ssq;
    __device__ __forceinline__ void operator()(const f32x4 (&acc)[2][2][4][2], const Unit& u, int wr, int wc, int fr, int fq) const {
        const int row0 = u.pm * BM + wr * 64 + fr, col0 = u.pn * BM + wc * 32 + 8 * fq;
#pragma unroll
        for (int ai = 0; ai < 2; ++ai)
#pragma unroll
            for (int m = 0; m < 4; ++m) {
                const int row = row0 + ai * HALF + m * 16; float s = 0.f;
#pragma unroll
                for (int bj = 0; bj < 2; ++bj) {
                    const float* xp = X + (size_t)row * 1024 + col0 + bj * HALF;
                    const f32x4 x0 = *(const f32x4*)xp, x1 = *(const f32x4*)(xp + 4);
                    const f32x4 v0 = acc[ai][bj][m][0] + x0, v1 = acc[ai][bj][m][1] + x1;
                    s += (v0[0] * v0[0] + v0[1] * v0[1]) + (v0[2] * v0[2] + v0[3] * v0[3]) + (v1[0] * v1[0] + v1[1] * v1[1]) + (v1[2] * v1[2] + v1[3] * v1[3]);
                    u32x4 w; w.x = cvt_pk_bf16(v0[0], v0[1]); w.y = cvt_pk_bf16(v0[2], v0[3]); w.z = cvt_pk_bf16(v1[0], v1[1]); w.w = cvt_pk_bf16(v1[2], v1[3]);
                    *(u32x4*)(O + (size_t)row * 1024 + col0 + bj * HALF) = w;
                }
                s += xshfl(s, (fq * 16 + fr) ^ 16); s += xshfl(s, (fq * 16 + fr) ^ 32);
                if (fq == 0) ssq[(size_t)(u.pn * 4 + wc) * 32768 + row] = s;
            }
    }
};
struct EpiPeerQ {
    static constexpr bool PERM = true, AFTER_DRAIN = false;
    bf16_t* O; const float* ssq;
    __device__ __forceinline__ void operator()(const f32x4 (&acc)[2][2][4][2], const Unit& u, int wr, int wc, int fr, int fq) const {
        const int row0 = u.pm * BM + wr * 64 + fr, col0 = u.pn * BM + wc * 32 + 8 * fq;
#pragma unroll
        for (int ai = 0; ai < 2; ++ai)
#pragma unroll
            for (int m = 0; m < 4; ++m) {
                const int row = row0 + ai * HALF + m * 16;
                float s = 0.f;
#pragma unroll
                for (int q = 0; q < 4; ++q) s += ssq[(size_t)(4 * fq + q) * 32768 + row];
                s += xshfl(s, (fq * 16 + fr) ^ 16); s += xshfl(s, (fq * 16 + fr) ^ 32);
                const float rstd = rsqrtf(s * (1.f / 1024.f) + 1e-6f);
#pragma unroll
                for (int bj = 0; bj < 2; ++bj) {
                    const f32x4 v0 = acc[ai][bj][m][0] * rstd, v1 = acc[ai][bj][m][1] * rstd;
                    u32x4 w; w.x = cvt_pk_bf16(v0[0], v0[1]); w.y = cvt_pk_bf16(v0[2], v0[3]); w.z = cvt_pk_bf16(v1[0], v1[1]); w.w = cvt_pk_bf16(v1[2], v1[3]);
                    *(u32x4*)(O + (size_t)row * 2048 + col0 + bj * HALF) = w;
                }
            }
    }
};
struct EpiPle {
    static constexpr bool PERM = true, AFTER_DRAIN = false;
    const bf16_t* X2; const bf16_t* PP; const float* rstd2; bf16_t* O;
    __device__ __forceinline__ void operator()(const f32x4 (&acc)[2][2][4][2], const Unit& u, int wr, int wc, int fr, int fq) const {
        const int row0 = u.pm * BM + wr * 64 + fr, col0 = u.pn * BM + wc * 32 + 8 * fq;
#pragma unroll
        for (int ai = 0; ai < 2; ++ai)
#pragma unroll
            for (int m = 0; m < 4; ++m) {
                const int row = row0 + ai * HALF + m * 16;
                const float rstd = rstd2[row];
#pragma unroll
                for (int bj = 0; bj < 2; ++bj) {
                    const size_t off = (size_t)row * 1024 + col0 + bj * HALF;
                    const u32x4 xw = *(const u32x4*)(X2 + off), pw = *(const u32x4*)(PP + off);
                    f32x4 o0, o1;
#pragma unroll
                    for (int e = 0; e < 4; ++e) {
                        const unsigned xe = (e < 2) ? ((e == 0) ? xw.x : xw.y) : ((e == 2) ? xw.z : xw.w);
                        const unsigned pe = (e < 2) ? ((e == 0) ? pw.x : pw.y) : ((e == 2) ? pw.z : pw.w);
                        const float xlo = __uint_as_float(xe << 16), xhi = __uint_as_float(xe & 0xffff0000u);
                        const float plo = __uint_as_float(pe << 16), phi = __uint_as_float(pe & 0xffff0000u);
                        const float a0 = (e < 2) ? acc[ai][bj][m][0][2 * e] : acc[ai][bj][m][1][2 * e - 4];
                        const float a1 = (e < 2) ? acc[ai][bj][m][0][2 * e + 1] : acc[ai][bj][m][1][2 * e - 3];
                        const float g0 = 1.f / (1.f + __expf(-a0 * rstd)), g1 = 1.f / (1.f + __expf(-a1 * rstd));
                        const float r0 = xlo + plo * g0, r1 = xhi + phi * g1;
                        if (e < 2) { o0[2 * e] = r0; o0[2 * e + 1] = r1; } else { o1[2 * e - 4] = r0; o1[2 * e - 3] = r1; }
                    }
                    { u32x4 w; w.x = cvt_pk_bf16(o0[0], o0[1]); w.y = cvt_pk_bf16(o0[2], o0[3]); w.z = cvt_pk_bf16(o1[0], o1[1]); w.w = cvt_pk_bf16(o1[2], o1[3]); *(u32x4*)(O + off) = w; }
                }
            }
    }
};
template <class Epi, class Sched, bool ALIGN_EPI = false, bool SP2 = false>
__device__ __forceinline__ void gemm_phase(PG8_LAS unsigned char* lds, const Gemm g, const Sched& S, const Epi& E, const int wave_id  ) {
    int lane_; asm volatile("v_mbcnt_lo_u32_b32 %0, -1, 0\n\tv_mbcnt_hi_u32_b32 %0, -1, %0" : "=v"(lane_)); int tid_ = wave_id * 64 + lane_;
    const int tid = tid_, wid = wave_id, lane = tid & 63, wr = wid >> 2, wc = wid & 3, fr = lane & 15, fq = lane >> 4;
    const int K = g.K, nt = K / BK;
    unsigned voffA[2], voffB[2];
#pragma unroll
    for (int i = 0; i < 2; ++i) { int R, C; stage_rc(tid * 16 + i * 8192, R, C); const int Rb = Epi::PERM ? ((R & ~31) + perm32(R & 31)) : R;
        voffA[i] = (unsigned)(R * K + C) * 2u; voffB[i] = (unsigned)(Rb * K + C) * 2u; }
    const size_t kstep = (size_t)(BK * 2);
    const size_t hstep = (size_t)HALF * K * 2;
    const size_t tstep = 2 * hstep;
    const unsigned ldsw = (unsigned)wid * 1024u;
    const int aoff = lds_byte(wr * 64 + fr, fq * 8), boff = lds_byte(wc * 32 + fr, fq * 8);
#define PG8_SA(b, h) (((b) * 2 + (h)) * HTB)
#define PG8_SB(b, h) ((4 + (b) * 2 + (h)) * HTB)
#define PG8_STAGE(bufoff, gbase, voff) do { _Pragma("unroll") for (int _i = 0; _i < 2; ++_i) \
        __builtin_amdgcn_global_load_lds((const unsigned*)((const char*)(gbase) + (voff)[_i]), (PG8_LAS unsigned*)(lds + (bufoff) + ldsw + _i * 8192), 16, 0, 0); } while (0)
#define PG8_LDA(dst, b, h) do { _Pragma("unroll") for (int m = 0; m < 4; ++m) _Pragma("unroll") for (int k = 0; k < 2; ++k) dst[m][k] = *(const PG8_LAS bf16x8*)(lds + PG8_SA(b, h) + aoff + m * 2048 + k * 1024); } while (0)
#define PG8_LDB(dst, b, h) do { _Pragma("unroll") for (int n = 0; n < 2; ++n) _Pragma("unroll") for (int k = 0; k < 2; ++k) dst[n][k] = *(const PG8_LAS bf16x8*)(lds + PG8_SB(b, h) + boff + n * 2048 + k * 1024); } while (0)
#define PG8_MMA(ai, bj, At, Bt) do { __builtin_amdgcn_s_setprio(1); _Pragma("unroll") for (int m = 0; m < 4; ++m) _Pragma("unroll") for (int n = 0; n < 2; ++n) _Pragma("unroll") for (int k = 0; k < 2; ++k) \
        acc[ai][bj][m][n] = __builtin_amdgcn_mfma_f32_16x16x32_bf16(Bt[n][k], At[m][k], acc[ai][bj][m][n], 0, 0, 0); __builtin_amdgcn_s_setprio(0); } while (0)
#define PG8_WAIT_V(n) asm volatile("s_waitcnt vmcnt(" #n ")" ::: "memory")
#define PG8_WAIT_L(n) asm volatile("s_waitcnt lgkmcnt(" #n ")" ::: "memory")
#define PG8_BAR __builtin_amdgcn_s_barrier()
#define PG8_SCHED __builtin_amdgcn_sched_barrier(0)
    Unit cur, nxt; int ui = 0;
    if (!S.next(0, cur)) return;
    f32x4 acc[2][2][4][2];
#pragma unroll
    for (int a = 0; a < 2; ++a)
#pragma unroll
        for (int b = 0; b < 2; ++b)
#pragma unroll
            for (int m = 0; m < 4; ++m)
#pragma unroll
                for (int n = 0; n < 2; ++n) acc[a][b][m][n] = (f32x4){0.f, 0.f, 0.f, 0.f};
    bf16x8 At[4][2], B0[2][2], B1[2][2];
    const char* cA = (const char*)g.A + (size_t)cur.pm * tstep; const char* cB = (const char*)g.Bt + (size_t)cur.pn * tstep;
    S.a_ready(cur);
    if constexpr (SP2) {
        PG8_STAGE(PG8_SB(0, 0), cB, voffB); PG8_STAGE(PG8_SB(0, 1), cB + hstep, voffB); PG8_STAGE(PG8_SA(0, 0), cA, voffA); PG8_STAGE(PG8_SA(0, 1), cA + hstep, voffA);
        if (wr == 1) PG8_BAR;
        PG8_WAIT_V(2); PG8_BAR;
        PG8_STAGE(PG8_SB(1, 0), cB + kstep, voffB); PG8_STAGE(PG8_SA(1, 0), cA + kstep, voffA); PG8_STAGE(PG8_SB(1, 1), cB + hstep + kstep, voffB);
        PG8_WAIT_V(6); PG8_BAR;
    } else {
        PG8_STAGE(PG8_SB(0, 0), cB, voffB); PG8_STAGE(PG8_SA(0, 0), cA, voffA); PG8_STAGE(PG8_SB(0, 1), cB + hstep, voffB); PG8_STAGE(PG8_SA(0, 1), cA + hstep, voffA);
        if (wr == 1) PG8_BAR;
        PG8_WAIT_V(4); PG8_BAR;
        PG8_STAGE(PG8_SB(1, 0), cB + kstep, voffB); PG8_STAGE(PG8_SA(1, 0), cA + kstep, voffA); PG8_STAGE(PG8_SB(1, 1), cB + hstep + kstep, voffB);
        PG8_WAIT_V(6); PG8_BAR;
    }
    for (;;) {
        const bool has_next = S.next(ui + 1, nxt);
        const char* nA = has_next ? (const char*)g.A + (size_t)nxt.pm * tstep : cA; const char* nB = has_next ? (const char*)g.Bt + (size_t)nxt.pn * tstep : cB;
        for (int t = 0; t < nt; t += 2) {
            const bool last = (t == nt - 2);
            const char* a1 = cA + (size_t)(t + 1) * kstep;
            const char* a2 = last ? nA : cA + (size_t)(t + 2) * kstep; const char* b2 = last ? nB : cB + (size_t)(t + 2) * kstep;
            const char* a3 = a2 + kstep; const char* b3 = b2 + kstep;
            if (last && has_next) S.a_ready(nxt);
            if constexpr (SP2) {
            PG8_LDB(B0, 0, 0); PG8_LDB(B1, 0, 1); PG8_SCHED; PG8_LDA(At, 0, 0); PG8_STAGE(PG8_SA(1, 1), a1 + hstep, voffA);
            PG8_WAIT_V(8); PG8_WAIT_L(0); PG8_BAR; PG8_MMA(0, 0, At, B0); PG8_MMA(0, 1, At, B1); PG8_BAR; PG8_SCHED;
            PG8_LDA(At, 0, 1); PG8_STAGE(PG8_SB(0, 0), b2, voffB); PG8_STAGE(PG8_SB(0, 1), b2 + hstep, voffB); PG8_STAGE(PG8_SA(0, 0), a2, voffA);
            PG8_WAIT_V(8); PG8_WAIT_L(0); PG8_BAR; PG8_MMA(1, 0, At, B0); PG8_MMA(1, 1, At, B1); PG8_BAR; PG8_SCHED;
            PG8_LDB(B0, 1, 0); PG8_LDB(B1, 1, 1); PG8_SCHED; PG8_LDA(At, 1, 0); PG8_STAGE(PG8_SA(0, 1), a2 + hstep, voffA);
            PG8_WAIT_V(8); PG8_WAIT_L(0); PG8_BAR; PG8_MMA(0, 0, At, B0); PG8_MMA(0, 1, At, B1); PG8_BAR; PG8_SCHED;
            PG8_LDA(At, 1, 1); PG8_STAGE(PG8_SB(1, 0), b3, voffB); PG8_STAGE(PG8_SB(1, 1), b3 + hstep, voffB); PG8_STAGE(PG8_SA(1, 0), a3, voffA);
            PG8_WAIT_V(8); PG8_WAIT_L(0); PG8_BAR; PG8_MMA(1, 0, At, B0); PG8_MMA(1, 1, At, B1); PG8_BAR; PG8_SCHED;
            } else {
            PG8_LDB(B0, 0, 0); PG8_SCHED; PG8_LDA(At, 0, 0); PG8_STAGE(PG8_SA(1, 1), a1 + hstep, voffA);
            PG8_WAIT_L(8); PG8_BAR; PG8_WAIT_L(0); PG8_MMA(0, 0, At, B0); PG8_BAR; PG8_SCHED;
            PG8_LDB(B1, 0, 1); PG8_STAGE(PG8_SB(0, 0), b2, voffB);
            PG8_BAR; PG8_WAIT_L(0); PG8_MMA(0, 1, At, B1); PG8_BAR;
            PG8_LDA(At, 0, 1); PG8_STAGE(PG8_SA(0, 0), a2, voffA);
            PG8_BAR; PG8_WAIT_L(0); PG8_MMA(1, 0, At, B0); PG8_BAR; PG8_SCHED;
            PG8_STAGE(PG8_SB(0, 1), b2 + hstep, voffB);
            PG8_WAIT_V(6); PG8_BAR; PG8_MMA(1, 1, At, B1); PG8_BAR;
            PG8_LDB(B0, 1, 0); PG8_SCHED; PG8_LDA(At, 1, 0); PG8_STAGE(PG8_SA(0, 1), a2 + hstep, voffA);
            PG8_WAIT_L(8); PG8_BAR; PG8_WAIT_L(0); PG8_MMA(0, 0, At, B0); PG8_BAR; PG8_SCHED;
            PG8_LDB(B1, 1, 1); PG8_STAGE(PG8_SB(1, 0), b3, voffB);
            PG8_BAR; PG8_WAIT_L(0); PG8_MMA(0, 1, At, B1); PG8_BAR;
            PG8_LDA(At, 1, 1); PG8_STAGE(PG8_SA(1, 0), a3, voffA);
            PG8_BAR; PG8_WAIT_L(0); PG8_MMA(1, 0, At, B0); PG8_BAR; PG8_SCHED;
            PG8_STAGE(PG8_SB(1, 1), b3 + hstep, voffB);
            PG8_WAIT_V(6); PG8_BAR; PG8_MMA(1, 1, At, B1); PG8_BAR;
            }
        }
        if constexpr (ALIGN_EPI) { if (wr == 0) PG8_BAR; }
        if constexpr (!Epi::AFTER_DRAIN) { E(acc, cur, wr, wc, fr, fq); S.done(cur); }
        if (!has_next) break;
#pragma unroll
        for (int a = 0; a < 2; ++a)
#pragma unroll
            for (int b = 0; b < 2; ++b)
#pragma unroll
                for (int m = 0; m < 4; ++m)
#pragma unroll
                    for (int n = 0; n < 2; ++n) acc[a][b][m][n] = (f32x4){0.f, 0.f, 0.f, 0.f};
        cur = nxt; cA = nA; cB = nB; ++ui;
        if constexpr (ALIGN_EPI) { if (wr == 1) PG8_BAR; }
    }
    PG8_WAIT_V(0);
    if constexpr (!ALIGN_EPI) { if (wr == 0) PG8_BAR; }
    PG8_BAR;
    if constexpr (Epi::AFTER_DRAIN) { E.fused(acc, cur, wr, wc, fr, fq, lds, wid, lane); S.done(cur); }
#undef PG8_SA
#undef PG8_SB
#undef PG8_STAGE
#undef PG8_LDA
#undef PG8_LDB
#undef PG8_MMA
#undef PG8_WAIT_V
#undef PG8_WAIT_L
#undef PG8_BAR
#undef PG8_SCHED
}
}

#define GAS __attribute__((address_space(1)))
#define LAS __attribute__((address_space(3)))
typedef unsigned short bf16;
typedef unsigned v4u __attribute__((ext_vector_type(4)));
typedef float f32x4 __attribute__((ext_vector_type(4)));
typedef short bf16x8 __attribute__((ext_vector_type(8)));
typedef GAS unsigned gu32;
typedef GAS unsigned long long gu64;
#define RLX_AGENT __ATOMIC_RELAXED, __HIP_MEMORY_SCOPE_AGENT
#define LDS_WAIT() asm volatile("s_waitcnt lgkmcnt(0)" ::: "memory")
#define VM_WAIT() asm volatile("s_waitcnt vmcnt(0)" ::: "memory")
__device__ __forceinline__ unsigned long long rt() { return __builtin_amdgcn_s_memrealtime(); }
__device__ __forceinline__ unsigned f2bf(float f) { unsigned u = __builtin_bit_cast(unsigned, f); return (u + 0x7fffu + ((u >> 16) & 1u)) >> 16; }
__device__ __forceinline__ unsigned pk2(float lo, float hi) { return f2bf(lo) | (f2bf(hi) << 16); }

#define XB_TMO      128
#define XB_XCNT(j)  (256  + 64 * (j))
#define XB_XSUB(j)  (1280 + 64 * (j))
#define XB_XGEN(j)  (2304 + 64 * (j))
#define XB_TOP      3328
#define XB_TOPGEN   3392
#define XCD_BAR_WORDS 3456
#define XB_SPIN_CAP (1u << 18)

__device__ __forceinline__ unsigned xb_ld(unsigned* p)              { return __hip_atomic_load(p, __ATOMIC_RELAXED, __HIP_MEMORY_SCOPE_AGENT); }
__device__ __forceinline__ unsigned xb_add(unsigned* p, unsigned v) { return __hip_atomic_fetch_add(p, v, __ATOMIC_RELAXED, __HIP_MEMORY_SCOPE_AGENT); }
__device__ __forceinline__ unsigned xb_xcc_id() { return (unsigned)__builtin_amdgcn_s_getreg((3 << 11) | 20) & 0xFu; }
#define XB_SPIN(cond, bar) do { unsigned _sp = 0; while (cond) { __builtin_amdgcn_s_sleep(1); \
    if ((++_sp & 255u) == 0u) { if (xb_ld(&(bar)[XB_TMO])) break; if (_sp > XB_SPIN_CAP) { atomicAdd(&(bar)[XB_TMO], 1u); break; } } } } while (0)

struct XcdBarrier {
    unsigned* bar; unsigned x;
    volatile LAS unsigned* st;
};

__device__ __forceinline__ XcdBarrier xcd_barrier_post(unsigned* bar, volatile LAS unsigned* st) {
    XcdBarrier b; b.bar = bar; b.x = xb_xcc_id(); b.st = st;
    if (threadIdx.x == 0) (void)xb_add(&bar[XB_XCNT(b.x)], 1u);
    return b;
}
__device__ __forceinline__ void xcd_barrier_complete(unsigned* bar, unsigned x, unsigned& nloc, unsigned& nx) {
    const unsigned G = gridDim.x * gridDim.y * gridDim.z;
    unsigned sum, cnt, mine, sp = 0u;
    for (;;) {
        sum = 0u; cnt = 0u; mine = 0u;
#pragma unroll
        for (unsigned j = 0; j < 16; ++j) { const unsigned c = xb_ld(&bar[XB_XCNT(j)]); sum += c; cnt += (c > 0u) ? 1u : 0u; mine = (j == x) ? c : mine; }
        if (sum == G) break;
        __builtin_amdgcn_s_sleep(1);
        if ((++sp & 255u) == 0u) { if (xb_ld(&bar[XB_TMO])) break; if (sp > XB_SPIN_CAP) { atomicAdd(&bar[XB_TMO], 1u); break; } }
    }
    nloc = mine > 0u ? mine : 1u; nx = cnt > 0u ? cnt : 1u;
}

__device__ __forceinline__ void xcd_barrier(const XcdBarrier& b, const bool leader  ) {
    asm volatile("s_waitcnt vmcnt(0)" ::: "memory");
    __syncthreads();
    if (leader) {
        unsigned* bar = b.bar;
        __builtin_amdgcn_s_waitcnt(0);
        unsigned nloc = b.st[0], nx = b.st[1];
        if (nloc == 0u) { xcd_barrier_complete(bar, b.x, nloc, nx); b.st[0] = nloc; b.st[1] = nx; }
        const unsigned old = xb_add(&bar[XB_XSUB(b.x)], 1u);
        const unsigned gen = old / nloc;
        if (old + 1u == (gen + 1u) * nloc) {
            __builtin_amdgcn_fence(__ATOMIC_RELEASE, "agent");
            asm volatile("s_waitcnt vmcnt(0)" ::: "memory");
            const unsigned og = xb_add(&bar[XB_TOP], 1u);
            const unsigned tg = og / nx;
            if (og + 1u == (tg + 1u) * nx) xb_add(&bar[XB_TOPGEN], 1u);
            else XB_SPIN(xb_ld(&bar[XB_TOPGEN]) == tg, bar);
            __builtin_amdgcn_fence(__ATOMIC_ACQUIRE, "agent");
            xb_add(&bar[XB_XGEN(b.x)], 1u);
            asm volatile("s_waitcnt vmcnt(0)" ::: "memory");
        } else {
            XB_SPIN(xb_ld(&bar[XB_XGEN(b.x)]) == gen, bar);
            __builtin_amdgcn_fence(__ATOMIC_ACQUIRE, "agent");
            asm volatile("s_waitcnt vmcnt(0)" ::: "memory");
        }
    }
    __syncthreads();
}
#ifndef REP_P0
#define REP_P0 1
#endif
#ifndef REP_P1
#define REP_P1 1
#endif
#ifndef REP_P2
#define REP_P2 1
#endif
#ifndef REP_P2A
#define REP_P2A 1
#endif
#ifndef REP_SEQ
#define REP_SEQ 1
#endif
#ifndef REP_DSW
#define REP_DSW 1
#endif
#ifndef REP_P3
#define REP_P3 1
#endif
#ifndef REP_P4
#define REP_P4 1
#endif
#ifndef REP_P5
#define REP_P5 1
#endif
#ifndef REP_P6
#define REP_P6 1
#endif
#ifndef REP_P7
#define REP_P7 1
#endif
constexpr int NWAVES = 8;
constexpr int T = 32768, D = 1024, SEQ = 4096;
constexpr int INC = 3328, INCP = 3328, INC_OLD = 3088;
constexpr int OFF_QA = 0, OFF_KA = 256, OFF_VA = 512, OFF_RA = 1024, OFF_LA = 1536, OFF_QB = 1792, OFF_KB = 2304, OFF_VB = 2816;
constexpr float EPS = 1e-6f;
constexpr size_t MiB = 1u << 20;
constexpr size_t WS_CTL = 0, CTL_ZERO_BYTES = 1 * MiB;
constexpr size_t WS_BT_IN = 2 * MiB, WS_BT_OUT = 10 * MiB, WS_BT_PQ = 12 * MiB, WS_BT_PG = 16 * MiB, WS_BT_PP = 18 * MiB;
constexpr size_t WS_ROPE = 20 * MiB, WS_SSQ1 = 22 * MiB, WS_RSTD2 = 24 * MiB, WS_KEYSB = 26 * MiB, WS_GDEC = 27 * MiB;
constexpr size_t WS_H1 = 32 * MiB;
constexpr size_t WS_PROJ = 96 * MiB;
constexpr size_t WS_QR = 96 * MiB, WS_SEL = 224 * MiB;
constexpr size_t WS_MIX = 304 * MiB;
constexpr size_t WS_PB = 368 * MiB;
constexpr size_t WS_PPROJ = 384 * MiB;
constexpr size_t WS_X2B = 304 * MiB;
constexpr size_t WS_UB = 448 * MiB, WS_VB = 464 * MiB;
constexpr size_t WS_GOG = 32 * MiB;
constexpr size_t WS_GQD = 368 * MiB;
constexpr size_t WS_GKV = 480 * MiB;
constexpr size_t WS_END = 512 * MiB;
constexpr int CW_BAR = 4096;
constexpr int CW_DSW = 16384;
constexpr int RING_OFF = 0, RING_BYTES = 131072;
constexpr int LDSCTL_OFF = 159 * 1024, MISC_OFF = LDSCTL_OFF + 320;
constexpr int LDS_BYTES = 163840;

__device__ __forceinline__ float bf2f(bf16 v) { return __uint_as_float(((unsigned)v) << 16); }
__device__ __forceinline__ float wave_sum(float v) {
    v += __int_as_float(__builtin_amdgcn_update_dpp(0, __float_as_int(v), 0xB1, 0xF, 0xF, true));
    v += __int_as_float(__builtin_amdgcn_update_dpp(0, __float_as_int(v), 0x4E, 0xF, 0xF, true));
    v += __int_as_float(__builtin_amdgcn_update_dpp(0, __float_as_int(v), 0x141, 0xF, 0xF, true));
    v += __int_as_float(__builtin_amdgcn_update_dpp(0, __float_as_int(v), 0x140, 0xF, 0xF, true));
    v += __int_as_float(__builtin_amdgcn_update_dpp(0, __float_as_int(v), 0x142, 0xA, 0xF, false));
    v += __int_as_float(__builtin_amdgcn_update_dpp(0, __float_as_int(v), 0x143, 0xC, 0xF, false));
    return __int_as_float(__builtin_amdgcn_readlane(__float_as_int(v), 63));
}
__device__ __forceinline__ float xshfl(float v, int srclane) { return __int_as_float(__builtin_amdgcn_ds_bpermute(srclane << 2, __float_as_int(v))); }
__device__ __forceinline__ int xshfl_i(int v, int srclane) { return __builtin_amdgcn_ds_bpermute(srclane << 2, v); }


typedef __bf16 bf16x2_t __attribute__((ext_vector_type(2)));
typedef int i32x2 __attribute__((ext_vector_type(2)));
typedef short s16x4 __attribute__((ext_vector_type(4)));
typedef float f32x2 __attribute__((ext_vector_type(2)));
typedef float f32x32 __attribute__((ext_vector_type(32)));
typedef float f32x16 __attribute__((ext_vector_type(16)));
typedef __bf16 bf16x32 __attribute__((ext_vector_type(32)));
typedef unsigned u32x6 __attribute__((ext_vector_type(6)));
typedef unsigned u32x16 __attribute__((ext_vector_type(16)));
__device__ __forceinline__ unsigned enc6(float y) { const float q = fabsf(y) * 8.f; float c;
    if (q < 16.f) c = rintf(q); else if (q < 32.f) c = 16.f + rintf((q - 16.f) * 0.5f); else c = 24.f + rintf((q - 32.f) * 0.25f);
    c = fminf(c, 31.f); return (unsigned)c | ((__float_as_uint(y) >> 31) << 5); }
__device__ __forceinline__ unsigned enc4(float y) { const float a = fabsf(y);
    const unsigned c = (a > 0.25f) + (a > 0.75f) + (a > 1.25f) + (a > 1.75f) + (a > 2.5f) + (a > 3.5f) + (a > 5.0f); return c | ((__float_as_uint(y) >> 31) << 3); }
__device__ __forceinline__ unsigned cvtpk(float a, float b) { const f32x2 v = {a, b}; return __builtin_bit_cast(unsigned, __builtin_convertvector(v, bf16x2_t)); }
template <int CTRL> __device__ __forceinline__ float dpp_mov(float v) { return __int_as_float(__builtin_amdgcn_update_dpp(0, __float_as_int(v), CTRL, 0xF, 0xF, true)); }
__device__ __forceinline__ float row_sum16(float v) { v += dpp_mov<0xB1>(v); v += dpp_mov<0x4E>(v); v += dpp_mov<0x141>(v); v += dpp_mov<0x140>(v); return v; }
__device__ __forceinline__ float dot2bf(unsigned a, unsigned b, float c) { return __builtin_amdgcn_fdot2_f32_bf16(__builtin_bit_cast(bf16x2_t, a), __builtin_bit_cast(bf16x2_t, b), c, false); }
__device__ __forceinline__ float bflo(unsigned w) { return __uint_as_float(w << 16); }
__device__ __forceinline__ float bfhi(unsigned w) { return __uint_as_float(w & 0xffff0000u); }


__device__ __forceinline__ int f2key(float f) { const int b = __float_as_int(f); return b ^ ((b >> 31) & 0x7fffffff); }
__device__ __forceinline__ float key2f(int k) { return __int_as_float(k ^ ((k >> 31) & 0x7fffffff)); }
#define CE_DESC(a, b) { const int _hi = max((a), (b)), _lo = min((a), (b)); (a) = _hi; (b) = _lo; }
template <int N> __device__ __forceinline__ void bitonic_sort_desc(int (&v)[N]) {
#pragma unroll
    for (int k = 2; k <= N; k <<= 1)
#pragma unroll
        for (int j = k >> 1; j > 0; j >>= 1)
#pragma unroll
            for (int i = 0; i < N; ++i) { const int l = i ^ j; if (l > i) { if ((i & k) == 0) CE_DESC(v[i], v[l]) else CE_DESC(v[l], v[i]) } }
}
template <int N> __device__ __forceinline__ void bitonic_merge_desc(int (&v)[N]) {
#pragma unroll
    for (int j = N >> 1; j > 0; j >>= 1)
#pragma unroll
        for (int i = 0; i < N; ++i) { const int l = i ^ j; if (l > i) CE_DESC(v[i], v[l]) }
}
__device__ __forceinline__ void merge_top16(int (&a)[16], int srclane) {
    int b[16];
#pragma unroll
    for (int i = 0; i < 16; ++i) b[i] = __builtin_amdgcn_ds_bpermute(srclane << 2, a[i]);
#pragma unroll
    for (int i = 0; i < 16; ++i) a[i] = max(a[i], b[15 - i]);
    bitonic_merge_desc<16>(a);
}
struct CandTab { int i[64], j[64]; int n;
    constexpr CandTab() : i{}, j{}, n(0) { for (int a = 0; a < 16; ++a) for (int b = 0; b < 16; ++b) if ((a + 1) * (b + 1) <= 16) { i[n] = a; j[n] = b; ++n; } for (int q = n; q < 64; ++q) { i[q] = -1; j[q] = -1; } } };
constexpr CandTab kCand{};
static_assert(kCand.n == 50, "50 product-key candidates can reach the top 16");

__device__ __forceinline__ float max_x16(float x) { const auto r = __builtin_amdgcn_permlane16_swap(__float_as_uint(x), __float_as_uint(x), false, false); return fmaxf(__uint_as_float(r[0]), __uint_as_float(r[1])); }
__device__ __forceinline__ float max_x32(float x) { const auto r = __builtin_amdgcn_permlane32_swap(__float_as_uint(x), __float_as_uint(x), false, false); return fmaxf(__uint_as_float(r[0]), __uint_as_float(r[1])); }
__device__ __forceinline__ float add_x16(float x) { const auto r = __builtin_amdgcn_permlane16_swap(__float_as_uint(x), __float_as_uint(x), false, false); return __uint_as_float(r[0]) + __uint_as_float(r[1]); }
__device__ __forceinline__ float add_x32(float x) { const auto r = __builtin_amdgcn_permlane32_swap(__float_as_uint(x), __float_as_uint(x), false, false); return __uint_as_float(r[0]) + __uint_as_float(r[1]); }

__device__ __forceinline__ void p0_transpose_item(const float* W, int K, int ldw, int src0, int ncols, const float* gain, bf16* WT, int dst0, int nblk, LAS float* scr, int item, int lane) {
    const int kb = item / nblk, nb = item % nblk, k0 = 64 * kb, n0 = 32 * nb;
    const int n = n0 + (lane & 31);
#pragma unroll 8
    for (int i = 0; i < 32; ++i) { const int kk = 2 * i + (lane >> 5); float v = 0.f; if (n < ncols) { v = W[(size_t)(k0 + kk) * ldw + src0 + n]; if (gain) v *= gain[k0 + kk]; } scr[kk * 33 + (lane & 31)] = v; }
    LDS_WAIT(); asm volatile("" ::: "memory");
    const int c = lane & 7;
#pragma unroll
    for (int j = 0; j < 4; ++j) { const int nn = (lane >> 3) + 8 * j; const LAS float* s = scr + (8 * c) * 33 + nn;
        v4u o; o.x = pk2(s[0 * 33], s[1 * 33]); o.y = pk2(s[2 * 33], s[3 * 33]); o.z = pk2(s[4 * 33], s[5 * 33]); o.w = pk2(s[6 * 33], s[7 * 33]);
        *(GAS v4u*)(WT + (size_t)(dst0 + n0 + nn) * K + k0 + 8 * c) = o; }
    LDS_WAIT(); asm volatile("" ::: "memory");
}

struct Args { const float* in[18]; float* outp; unsigned char* ws; };

#define xin      (args.in[0])
#define p_in     (args.in[1])
#define positions ((const int*)args.in[2])
#define g_mix    (args.in[3])
#define w_in     (args.in[4])
#define w_up     (args.in[5])
#define b_gate   (args.in[6])
#define g_gla    (args.in[7])
#define w_out    (args.in[8])
#define g_peer   (args.in[9])
#define w_pq     (args.in[10])
#define skeys    (args.in[11])
#define pu       (args.in[12])
#define pv       (args.in[13])
#define g_ple    (args.in[14])
#define w_pg     (args.in[15])
#define w_pp     (args.in[16])
#define g_final  (args.in[17])
#define out      (args.outp)
#define Bt_in    ((bf16*)(args.ws + WS_BT_IN))
#define Bt_out   ((bf16*)(args.ws + WS_BT_OUT))
#define Bt_pq    ((bf16*)(args.ws + WS_BT_PQ))
#define Bt_pg    ((bf16*)(args.ws + WS_BT_PG))
#define Bt_pp    ((bf16*)(args.ws + WS_BT_PP))
#define rope     ((float*)(args.ws + WS_ROPE))
#define ssq1     ((float*)(args.ws + WS_SSQ1))
#define rstd2    ((float*)(args.ws + WS_RSTD2))
#define h1       ((bf16*)(args.ws + WS_H1))
#define x1b      ((bf16*)(args.ws + WS_H1))
#define proj     ((bf16*)(args.ws + WS_PROJ))
#define qr       ((bf16*)(args.ws + WS_QR))
#define sel2     ((i32x2*)(args.ws + WS_SEL))
#define Ub       ((unsigned char*)(args.ws + WS_UB))
#define Vb       ((unsigned char*)(args.ws + WS_VB))
#define keysb    ((bf16*)(args.ws + WS_KEYSB))
#define mix      ((bf16*)(args.ws + WS_MIX))
#define pb       ((bf16*)(args.ws + WS_PB))
#define pproj    ((bf16*)(args.ws + WS_PPROJ))
#define x2b      ((bf16*)(args.ws + WS_X2B))


__global__ void __launch_bounds__(NWAVES * 64, 2) mk_fwd(Args args) {
    extern __shared__ __attribute__((aligned(16))) unsigned char lds[];
    LAS unsigned char* const L = (LAS unsigned char*)lds;
    volatile LAS unsigned* const MISC = (volatile LAS unsigned*)(L + MISC_OFF);
    const int wave = __builtin_amdgcn_readfirstlane((int)threadIdx.x >> 6);
#define LANE_DECL int lane; asm volatile("v_mbcnt_lo_u32_b32 %0, -1, 0\n\tv_mbcnt_hi_u32_b32 %0, -1, %0" : "=v"(lane))
    const int G = gridDim.x; const int bx = blockIdx.x;
    const int vcu = (G % 8 == 0) ? (bx % 8) * (G / 8) + bx / 8 : bx;
    const int gw = vcu * NWAVES + wave, NGW = G * NWAVES;
    gu32* const ctl = (gu32*)(args.ws + WS_CTL);
    for (int u = threadIdx.x; u < (LDS_BYTES - LDSCTL_OFF) / 4; u += NWAVES * 64) ((LAS unsigned*)(L + LDSCTL_OFF))[u] = 0u;
    __syncthreads();
    XcdBarrier bar = xcd_barrier_post((unsigned*)(ctl + CW_BAR), MISC + 8);

    for (int rep_ = 0; rep_ < REP_P0; ++rep_) {
        LANE_DECL;
        LAS float* scr = (LAS float*)(L + RING_OFF + wave * 16384);
        constexpr int I_INA = 16 * 48, I_INB = 16 * 48, I_PP = 4 * 32;
        constexpr int NITEMS = I_INA + I_INB + I_PP;
        for (int it = gw; it < NITEMS; it += NGW) {
            int r = it;
            if (r < I_INA) { p0_transpose_item(w_in, 1024, INC_OLD, 0, 1536, nullptr, Bt_in, 0, 48, scr, r, lane); continue; } r -= I_INA;
            if (r < I_INB) { p0_transpose_item(w_in, 1024, INC_OLD, 1552, 1536, nullptr, Bt_in, 1792, 48, scr, r, lane); continue; } r -= I_INB;
            p0_transpose_item(w_pp, 256, 1024, 0, 1024, nullptr, Bt_pp, 0, 32, scr, r, lane);
        }
        for (int i = gw * 64 + lane; i < 256 * 128; i += NGW * 64) {
            const int n = i >> 7, k0 = (i & 127) * 8;
            float wu[16];
#pragma unroll
            for (int r = 0; r < 16; ++r) wu[r] = w_up[r * 256 + n];
            float o8[8];
#pragma unroll
            for (int kk = 0; kk < 8; ++kk) { const GAS f32x4* wr4 = (const GAS f32x4*)(w_in + (size_t)(k0 + kk) * INC_OLD + 1536); float a = 0.f;
#pragma unroll
                for (int q = 0; q < 4; ++q) { const f32x4 w4 = wr4[q]; a += w4.x * wu[4 * q] + w4.y * wu[4 * q + 1] + w4.z * wu[4 * q + 2] + w4.w * wu[4 * q + 3]; }
                o8[kk] = a; }
            v4u o; o.x = pk2(o8[0], o8[1]); o.y = pk2(o8[2], o8[3]); o.z = pk2(o8[4], o8[5]); o.w = pk2(o8[6], o8[7]);
            *(GAS v4u*)(Bt_in + (size_t)(1536 + n) * 1024 + k0) = o;
        }
        for (int row = gw; row < T; row += NGW) {
            const GAS f32x4* xr = (const GAS f32x4*)(xin + (size_t)row * D) + lane;
            f32x4 v[4]; float s = 0.f;
#pragma unroll
            for (int j = 0; j < 4; ++j) { v[j] = xr[64 * j]; s += (v[j].x * v[j].x + v[j].y * v[j].y) + (v[j].z * v[j].z + v[j].w * v[j].w); }
            const float rstd = rsqrtf(wave_sum(s) * (1.f / D) + EPS);
            GAS unsigned long long* o8 = (GAS unsigned long long*)(h1 + (size_t)row * D) + lane;
#pragma unroll
            for (int j = 0; j < 4; ++j) { const f32x4 gg = ((const GAS f32x4*)g_mix)[64 * j + lane];
                o8[64 * j] = (unsigned long long)pk2(v[j].x * rstd * gg.x, v[j].y * rstd * gg.y) | ((unsigned long long)pk2(v[j].z * rstd * gg.z, v[j].w * rstd * gg.w) << 32); }
        }
        for (size_t i = (size_t)gw * 64 + lane; i < (size_t)T * 256 / 4; i += (size_t)NGW * 64) {
            const f32x4 v = ((const GAS f32x4*)p_in)[i];
            ((GAS unsigned long long*)pb)[i] = (unsigned long long)pk2(v.x, v.y) | ((unsigned long long)pk2(v.z, v.w) << 32);
        }
        for (int i = gw * 64 + lane; i < T * 8; i += NGW * 64) {
            const int t = i >> 3, j = i & 7;
            const float inv_freq = powf(500000.0f, -(float)j / 8.0f);
            const float ang = (float)positions[t] * inv_freq;
            rope[2 * i] = cosf(ang); rope[2 * i + 1] = sinf(ang);
        }
    }
    { LANE_DECL; xcd_barrier(bar, wave == 0 && lane == 0); }

    for (int rep_ = 0; rep_ < REP_P1; ++rep_) {
        pg8::Gemm g{h1, Bt_in, T, INCP, D}; pg8::StaticOrder S; S.init(T, INCP, G, bx);
        pg8::EpiInProj E{proj, rope, b_gate};
        pg8::gemm_phase<pg8::EpiInProj, pg8::StaticOrder, true, true>(L + RING_OFF, g, S, E, wave);
        pg8::Gemm g2{pb, Bt_pp, T, D, 256}; pg8::StaticOrder S2;
        { const int nfull = (T / 256) * (INCP / 256) - ((T / 256) * (INCP / 256) / G) * G;
          if (nfull > 0 && nfull < G && ((G - nfull) % 8) == 0 && (nfull % 8) == 0) S2.init(T, D, G - nfull, bx >= nfull ? bx - nfull : (1 << 28)); else S2.init(T, D, G, bx); }
        pg8::EpiBf16<0> E2{pproj, D, nullptr, 0, 0, 1.f};
        pg8::gemm_phase<pg8::EpiBf16<0>, pg8::StaticOrder, true, true>(L + RING_OFF, g2, S2, E2, wave);
    }
    { LANE_DECL; xcd_barrier(bar, wave == 0 && lane == 0); }

    {
        LANE_DECL;
        const int fr = lane & 15, g = lane >> 4;
        constexpr int RS = 144;
        LAS unsigned char* const qd = L + RING_OFF;
        LAS unsigned char* const kd = qd + 64 * RS;
        LAS unsigned char* const keT = kd + 64 * RS;
        LAS unsigned char* const vT = keT + 64 * RS;
        LAS unsigned char* const Am = vT + 128 * RS;
        LAS float* const dec = (LAS float*)(Am + 64 * RS);
        for (int i = wave * 64 + lane; i < 64 * RS / 4; i += NWAVES * 64) ((LAS unsigned*)Am)[i] = 0u;
        __syncthreads();
        for (int rep4_ = 0; rep4_ < REP_P2A; ++rep4_) {
        int u = bx;
        const bf16* prow = proj + (size_t)((u >> 6) * 64 + lane) * INC + 0;
        v4u lav, qv, kv, vv0, vv1;
        {
            const int hh = (u >> 6) & 3, t0 = (u >> 8) * SEQ + (u & 63) * 64;
            prow = proj + (size_t)(t0 + lane) * INC;
            lav = *(const GAS v4u*)(prow + OFF_LA + hh * 64 + 8 * wave); qv = *(const GAS v4u*)(prow + OFF_QA + hh * 64 + 8 * wave); kv = *(const GAS v4u*)(prow + OFF_KA + hh * 64 + 8 * wave);
            vv0 = *(const GAS v4u*)(prow + OFF_VA + hh * 128 + 16 * wave); vv1 = *(const GAS v4u*)(prow + OFF_VA + hh * 128 + 16 * wave + 8);
        }
        for (; u < 2048; u += G) {
            const int h = (u >> 6) & 3, t0 = (u >> 8) * SEQ + (u & 63) * 64;
            float laf[8];
            laf[0] = bflo(lav.x); laf[1] = bfhi(lav.x); laf[2] = bflo(lav.y); laf[3] = bfhi(lav.y); laf[4] = bflo(lav.z); laf[5] = bfhi(lav.z); laf[6] = bflo(lav.w); laf[7] = bfhi(lav.w);
            float qf[8], kf[8];
            qf[0] = bflo(qv.x); qf[1] = bfhi(qv.x); qf[2] = bflo(qv.y); qf[3] = bfhi(qv.y); qf[4] = bflo(qv.z); qf[5] = bfhi(qv.z); qf[6] = bflo(qv.w); qf[7] = bfhi(qv.w);
            kf[0] = bflo(kv.x); kf[1] = bfhi(kv.x); kf[2] = bflo(kv.y); kf[3] = bfhi(kv.y); kf[4] = bflo(kv.z); kf[5] = bfhi(kv.z); kf[6] = bflo(kv.w); kf[7] = bfhi(kv.w);
            float qdv[8], kdv[8], kev[8];
#pragma unroll
            for (int c = 0; c < 8; ++c) {
                float bsum = laf[c];
                bsum += __int_as_float(__builtin_amdgcn_update_dpp(0, __float_as_int(bsum), 0x111, 0xF, 0xF, false));
                bsum += __int_as_float(__builtin_amdgcn_update_dpp(0, __float_as_int(bsum), 0x112, 0xF, 0xF, false));
                bsum += __int_as_float(__builtin_amdgcn_update_dpp(0, __float_as_int(bsum), 0x114, 0xF, 0xF, false));
                bsum += __int_as_float(__builtin_amdgcn_update_dpp(0, __float_as_int(bsum), 0x118, 0xF, 0xF, false));
                bsum += __int_as_float(__builtin_amdgcn_update_dpp(0, __float_as_int(bsum), 0x142, 0xA, 0xF, false));
                bsum += __int_as_float(__builtin_amdgcn_update_dpp(0, __float_as_int(bsum), 0x143, 0xC, 0xF, false));
                const float blast = __int_as_float(__builtin_amdgcn_readlane(__float_as_int(bsum), 63));
                qdv[c] = qf[c] * 0.125f * __expf(bsum);
                kdv[c] = kf[c] * __expf(-bsum);
                kev[c] = kf[c] * __expf(blast - bsum);
                if (lane == 0) dec[8 * wave + c] = __expf(blast);
            }
#pragma unroll
            for (int c = 0; c < 8; c += 2) { const unsigned w2 = cvtpk(kev[c], kev[c + 1]);
                *(LAS bf16*)(keT + (8 * wave + c) * RS + lane * 2) = (bf16)(w2 & 0xffffu); *(LAS bf16*)(keT + (8 * wave + c + 1) * RS + lane * 2) = (bf16)(w2 >> 16); }
            { v4u o; o.x = cvtpk(qdv[0], qdv[1]); o.y = cvtpk(qdv[2], qdv[3]); o.z = cvtpk(qdv[4], qdv[5]); o.w = cvtpk(qdv[6], qdv[7]); *(LAS v4u*)(qd + lane * RS + 16 * wave) = o;
              v4u o2; o2.x = cvtpk(kdv[0], kdv[1]); o2.y = cvtpk(kdv[2], kdv[3]); o2.z = cvtpk(kdv[4], kdv[5]); o2.w = cvtpk(kdv[6], kdv[7]); *(LAS v4u*)(kd + lane * RS + 16 * wave) = o2; }
            {
                const unsigned vw[8] = {vv0.x, vv0.y, vv0.z, vv0.w, vv1.x, vv1.y, vv1.z, vv1.w};
#pragma unroll
                for (int e = 0; e < 8; ++e) { *(LAS bf16*)(vT + (16 * wave + 2 * e) * RS + lane * 2) = (bf16)(vw[e] & 0xffffu); *(LAS bf16*)(vT + (16 * wave + 2 * e + 1) * RS + lane * 2) = (bf16)(vw[e] >> 16); }
            }
            if (u + G < 2048) {
                const int un = u + G, hn = (un >> 6) & 3, tn = (un >> 8) * SEQ + (un & 63) * 64;
                const bf16* pn = proj + (size_t)(tn + lane) * INC;
                lav = *(const GAS v4u*)(pn + OFF_LA + hn * 64 + 8 * wave); qv = *(const GAS v4u*)(pn + OFF_QA + hn * 64 + 8 * wave); kv = *(const GAS v4u*)(pn + OFF_KA + hn * 64 + 8 * wave);
                vv0 = *(const GAS v4u*)(pn + OFF_VA + hn * 128 + 16 * wave); vv1 = *(const GAS v4u*)(pn + OFF_VA + hn * 128 + 16 * wave + 8);
            }
            unsigned long long rav[4];
#pragma unroll
            for (int tt = 0; tt < 4; ++tt) rav[tt] = *(const GAS unsigned long long*)(proj + (size_t)(t0 + 16 * tt + fr) * INC + OFF_RA + h * 128 + 16 * wave + 4 * g);
            const f32x4 ggl = *(const GAS f32x4*)(g_gla + h * 128 + 16 * wave + 4 * g);
            LDS_WAIT(); __syncthreads();
#pragma unroll
            for (int rep = 0; rep < 2; ++rep) {
                const int ti = wave + 8 * rep;
                if (ti < 10) {
                    const int tt = (ti >= 6) ? 3 : ((ti >= 3) ? 2 : ((ti >= 1) ? 1 : 0));
                    const int tk = ti - ((tt * (tt + 1)) >> 1);
                    f32x4 acc = {0.f, 0.f, 0.f, 0.f};
#pragma unroll
                    for (int ks = 0; ks < 2; ++ks) { const bf16x8 a = *(const LAS bf16x8*)(qd + (16 * tt + fr) * RS + (32 * ks + 8 * g) * 2), bb = *(const LAS bf16x8*)(kd + (16 * tk + fr) * RS + (32 * ks + 8 * g) * 2);
                        acc = __builtin_amdgcn_mfma_f32_16x16x32_bf16(a, bb, acc, 0, 0, 0); }
#pragma unroll
                    for (int r = 0; r < 4; ++r) { const int tq = 16 * tt + 4 * g + r, tc = 16 * tk + fr; *(LAS bf16*)(Am + tq * RS + tc * 2) = (bf16)f2bf(tq >= tc ? acc[r] : 0.f); }
                }
            }
            {
                const int tt = wave >> 1, ks = wave & 1;
                const unsigned long long lo = *(const LAS unsigned long long*)(qd + (16 * tt + fr) * RS + (32 * ks + 4 * g) * 2), hi = *(const LAS unsigned long long*)(qd + (16 * tt + fr) * RS + (32 * ks + 16 + 4 * g) * 2);
                v4u w; w.x = (unsigned)lo; w.y = (unsigned)(lo >> 32); w.z = (unsigned)hi; w.w = (unsigned)(hi >> 32);
                ((GAS v4u*)(args.ws + WS_GQD))[((size_t)u * 8 + wave) * 64 + lane] = w;
                if (wave == 0) ((GAS float*)(args.ws + WS_GDEC))[(size_t)u * 64 + lane] = dec[lane];
            }
            LDS_WAIT(); __syncthreads();
            bf16x8 vb[2];
#pragma unroll
            for (int ks = 0; ks < 2; ++ks) vb[ks] = *(const LAS bf16x8*)(vT + (16 * wave + fr) * RS + (32 * ks + 8 * g) * 2);
#pragma unroll
            for (int tt = 0; tt < 4; ++tt) {
                f32x4 acc = {0.f, 0.f, 0.f, 0.f};
#pragma unroll
                for (int ks = 0; ks < 2; ++ks) { const bf16x8 a = *(const LAS bf16x8*)(Am + (16 * tt + fr) * RS + (32 * ks + 8 * g) * 2); acc = __builtin_amdgcn_mfma_f32_16x16x32_bf16(vb[ks], a, acc, 0, 0, 0); }
                const unsigned rlo = (unsigned)rav[tt], rhi = (unsigned)(rav[tt] >> 32);
                const float rr[4] = {bflo(rlo), bfhi(rlo), bflo(rhi), bfhi(rhi)};
                v4u w;
#pragma unroll
                for (int r = 0; r < 4; ++r) { const float gate = ggl[r] * rr[r] * __builtin_amdgcn_rcpf(1.f + __expf(-rr[r])); w[r] = cvtpk(acc[r], gate); }
                ((GAS v4u*)(args.ws + WS_GOG))[(((size_t)u * 8 + wave) * 4 + tt) * 64 + lane] = w;
            }
#pragma unroll
            for (int dt = 0; dt < 4; ++dt) {
                f32x4 acc = {0.f, 0.f, 0.f, 0.f};
#pragma unroll
                for (int ks = 0; ks < 2; ++ks) { const bf16x8 a = *(const LAS bf16x8*)(keT + (16 * dt + fr) * RS + (32 * ks + 8 * g) * 2); acc = __builtin_amdgcn_mfma_f32_16x16x32_bf16(a, vb[ks], acc, 0, 0, 0); }
                const unsigned long long w = (unsigned long long)cvtpk(acc[0], acc[1]) | ((unsigned long long)cvtpk(acc[2], acc[3]) << 32);
                ((GAS unsigned long long*)(args.ws + WS_GKV))[(((size_t)u * 8 + wave) * 4 + dt) * 64 + lane] = w;
            }
            LDS_WAIT(); __syncthreads();
        }
        }
    }
    { LANE_DECL; xcd_barrier(bar, wave == 0 && lane == 0); }

    for (int rep_ = 0; rep_ < REP_P2; ++rep_) {
    for (int rep3_ = 0; rep3_ < REP_SEQ; ++rep3_)
    if (bx < 32) {
        LANE_DECL;
        const int fr = lane & 15, g = lane >> 4;
        const int b = bx >> 2, h = bx & 3;
        LAS float* const ssqb = (LAS float*)(L + RING_OFF);
        LAS float* const rstdl = ssqb + 1024 + wave * 64;
        f32x4 S[4];
#pragma unroll
        for (int dt = 0; dt < 4; ++dt) S[dt] = (f32x4){0.f, 0.f, 0.f, 0.f};
        const GAS v4u* const gog = (const GAS v4u*)(args.ws + WS_GOG);
        const GAS unsigned long long* const gkv = (const GAS unsigned long long*)(args.ws + WS_GKV);
        const GAS v4u* const gqd = (const GAS v4u*)(args.ws + WS_GQD);
        const GAS f32x4* const gdec = (const GAS f32x4*)(args.ws + WS_GDEC);
        const int u0 = bx * 64;
        v4u ogA[4], ogB[4]; unsigned long long kvA[4], kvB[4]; v4u qdA[8], qdB[8]; f32x4 dcA[4], dcB[4];
#define GLA_LOAD(og_, kv_, qd_, dc_, uu) do { const size_t u_ = (size_t)(uu); \
        _Pragma("unroll") for (int q = 0; q < 4; ++q) { og_[q] = gog[((u_ * 8 + wave) * 4 + q) * 64 + lane]; kv_[q] = gkv[((u_ * 8 + wave) * 4 + q) * 64 + lane]; dc_[q] = gdec[u_ * 16 + 4 * q + g]; } \
        _Pragma("unroll") for (int q = 0; q < 8; ++q) qd_[q] = gqd[(u_ * 8 + q) * 64 + lane]; } while (0)
#define GLA_STEP(og_, kv_, qd_, dc_, n_) do { \
            const int t0 = b * SEQ + (n_) * 64; \
            bf16x8 sa[2];                                                   \
            _Pragma("unroll") for (int ks = 0; ks < 2; ++ks) { v4u w; w.x = cvtpk(S[2 * ks][0], S[2 * ks][1]); w.y = cvtpk(S[2 * ks][2], S[2 * ks][3]); w.z = cvtpk(S[2 * ks + 1][0], S[2 * ks + 1][1]); w.w = cvtpk(S[2 * ks + 1][2], S[2 * ks + 1][3]); sa[ks] = __builtin_bit_cast(bf16x8, w); } \
            f32x4 o[4]; f32x4 gt[4];                                        \
            _Pragma("unroll") for (int tt = 0; tt < 4; ++tt) { \
                f32x4 acc; \
                _Pragma("unroll") for (int r = 0; r < 4; ++r) { acc[r] = bflo(og_[tt][r]); gt[tt][r] = bfhi(og_[tt][r]); } \
                _Pragma("unroll") for (int ks = 0; ks < 2; ++ks) acc = __builtin_amdgcn_mfma_f32_16x16x32_bf16(sa[ks], __builtin_bit_cast(bf16x8, qd_[2 * tt + ks]), acc, 0, 0, 0); \
                o[tt] = acc; } \
            _Pragma("unroll") for (int dt = 0; dt < 4; ++dt) { const unsigned lo = (unsigned)kv_[dt], hi = (unsigned)(kv_[dt] >> 32); \
                S[dt][0] = S[dt][0] * dc_[dt][0] + bflo(lo); S[dt][1] = S[dt][1] * dc_[dt][1] + bfhi(lo); S[dt][2] = S[dt][2] * dc_[dt][2] + bflo(hi); S[dt][3] = S[dt][3] * dc_[dt][3] + bfhi(hi); } \
            LAS float* const sq = ssqb + ((n_) & 1) * 512; \
            _Pragma("unroll") for (int tt = 0; tt < 4; ++tt) { float s2 = (o[tt][0] * o[tt][0] + o[tt][1] * o[tt][1]) + (o[tt][2] * o[tt][2] + o[tt][3] * o[tt][3]); s2 = add_x32(add_x16(s2)); if (g == 0) sq[wave * 64 + 16 * tt + fr] = s2; } \
            LDS_WAIT(); __syncthreads(); \
            { float tot = 0.f; \
              _Pragma("unroll") for (int w2 = 0; w2 < 8; ++w2) tot += sq[w2 * 64 + lane]; \
              rstdl[lane] = __builtin_amdgcn_rsqf(tot * (1.f / 128.f) + EPS); } \
            LDS_WAIT(); asm volatile("" ::: "memory"); \
            _Pragma("unroll") for (int tt = 0; tt < 4; ++tt) { \
                const float rs = rstdl[16 * tt + fr]; \
                const unsigned long long w = (unsigned long long)cvtpk(o[tt][0] * rs * gt[tt][0], o[tt][1] * rs * gt[tt][1]) | ((unsigned long long)cvtpk(o[tt][2] * rs * gt[tt][2], o[tt][3] * rs * gt[tt][3]) << 32); \
                *(GAS unsigned long long*)(mix + (size_t)(t0 + 16 * tt + fr) * D + h * 128 + 16 * wave + 4 * g) = w; } \
            LDS_WAIT(); asm volatile("" ::: "memory"); } while (0)
        GLA_LOAD(ogA, kvA, qdA, dcA, u0);
        for (int n = 0; n < 64; n += 2) {
            GLA_LOAD(ogB, kvB, qdB, dcB, u0 + n + 1);
            GLA_STEP(ogA, kvA, qdA, dcA, n);
            if (n + 2 < 64) GLA_LOAD(ogA, kvA, qdA, dcA, u0 + n + 2);
            GLA_STEP(ogB, kvB, qdB, dcB, n + 1);
        }
#undef GLA_LOAD
#undef GLA_STEP
        __syncthreads();
    }
    if (bx >= 32) {
        LANE_DECL;
        LAS float* scr = (LAS float*)(L + RING_OFF + wave * 16384);
        const int gwl = (bx - 32) * NWAVES + wave, NGWL = (G - 32) * NWAVES;
        constexpr int I_OUT = 16 * 32, I_PQ = 16 * 64, I_PG = 16 * 32;
        for (int it = gwl; it < I_OUT + I_PQ + I_PG; it += NGWL) {
            int r = it;
            if (r < I_OUT) { p0_transpose_item(w_out, 1024, 1024, 0, 1024, nullptr, Bt_out, 0, 32, scr, r, lane); continue; } r -= I_OUT;
            if (r < I_PQ) { p0_transpose_item(w_pq, 1024, 2048, 0, 2048, g_peer, Bt_pq, 0, 64, scr, r, lane); continue; } r -= I_PQ;
            p0_transpose_item(w_pg, 1024, 1024, 0, 1024, g_ple, Bt_pg, 0, 32, scr, r, lane);
        }
        for (int i = gwl * 64 + lane; i < 16384 * 16 * 2; i += NGWL * 64) {
            const int tab = i >> 18, row = (i >> 4) & 16383, li = i & 15;
            const float* src = (tab ? pv : pu) + (size_t)row * D;
            const float scl = tab ? 4.f : 64.f;
            unsigned dw[12];
#pragma unroll
            for (int q = 0; q < 12; ++q) dw[q] = 0u;
#pragma unroll
            for (int j = 0; j < 4; ++j)
#pragma unroll
                for (int e4 = 0; e4 < 4; ++e4) {
                    f32x4 v = ((const GAS f32x4*)(src + 256 * j + 16 * li))[e4];
                    if (!tab) v = v * ((const GAS f32x4*)(g_peer + 256 * j + 16 * li))[e4];
                    v = v * scl;
#pragma unroll
                    for (int e = 0; e < 4; ++e) {
                        const int k = (j & 1) * 16 + e4 * 4 + e, grp = j >> 1;
                        dw[grp * 4 + (k >> 3)] |= enc4(v[e]) << (4 * (k & 7));
                    }
                }
            { GAS v4u* dst = (GAS v4u*)((tab ? Vb : Ub) + (size_t)row * 512) + li;
                v4u o0, o1; o0.x = dw[0]; o0.y = dw[1]; o0.z = dw[2]; o0.w = dw[3]; o1.x = dw[4]; o1.y = dw[5]; o1.z = dw[6]; o1.w = dw[7];
                dst[0] = o0; dst[16] = o1; }
        }
        for (int i = gwl * 64 + lane; i < 16 * 128 * 128 / 4; i += NGWL * 64) {
            const f32x4 v = ((const GAS f32x4*)skeys)[i];
            ((GAS unsigned long long*)keysb)[i] = (unsigned long long)pk2(v.x, v.y) | ((unsigned long long)pk2(v.z, v.w) << 32);
        }
        __syncthreads();
    }
    for (int rep2_ = 0; rep2_ < REP_DSW; ++rep2_)
    {
        LANE_DECL;
        const int qc = lane & 31, hh = lane >> 5;
        constexpr int OROW = 136;
        LAS unsigned char* const Ob = L + RING_OFF;
        constexpr int KROW = 144;
        LAS unsigned char* const Kst = L + RING_OFF + 512 * OROW + wave * (2 * 32 * KROW);
        LAS unsigned char* const Vst = Kst + 32 * KROW;
        volatile LAS int* const ubox = (volatile LAS int*)(L + MISC_OFF + 64);
        const float C2 = 0.125f * 1.4426950408889634f;
        for (;;) {
            if (wave == 0 && lane == 0) ubox[0] = (int)__hip_atomic_fetch_add(ctl + CW_DSW + 64 * (rep_ * 4 + rep2_), 1u, __ATOMIC_RELAXED, __HIP_MEMORY_SCOPE_AGENT);
            __syncthreads();
            const int unit = __builtin_amdgcn_readfirstlane(ubox[0]);
            if (unit >= 512) break;
            const int sp = unit & 7, h = (unit >> 3) & 7, b = unit >> 6;
            const int s0 = sp * 512;
            const bf16* const base = proj + (size_t)b * SEQ * INC;
#pragma unroll 1
            for (int pt = 0; pt < 3; ++pt) {
                const int dl = (pt == 0) ? 0 : ((pt == 1) ? 2 : 4), d = 1 << dl;
#pragma unroll 1
                for (int rep = 0; rep < 2; ++rep) {
                    const int qt = wave + 8 * rep;
                    const int rr = qt & (d - 1), jj = qt >> dl;
                    const int tq0 = s0 + rr + ((32 * jj) << dl);
                    const int tkb = tq0 - (128 << dl);
                    int kkmin = 0;
                    if (tkb < 0) kkmin = (-tkb + d - 1) >> dl;
                    bf16x8 qf[4];
#pragma unroll
                    for (int ks = 0; ks < 4; ++ks) qf[ks] = *(const GAS bf16x8*)(base + (size_t)(tq0 + (qc << dl)) * INC + OFF_QB + h * 64 + 16 * ks + 8 * hh);
                    f32x16 O0, O1;
#pragma unroll
                    for (int r = 0; r < 16; ++r) { O0[r] = 0.f; O1[r] = 0.f; }
                    float m = -INFINITY, l = 0.f;
                    const int cmin = kkmin >> 5;
                    v4u kA[4], vA[4], kB[4], vB[4];
#define DSW_LOAD(kr_, vr_, c_) do { const int k0_ = 32 * (c_); \
                        _Pragma("unroll") for (int it = 0; it < 4; ++it) { const int pc = lane + 64 * it, key = pc >> 3, ch = pc & 7; int tk = tkb + ((k0_ + key) << dl); tk = tk < 0 ? 0 : (tk > SEQ - 1 ? SEQ - 1 : tk); \
                            const bf16* rp = base + (size_t)tk * INC + h * 64 + 8 * ch; kr_[it] = *(const GAS v4u*)(rp + OFF_KB); vr_[it] = *(const GAS v4u*)(rp + OFF_VB); } } while (0)
#define DSW_STEP(kr_, vr_, c_) do { const int k0 = 32 * (c_); \
                        _Pragma("unroll") for (int it = 0; it < 4; ++it) { const int pc = lane + 64 * it, key = pc >> 3, ch = pc & 7; *(LAS v4u*)(Kst + key * KROW + ch * 16) = kr_[it]; *(LAS v4u*)(Vst + key * KROW + ch * 16) = vr_[it]; } \
                        LDS_WAIT(); asm volatile("" ::: "memory"); \
                        f32x16 sc; \
                        _Pragma("unroll") for (int r = 0; r < 16; ++r) sc[r] = 0.f; \
                        _Pragma("unroll") for (int ks = 0; ks < 4; ++ks) { const bf16x8 ka = *(const LAS bf16x8*)(Kst + qc * KROW + (16 * ks + 8 * hh) * 2);     \
                            sc = __builtin_amdgcn_mfma_f32_32x32x16_bf16(ka, qf[ks], sc, 0, 0, 0); } \
                        const bool edge = ((c_) == 0) | ((c_) == 4) | (k0 < kkmin);     \
                        float cmax = -INFINITY; \
                        _Pragma("unroll") for (int r = 0; r < 16; ++r) { float v = sc[r] * C2; \
                            if (edge) { const int kk = k0 + (r & 3) + 8 * (r >> 2) + 4 * hh; const bool ok = (kk >= qc) & (kk <= qc + 128) & (kk >= kkmin); v = ok ? v : -INFINITY; } \
                            sc[r] = v; cmax = fmaxf(cmax, v); } \
                        cmax = max_x32(cmax); \
                        const float mn = fmaxf(m, cmax);                    \
                        const float alpha = __builtin_amdgcn_exp2f(m - mn); \
                        float ps = 0.f; \
                        _Pragma("unroll") for (int r = 0; r < 16; ++r) { sc[r] = __builtin_amdgcn_exp2f(sc[r] - mn); ps += sc[r]; } \
                        l = l * alpha + ps; m = mn; \
                        bf16x8 pf[2];                                       \
                        _Pragma("unroll") for (int sx = 0; sx < 2; ++sx) { v4u w; w.x = cvtpk(sc[8 * sx], sc[8 * sx + 1]); w.y = cvtpk(sc[8 * sx + 2], sc[8 * sx + 3]); w.z = cvtpk(sc[8 * sx + 4], sc[8 * sx + 5]); w.w = cvtpk(sc[8 * sx + 6], sc[8 * sx + 7]); pf[sx] = __builtin_bit_cast(bf16x8, w); } \
                        _Pragma("unroll") for (int r = 0; r < 16; ++r) { O0[r] *= alpha; O1[r] *= alpha; } \
                        _Pragma("unroll") for (int sx = 0; sx < 2; ++sx) { \
                            const int vrow = 16 * sx + 4 * hh + ((lane & 15) >> 2), vcol = 16 * ((lane >> 4) & 1) + 4 * (lane & 3); \
                            const s16x4 a0 = __builtin_amdgcn_ds_read_tr16_b64_v4i16((LAS s16x4*)(Vst + vrow * KROW + vcol * 2)); \
                            const s16x4 a1 = __builtin_amdgcn_ds_read_tr16_b64_v4i16((LAS s16x4*)(Vst + (vrow + 8) * KROW + vcol * 2)); \
                            const s16x4 c0 = __builtin_amdgcn_ds_read_tr16_b64_v4i16((LAS s16x4*)(Vst + vrow * KROW + (32 + vcol) * 2)); \
                            const s16x4 c1 = __builtin_amdgcn_ds_read_tr16_b64_v4i16((LAS s16x4*)(Vst + (vrow + 8) * KROW + (32 + vcol) * 2)); \
                            bf16x8 va, vc; va[0] = a0[0]; va[1] = a0[1]; va[2] = a0[2]; va[3] = a0[3]; va[4] = a1[0]; va[5] = a1[1]; va[6] = a1[2]; va[7] = a1[3]; \
                            vc[0] = c0[0]; vc[1] = c0[1]; vc[2] = c0[2]; vc[3] = c0[3]; vc[4] = c1[0]; vc[5] = c1[1]; vc[6] = c1[2]; vc[7] = c1[3]; \
                            O0 = __builtin_amdgcn_mfma_f32_32x32x16_bf16(va, pf[sx], O0, 0, 0, 0); \
                            O1 = __builtin_amdgcn_mfma_f32_32x32x16_bf16(vc, pf[sx], O1, 0, 0, 0); } \
                        LDS_WAIT(); asm volatile("" ::: "memory");         \
                    } while (0)
                    DSW_LOAD(kA, vA, 4);
                    if (3 >= cmin) DSW_LOAD(kB, vB, 3);
                    DSW_STEP(kA, vA, 4);
                    if (3 >= cmin) {
                        if (2 >= cmin) DSW_LOAD(kA, vA, 2);
                        DSW_STEP(kB, vB, 3);
                        if (2 >= cmin) {
                            if (1 >= cmin) DSW_LOAD(kB, vB, 1);
                            DSW_STEP(kA, vA, 2);
                            if (1 >= cmin) {
                                if (0 >= cmin) DSW_LOAD(kA, vA, 0);
                                DSW_STEP(kB, vB, 1);
                                if (0 >= cmin) DSW_STEP(kA, vA, 0);
                            }
                        }
                    }
#undef DSW_LOAD
#undef DSW_STEP
                    l = add_x32(l);
                    const int row = (tq0 - s0) + (qc << dl);
                    LAS unsigned char* orow = Ob + row * OROW;
                    if (pt > 0) {
                        const float m1 = *(const LAS float*)(orow + 128), l1 = *(const LAS float*)(orow + 132);
                        const float mn = fmaxf(m, m1), a0 = __builtin_amdgcn_exp2f(m - mn), a1 = __builtin_amdgcn_exp2f(m1 - mn);
#pragma unroll
                        for (int rq = 0; rq < 4; ++rq) {
                            const unsigned long long w0 = *(const LAS unsigned long long*)(orow + (8 * rq + 4 * hh) * 2), w1 = *(const LAS unsigned long long*)(orow + (32 + 8 * rq + 4 * hh) * 2);
                            O0[4 * rq] = O0[4 * rq] * a0 + bflo((unsigned)w0) * a1; O0[4 * rq + 1] = O0[4 * rq + 1] * a0 + bfhi((unsigned)w0) * a1;
                            O0[4 * rq + 2] = O0[4 * rq + 2] * a0 + bflo((unsigned)(w0 >> 32)) * a1; O0[4 * rq + 3] = O0[4 * rq + 3] * a0 + bfhi((unsigned)(w0 >> 32)) * a1;
                            O1[4 * rq] = O1[4 * rq] * a0 + bflo((unsigned)w1) * a1; O1[4 * rq + 1] = O1[4 * rq + 1] * a0 + bfhi((unsigned)w1) * a1;
                            O1[4 * rq + 2] = O1[4 * rq + 2] * a0 + bflo((unsigned)(w1 >> 32)) * a1; O1[4 * rq + 3] = O1[4 * rq + 3] * a0 + bfhi((unsigned)(w1 >> 32)) * a1;
                        }
                        l = l * a0 + l1 * a1; m = mn;
                    }
                    if (pt < 2) {
#pragma unroll
                        for (int rq = 0; rq < 4; ++rq) {
                            *(LAS unsigned long long*)(orow + (8 * rq + 4 * hh) * 2) = (unsigned long long)cvtpk(O0[4 * rq], O0[4 * rq + 1]) | ((unsigned long long)cvtpk(O0[4 * rq + 2], O0[4 * rq + 3]) << 32);
                            *(LAS unsigned long long*)(orow + (32 + 8 * rq + 4 * hh) * 2) = (unsigned long long)cvtpk(O1[4 * rq], O1[4 * rq + 1]) | ((unsigned long long)cvtpk(O1[4 * rq + 2], O1[4 * rq + 3]) << 32);
                        }
                        if (hh == 0) { *(LAS float*)(orow + 128) = m; *(LAS float*)(orow + 132) = l; }
                    } else {
                        const float rl = 1.f / l;
                        bf16* op = mix + (size_t)(b * SEQ + s0 + row) * D + 512 + h * 64;
#pragma unroll
                        for (int rq = 0; rq < 4; ++rq) {
                            *(GAS unsigned long long*)(op + 8 * rq + 4 * hh) = (unsigned long long)cvtpk(O0[4 * rq] * rl, O0[4 * rq + 1] * rl) | ((unsigned long long)cvtpk(O0[4 * rq + 2] * rl, O0[4 * rq + 3] * rl) << 32);
                            *(GAS unsigned long long*)(op + 32 + 8 * rq + 4 * hh) = (unsigned long long)cvtpk(O1[4 * rq] * rl, O1[4 * rq + 1] * rl) | ((unsigned long long)cvtpk(O1[4 * rq + 2] * rl, O1[4 * rq + 3] * rl) << 32);
                        }
                    }
                }
                LDS_WAIT(); __syncthreads();
            }
        }
    }
    }
    { LANE_DECL; xcd_barrier(bar, wave == 0 && lane == 0); }

    for (int rep_ = 0; rep_ < REP_P3; ++rep_) {
        pg8::Gemm g{mix, Bt_out, T, D, D}; pg8::StaticOrder S; S.init(T, D, G, bx);
        pg8::EpiOutProj E{xin, x1b, ssq1};
        pg8::gemm_phase<pg8::EpiOutProj, pg8::StaticOrder, true, true>(L + RING_OFF, g, S, E, wave);
    }
    { LANE_DECL; xcd_barrier(bar, wave == 0 && lane == 0); }

    for (int rep_ = 0; rep_ < REP_P4; ++rep_) {
        pg8::Gemm g{x1b, Bt_pq, T, 2048, D}; pg8::StaticOrder S; S.init(T, 2048, G, bx);
        pg8::EpiPeerQ E{qr, ssq1};
        pg8::gemm_phase<pg8::EpiPeerQ, pg8::StaticOrder, true, true>(L + RING_OFF, g, S, E, wave);
    }
    { LANE_DECL; xcd_barrier(bar, wave == 0 && lane == 0); }

    for (int rep_ = 0; rep_ < REP_P5; ++rep_) {
        LANE_DECL;
        const int fr = lane & 15, g = lane >> 4;
        constexpr int KROW = 272;
        const int h = bx & 7, nbh = G >> 3;
        {
            const GAS v4u* src = (const GAS v4u*)(keysb + (size_t)h * 2 * 128 * 128);
            for (int pc = wave * 64 + lane; pc < 4096; pc += NWAVES * 64) { const int R = pc >> 4, ch = pc & 15; *(LAS v4u*)(L + RING_OFF + R * KROW + ch * 16) = src[pc]; }
        }
        LAS int* const scr = (LAS int*)(L + RING_OFF + 256 * KROW + wave * (16 * 33 * 4));
        __syncthreads();
        for (int tg = (bx >> 3) * NWAVES + wave; tg < T / 16; tg += nbh * NWAVES) {
            const int tok0 = tg * 16;
            int top[2][16];
#pragma unroll
            for (int c = 0; c < 2; ++c) {
                bf16x8 bq[4];
#pragma unroll
                for (int ks = 0; ks < 4; ++ks) bq[ks] = *(const GAS bf16x8*)(qr + (size_t)(tok0 + fr) * 2048 + h * 256 + c * 128 + 32 * ks + 8 * g);
                int v[32];
#pragma unroll
                for (int tl = 0; tl < 8; ++tl) {
                    f32x4 acc = {0.f, 0.f, 0.f, 0.f};
#pragma unroll
                    for (int ks = 0; ks < 4; ++ks) { const bf16x8 a = *(const LAS bf16x8*)(L + RING_OFF + (c * 128 + 16 * tl + fr) * KROW + (32 * ks + 8 * g) * 2);
                        acc = __builtin_amdgcn_mfma_f32_16x16x32_bf16(a, bq[ks], acc, 0, 0, 0); }
#pragma unroll
                    for (int r = 0; r < 4; ++r) v[4 * tl + r] = (f2key(acc[r]) & ~0x7f) | (16 * tl + 4 * g + r);
                }
                bitonic_sort_desc<32>(v);
#pragma unroll
                for (int i = 0; i < 16; ++i) top[c][i] = v[i];
                merge_top16(top[c], lane ^ 16);
                merge_top16(top[c], lane ^ 32);
            }
            float fa[16], fb[16];
#pragma unroll
            for (int i = 0; i < 16; ++i) { fa[i] = key2f(top[0][i]); fb[i] = key2f(top[1][i]); }
            int cand[16];
#pragma unroll
            for (int sl = 0; sl < 16; ++sl) {
                int cv[4];
#pragma unroll
                for (int gg = 0; gg < 4; ++gg) { constexpr int NEG = (int)0x80000000;
                    const int n = 16 * gg + sl;
                    if (kCand.i[n] >= 0) cv[gg] = (f2key(fa[kCand.i[n] < 0 ? 0 : kCand.i[n]] + fb[kCand.j[n] < 0 ? 0 : kCand.j[n]]) & ~0xff) | (kCand.i[n] * 16 + kCand.j[n]); else cv[gg] = NEG; }
                cand[sl] = (g == 0) ? cv[0] : ((g == 1) ? cv[1] : ((g == 2) ? cv[2] : cv[3]));
            }
            bitonic_sort_desc<16>(cand);
            merge_top16(cand, lane ^ 16);
            merge_top16(cand, lane ^ 32);
#pragma unroll
            for (int i = 0; i < 16; ++i) { if (g == (i >> 3)) scr[fr * 33 + i] = top[0][i] & 0x7f; if (g == 2 + (i >> 3)) scr[fr * 33 + 16 + i] = top[1][i] & 0x7f; }
            float ex[16]; float den = 0.f; const float m0 = key2f(cand[0]);
#pragma unroll
            for (int r = 0; r < 16; ++r) { ex[r] = __expf(key2f(cand[r]) - m0); den += ex[r]; }
            const float rden = 1.f / den;
            LDS_WAIT(); asm volatile("" ::: "memory");
            int oi[4]; float og[4];
#pragma unroll
            for (int q = 0; q < 4; ++q) {
                const int kq = (g == 0) ? cand[q] : ((g == 1) ? cand[4 + q] : ((g == 2) ? cand[8 + q] : cand[12 + q]));
                const float eq = (g == 0) ? ex[q] : ((g == 1) ? ex[4 + q] : ((g == 2) ? ex[8 + q] : ex[12 + q]));
                const int code = kq & 0xff;
                oi[q] = scr[fr * 33 + (code >> 4)] * 128 + scr[fr * 33 + 16 + (code & 15)]; og[q] = eq * rden;
            }
            GAS v4u* op = (GAS v4u*)(sel2 + (size_t)(tok0 + fr) * 128 + h * 16 + 4 * g);
            v4u o0, o1; o0.x = (unsigned)oi[0]; o0.y = __float_as_uint(og[0]); o0.z = (unsigned)oi[1]; o0.w = __float_as_uint(og[1]);
            o1.x = (unsigned)oi[2]; o1.y = __float_as_uint(og[2]); o1.z = (unsigned)oi[3]; o1.w = __float_as_uint(og[3]);
            op[0] = o0; op[1] = o1;
            LDS_WAIT(); asm volatile("" ::: "memory");
        }
        __syncthreads();
    }
    { LANE_DECL; xcd_barrier(bar, wave == 0 && lane == 0); }

    for (int rep_ = 0; rep_ < REP_P6; ++rep_) {
        LANE_DECL;
        const int g4 = lane >> 4, li = lane & 15;
        LAS i32x2* const selw = (LAS i32x2*)(L + RING_OFF + wave * 1024);
        for (int tok = gw; tok < T; tok += NGW) {
            const float s1 = (lane < 16) ? ssq1[(size_t)lane * T + tok] : 0.f;
            const float rstd1 = rsqrtf(wave_sum(s1) * (1.f / D) + EPS);
            v4u xw[8];
#pragma unroll
            for (int j = 0; j < 4; ++j) { xw[2 * j] = ((const GAS v4u*)(x1b + (size_t)tok * D))[32 * j + 2 * li]; xw[2 * j + 1] = ((const GAS v4u*)(x1b + (size_t)tok * D))[32 * j + 2 * li + 1]; }
            float acc[64];
#pragma unroll
            for (int k = 0; k < 64; ++k) acc[k] = 0.f;
            {
                const GAS i32x2* selg = (const GAS i32x2*)sel2 + (size_t)tok * 128;
                const i32x2 p0 = selg[lane], p1 = selg[lane + 64];
                const int b0 = p0.x >> 11, b1 = p1.x >> 11;
                const unsigned long long lt = (1ull << lane) - 1ull;
                int base = 0, r0 = 0, r1 = 0;
#pragma unroll
                for (int bk = 0; bk < 8; ++bk) {
                    const unsigned long long m0 = __ballot(b0 == bk), m1 = __ballot(b1 == bk);
                    const int c0 = __popcll(m0), c1 = __popcll(m1);
                    if (b0 == bk) r0 = base + __popcll(m0 & lt);
                    if (b1 == bk) r1 = base + c0 + __popcll(m1 & lt);
                    base += c0 + c1;
                }
                selw[r0] = p0; selw[r1] = p1;
                LDS_WAIT(); asm volatile("" ::: "memory");
            }
            const float ascale = rstd1 * (1.f / 64.f);
            v4u rA[4], rB[4], rC[4], rD[4]; i32x2 eA, eB, eC, eD;
#define PG_LOAD(r_, e_, it_) do { e_ = selw[4 * (it_) + g4]; const GAS v4u* up = (const GAS v4u*)(Ub + (size_t)e_.x * 512) + li; const GAS v4u* vp = (const GAS v4u*)(Vb + (size_t)e_.x * 512) + li; \
                r_[0] = up[0]; r_[1] = up[16]; r_[2] = vp[0]; r_[3] = vp[16]; } while (0)
#define PG_U4(r_, bsel) { const unsigned da = __builtin_bit_cast(unsigned, __builtin_amdgcn_cvt_scalef32_pk_bf16_fp4(r_[0][w], 1.0f, bsel)), db = __builtin_bit_cast(unsigned, __builtin_amdgcn_cvt_scalef32_pk_bf16_fp4(r_[1][w], 1.0f, bsel)); \
                        s = dot2bf(xw[w][bsel], da, s); s = dot2bf(xw[4 + w][bsel], db, s); }
#define PG_V4(r_, bsel) { const f32x2 fa = __builtin_amdgcn_cvt_scalef32_pk_f32_fp4(r_[2][w], 1.0f, bsel), fb = __builtin_amdgcn_cvt_scalef32_pk_f32_fp4(r_[3][w], 1.0f, bsel); \
                        acc[8 * w + 2 * bsel] += act * fa.x; acc[8 * w + 2 * bsel + 1] += act * fa.y; acc[32 + 8 * w + 2 * bsel] += act * fb.x; acc[32 + 8 * w + 2 * bsel + 1] += act * fb.y; }
#define PG_STEP(r_, e_) do { float s = 0.f; \
                _Pragma("unroll") for (int w = 0; w < 4; ++w) { PG_U4(r_, 0) PG_U4(r_, 1) PG_U4(r_, 2) PG_U4(r_, 3) } \
                s = row_sum16(s); \
                const float a = s * ascale; \
                const float act = 0.5f * a * (1.f + erff(a * 0.70710678118654752f)) * __int_as_float(e_.y) * 0.25f; \
                _Pragma("unroll") for (int w = 0; w < 4; ++w) { PG_V4(r_, 0) PG_V4(r_, 1) PG_V4(r_, 2) PG_V4(r_, 3) } } while (0)
            PG_LOAD(rA, eA, 0); PG_LOAD(rB, eB, 1); PG_LOAD(rC, eC, 2);
            for (int it = 0; it < 32; it += 4) {
                PG_LOAD(rD, eD, it + 3);
                PG_STEP(rA, eA);
                if (it + 4 < 32) PG_LOAD(rA, eA, it + 4);
                PG_STEP(rB, eB);
                if (it + 4 < 32) PG_LOAD(rB, eB, it + 5);
                PG_STEP(rC, eC);
                if (it + 4 < 32) PG_LOAD(rC, eC, it + 6);
                PG_STEP(rD, eD);
            }
#undef PG_LOAD
#undef PG_U4
#undef PG_V4
#undef PG_STEP
            float s2 = 0.f;
#pragma unroll
            for (int j = 0; j < 4; ++j) {
                float r[16];
#pragma unroll
                for (int e = 0; e < 16; ++e) { float v = acc[16 * j + e]; v += xshfl(v, lane ^ 16); v += xshfl(v, lane ^ 32);
                    const unsigned xwd = xw[2 * j + (e >> 3)][(e >> 1) & 3]; r[e] = v + ((e & 1) ? bfhi(xwd) : bflo(xwd)); s2 += r[e] * r[e]; }
                if (g4 == j) { v4u o0, o1; o0.x = pk2(r[0], r[1]); o0.y = pk2(r[2], r[3]); o0.z = pk2(r[4], r[5]); o0.w = pk2(r[6], r[7]); o1.x = pk2(r[8], r[9]); o1.y = pk2(r[10], r[11]); o1.z = pk2(r[12], r[13]); o1.w = pk2(r[14], r[15]);
                    ((GAS v4u*)(x2b + (size_t)tok * D))[32 * j + 2 * li] = o0; ((GAS v4u*)(x2b + (size_t)tok * D))[32 * j + 2 * li + 1] = o1; }
            }
            s2 = row_sum16(s2);
            if (lane == 0) rstd2[tok] = rsqrtf(s2 * (1.f / D) + EPS);
            LDS_WAIT(); asm volatile("" ::: "memory");
        }
    }
    { LANE_DECL; xcd_barrier(bar, wave == 0 && lane == 0); }

    for (int rep_ = 0; rep_ < REP_P7; ++rep_) {
        pg8::Gemm g{x2b, Bt_pg, T, D, D}; pg8::StaticOrder S; S.init(T, D, G, bx);
        pg8::EpiPle E{x2b, pproj, rstd2, x1b};
        pg8::gemm_phase<pg8::EpiPle, pg8::StaticOrder, true, true>(L + RING_OFF, g, S, E, wave);
    }
    { LANE_DECL; xcd_barrier(bar, wave == 0 && lane == 0); }

    {
    LANE_DECL;
    for (int row = gw; row < T; row += NGW) {
        const GAS v4u* xr = (const GAS v4u*)(x1b + (size_t)row * D);
        const v4u a = xr[lane], c = xr[64 + lane];
        float v[16];
        v[0] = bflo(a.x); v[1] = bfhi(a.x); v[2] = bflo(a.y); v[3] = bfhi(a.y); v[4] = bflo(a.z); v[5] = bfhi(a.z); v[6] = bflo(a.w); v[7] = bfhi(a.w);
        v[8] = bflo(c.x); v[9] = bfhi(c.x); v[10] = bflo(c.y); v[11] = bfhi(c.y); v[12] = bflo(c.z); v[13] = bfhi(c.z); v[14] = bflo(c.w); v[15] = bfhi(c.w);
        float s = 0.f;
#pragma unroll
        for (int k = 0; k < 16; ++k) s += v[k] * v[k];
        const float rstd = rsqrtf(wave_sum(s) * (1.f / D) + EPS);
        GAS f32x4* orow = (GAS f32x4*)(out + (size_t)row * D);
#pragma unroll
        for (int q = 0; q < 4; ++q) {
            const int e0 = (q < 2) ? (8 * lane + 4 * q) : (512 + 8 * lane + 4 * (q - 2));
            const f32x4 gg = *(const GAS f32x4*)(g_final + e0);
            f32x4 o; o.x = v[4 * q] * rstd * gg.x; o.y = v[4 * q + 1] * rstd * gg.y; o.z = v[4 * q + 2] * rstd * gg.z; o.w = v[4 * q + 3] * rstd * gg.w;
            orow[e0 >> 2] = o;
        }
    }
    }
}

#undef xin
#undef p_in
#undef positions
#undef g_mix
#undef w_in
#undef w_up
#undef b_gate
#undef g_gla
#undef w_out
#undef g_peer
#undef w_pq
#undef skeys
#undef pu
#undef pv
#undef g_ple
#undef w_pg
#undef w_pp
#undef g_final
#undef out
#undef Bt_in
#undef Bt_out
#undef Bt_pq
#undef Bt_pg
#undef Bt_pp
#undef rope
#undef ssq1
#undef rstd2
#undef h1
#undef x1b
#undef proj
#undef qr
#undef sel2
#undef Ub
#undef Vb
#undef keysb
#undef mix
#undef pb
#undef pproj
#undef x2b
extern "C" void kernel_launch(void* const* d_in, const int* in_sizes, int n_in, void* d_out, int out_size, void* d_ws, size_t ws_size, hipStream_t stream) {
    static int grid = 0;
    if (grid == 0) {
        if (n_in != 18 || out_size != T * D || ws_size < WS_END) { fprintf(stderr, "kernel_launch: unexpected shapes n_in %d out %d ws %zu\n", n_in, out_size, ws_size); grid = -1; return; }
        int dev = 0, cus = 0, per_cu = 0;
        if (hipGetDevice(&dev) != hipSuccess || hipDeviceGetAttribute(&cus, hipDeviceAttributeMultiprocessorCount, dev) != hipSuccess) { grid = -1; return; }
        if (hipFuncSetAttribute((const void*)mk_fwd, hipFuncAttributeMaxDynamicSharedMemorySize, LDS_BYTES) != hipSuccess) { fprintf(stderr, "kernel_launch: hipFuncSetAttribute failed\n"); grid = -1; return; }
        if (hipOccupancyMaxActiveBlocksPerMultiprocessor(&per_cu, (const void*)mk_fwd, NWAVES * 64, LDS_BYTES) != hipSuccess || per_cu < 1) fprintf(stderr, "kernel_launch: occupancy query reports %d\n", per_cu);
        (void)hipGetLastError();
        grid = cus;
    }
    if (grid < 0) return;
    if (hipMemsetAsync((char*)d_ws + WS_CTL, 0, CTL_ZERO_BYTES, stream) != hipSuccess) return;
    Args a{};
    for (int i = 0; i < 18; ++i) a.in[i] = (const float*)d_in[i];
    a.outp = (float*)d_out; a.ws = (unsigned char*)d_ws;
    hipLaunchKernelGGL(mk_fwd, dim3(grid), dim3(NWAVES * 64), LDS_BYTES, stream, a);
}
```
